# Optimizing an MI355X kernel written in HIP

```python
import math
import jax, jax.numpy as jnp
from jax import lax
import numpy as np

D_MODEL = 1024
BATCH = 16
SEQ = 2048
DEPTH = 2

SSD_WIDTH = D_MODEL
SSD_HEAD_DIM = 64
SSD_HEADS = SSD_WIDTH // SSD_HEAD_DIM
SSD_GROUPS = 2
SSD_STATE = 128
SSD_CONV = 4
SSD_CHUNK = 128
SSD_CONV_DIM = SSD_WIDTH + 2 * SSD_GROUPS * SSD_STATE
ATTN_HEAD_DIM = 64
ATTN_WIDTH = D_MODEL // 2
ATTN_Q_HEADS = ATTN_WIDTH // ATTN_HEAD_DIM
ATTN_KV_HEADS = 2
WINDOW = 128
CONF_WIDTH = D_MODEL // 2
CONF_KERNEL = 31
MIX_WIDTH = SSD_WIDTH + ATTN_WIDTH + CONF_WIDTH
IN_SPLITS = (MIX_WIDTH, SSD_CONV_DIM, SSD_HEADS, ATTN_Q_HEADS * ATTN_HEAD_DIM,
             ATTN_KV_HEADS * ATTN_HEAD_DIM, ATTN_KV_HEADS * ATTN_HEAD_DIM, 2 * CONF_WIDTH)
D_IN_PROJ = sum(IN_SPLITS)
EPS = 1e-5

kernel_name = "hybrid_ssd_swa_conformer_parallel_heads"


def _split(a, sizes):
    idx = np.cumsum(sizes)[:-1].tolist()
    return jnp.split(a, idx, axis=-1)


def rmsnorm(x, w):
    xf = x.astype(jnp.float32)
    y = xf * lax.rsqrt(jnp.mean(xf * xf, axis=-1, keepdims=True) + EPS)
    return (y * w.astype(jnp.float32)).astype(x.dtype)


def gated_group_rmsnorm(y, z, w, groups):
    g = (y * jax.nn.silu(z)).astype(jnp.float32)
    shp = g.shape
    g = g.reshape(shp[:-1] + (groups, shp[-1] // groups))
    g = g * lax.rsqrt(jnp.mean(g * g, axis=-1, keepdims=True) + EPS)
    return (g.reshape(shp) * w.astype(jnp.float32)).astype(y.dtype)


def layernorm(x, w, b):
    xf = x.astype(jnp.float32)
    mu = jnp.mean(xf, axis=-1, keepdims=True)
    xc = xf - mu
    y = xc * lax.rsqrt(jnp.mean(xc * xc, axis=-1, keepdims=True) + EPS)
    return (y * w.astype(jnp.float32) + b.astype(jnp.float32)).astype(x.dtype)


def causal_depthwise_conv(x, w, b):
    K, C = w.shape
    y = lax.conv_general_dilated(x, w[:, None, :].astype(x.dtype), window_strides=(1,),
                                 padding=[(K - 1, 0)], dimension_numbers=('NWC', 'WIO', 'NWC'),
                                 feature_group_count=C)
    return y + b.astype(x.dtype)


def ssd_chunked(x, dt, A, B, C):
    b, l, h, p = x.shape
    g, n = B.shape[2], B.shape[3]
    r = h // g
    nc = l // SSD_CHUNK
    Q = SSD_CHUNK
    x = x.reshape(b, nc, Q, g, r, p)
    dt = dt.reshape(b, nc, Q, g, r)
    B = B.reshape(b, nc, Q, g, n)
    C = C.reshape(b, nc, Q, g, n)
    a = dt * A.reshape(g, r)
    a_cs = jnp.cumsum(a, axis=2)
    xdt = x * dt[..., None]
    seg = a_cs[:, :, :, None] - a_cs[:, :, None, :]
    causal = jnp.tril(jnp.ones((Q, Q), dtype=bool))[None, None, :, :, None, None]
    L = jnp.exp(jnp.where(causal, seg, -jnp.inf))
    cb = jnp.einsum('bcign,bcjgn->bcijg', C, B)
    M = cb[..., None] * L
    y_diag = jnp.einsum('bcijgr,bcjgrp->bcigrp', M, xdt)
    decay_to_end = jnp.exp(a_cs[:, :, -1:] - a_cs)
    states = jnp.einsum('bcjgn,bcjgrp->bcgrpn', B, xdt * decay_to_end[..., None])
    chunk_decay = jnp.exp(a_cs[:, :, -1])

    def step(S, inp):
        st, dec = inp
        return dec[..., None, None] * S + st, S

    S0 = jnp.zeros((b, g, r, p, n), jnp.float32)
    _, prev = lax.scan(step, S0, (jnp.moveaxis(states, 1, 0), jnp.moveaxis(chunk_decay, 1, 0)))
    prev = jnp.moveaxis(prev, 0, 1)
    y_off = jnp.einsum('bcign,bcgrpn->bcigrp', C, prev) * jnp.exp(a_cs)[..., None]
    return (y_diag + y_off).reshape(b, l, h, p)


def swa_gqa_sinks(q, k, v, sinks):
    b, l, g, r, d = q.shape
    W = WINDOW
    nb = l // W
    qb = q.reshape(b, nb, W, g, r, d)
    kb = k.reshape(b, nb, W, g, d)
    vb = v.reshape(b, nb, W, g, d)
    pad = ((0, 0), (1, 0), (0, 0), (0, 0), (0, 0))
    kk = jnp.concatenate([jnp.pad(kb, pad)[:, :-1], kb], axis=2)
    vv = jnp.concatenate([jnp.pad(vb, pad)[:, :-1], vb], axis=2)
    s = jnp.einsum('bnqgrd,bnkgd->bngrqk', qb, kk,
                   preferred_element_type=jnp.float32) * (d ** -0.5)
    qi = jnp.arange(W)[:, None]
    kj = jnp.arange(2 * W)[None, :] - W
    rel = qi - kj
    band = (rel >= 0) & (rel < W)
    mask = band[None] & ((jnp.arange(nb)[:, None, None] > 0) | (kj[None] >= 0))
    s = jnp.where(mask[None, :, None, None], s, -jnp.inf)
    sk = sinks.astype(jnp.float32).reshape(g, r)[None, None, :, :, None, None]
    lse = jnp.logaddexp(jax.nn.logsumexp(s, axis=-1, keepdims=True), sk)
    pr = jnp.exp(s - lse)
    o = jnp.einsum('bngrqk,bnkgd->bnqgrd', pr.astype(v.dtype), vv)
    return o.reshape(b, l, g * r * d)


def hybrid_mixer(h, w_in, conv_w, conv_b, dt_bias, a_log, d_skip, ssd_norm_w, sinks,
                 dw_w, dw_b, ln_w, ln_b, w_out):
    b, l, _ = h.shape
    proj = h @ w_in
    z, xbc, dt, q, k, v, conf = _split(proj, IN_SPLITS)
    z_ssd, z_attn, z_conf = _split(z, (SSD_WIDTH, ATTN_WIDTH, CONF_WIDTH))
    xbc = jax.nn.silu(causal_depthwise_conv(xbc, conv_w, conv_b))
    xs, Bs, Cs = _split(xbc, (SSD_WIDTH, SSD_GROUPS * SSD_STATE, SSD_GROUPS * SSD_STATE))
    xs = xs.reshape(b, l, SSD_HEADS, SSD_HEAD_DIM).astype(jnp.float32)
    Bs = Bs.reshape(b, l, SSD_GROUPS, SSD_STATE).astype(jnp.float32)
    Cs = Cs.reshape(b, l, SSD_GROUPS, SSD_STATE).astype(jnp.float32)
    dtp = jax.nn.softplus(dt.astype(jnp.float32) + dt_bias.astype(jnp.float32))
    A = -jnp.exp(a_log.astype(jnp.float32))
    y = ssd_chunked(xs, dtp, A, Bs, Cs) + d_skip.astype(jnp.float32)[:, None] * xs
    y_ssd = gated_group_rmsnorm(y.reshape(b, l, SSD_WIDTH).astype(h.dtype), z_ssd,
                                ssd_norm_w, SSD_GROUPS)
    rep = ATTN_Q_HEADS // ATTN_KV_HEADS
    qh = q.reshape(b, l, ATTN_KV_HEADS, rep, ATTN_HEAD_DIM)
    kh = k.reshape(b, l, ATTN_KV_HEADS, ATTN_HEAD_DIM)
    vh = v.reshape(b, l, ATTN_KV_HEADS, ATTN_HEAD_DIM)
    y_attn = swa_gqa_sinks(qh, kh, vh, sinks) * jax.nn.silu(z_attn)
    ca, cg = _split(conf, (CONF_WIDTH, CONF_WIDTH))
    c = ca * jax.nn.sigmoid(cg)
    c = causal_depthwise_conv(c, dw_w, dw_b)
    c = jax.nn.silu(layernorm(c, ln_w, ln_b))
    y_conf = c * jax.nn.silu(z_conf)
    return jnp.concatenate([y_ssd, y_attn, y_conf], axis=-1) @ w_out


def setup_inputs(seed: int = 0) -> dict:
    key = jax.random.key(seed)
    ks = jax.random.split(key, 20)
    f32 = jnp.float32
    nrm = lambda k, s, sc: jax.random.normal(k, s, f32) * sc
    x = jax.random.normal(ks[0], (BATCH, SEQ, D_MODEL), f32)
    norm_w = 1.0 + nrm(ks[1], (DEPTH, D_MODEL), 0.02)
    w_in = nrm(ks[2], (DEPTH, D_MODEL, D_IN_PROJ), D_MODEL ** -0.5)
    ssd_conv_w = nrm(ks[3], (DEPTH, SSD_CONV, SSD_CONV_DIM), SSD_CONV ** -0.5)
    ssd_conv_b = nrm(ks[4], (DEPTH, SSD_CONV_DIM), 0.02)
    dt0 = jnp.exp(jax.random.uniform(ks[5], (DEPTH, SSD_HEADS), f32,
                                     math.log(1e-3), math.log(1e-1)))
    ssd_dt_bias = dt0 + jnp.log(-jnp.expm1(-dt0))
    ssd_a_log = jnp.log(jax.random.uniform(ks[6], (DEPTH, SSD_HEADS), f32, 1.0, 16.0))
    ssd_d = 1.0 + nrm(ks[7], (DEPTH, SSD_HEADS), 0.1)
    ssd_norm_w = 1.0 + nrm(ks[8], (DEPTH, SSD_WIDTH), 0.02)
    attn_sinks = nrm(ks[9], (DEPTH, ATTN_Q_HEADS), 1.0)
    conf_dw_w = nrm(ks[10], (DEPTH, CONF_KERNEL, CONF_WIDTH), CONF_KERNEL ** -0.5)
    conf_dw_b = nrm(ks[11], (DEPTH, CONF_WIDTH), 0.02)
    conf_ln_w = 1.0 + nrm(ks[12], (DEPTH, CONF_WIDTH), 0.02)
    conf_ln_b = nrm(ks[13], (DEPTH, CONF_WIDTH), 0.02)
    w_out = nrm(ks[14], (DEPTH, MIX_WIDTH, D_MODEL), MIX_WIDTH ** -0.5)
    final_norm_w = 1.0 + nrm(ks[15], (D_MODEL,), 0.02)
    return {"x": x, "norm_w": norm_w, "w_in": w_in, "ssd_conv_w": ssd_conv_w,
            "ssd_conv_b": ssd_conv_b, "ssd_dt_bias": ssd_dt_bias, "ssd_a_log": ssd_a_log,
            "ssd_d": ssd_d, "ssd_norm_w": ssd_norm_w, "attn_sinks": attn_sinks,
            "conf_dw_w": conf_dw_w, "conf_dw_b": conf_dw_b, "conf_ln_w": conf_ln_w,
            "conf_ln_b": conf_ln_b, "w_out": w_out, "final_norm_w": final_norm_w}


def reference(x, norm_w, w_in, ssd_conv_w, ssd_conv_b, ssd_dt_bias, ssd_a_log, ssd_d,
              ssd_norm_w, attn_sinks, conf_dw_w, conf_dw_b, conf_ln_w, conf_ln_b, w_out,
              final_norm_w):
    for i in range(DEPTH):
        h = rmsnorm(x, norm_w[i])
        x = x + hybrid_mixer(h, w_in[i], ssd_conv_w[i], ssd_conv_b[i], ssd_dt_bias[i],
                             ssd_a_log[i], ssd_d[i], ssd_norm_w[i], attn_sinks[i],
                             conf_dw_w[i], conf_dw_b[i], conf_ln_w[i], conf_ln_b[i], w_out[i])
    return rmsnorm(x, final_norm_w)
```

```cpp
#include <hip/hip_runtime.h>
#include <hip/hip_cooperative_groups.h>
namespace cg = cooperative_groups;
#include <cstdint>
#include <cstdio>

typedef unsigned short bf16;

constexpr int BATCH = 16, SEQ = 2048, DM = 1024, DEPTH = 2;
constexpr int M = BATCH * SEQ;
constexpr int NIN = 5392, NINP = 5632;
constexpr int ZYW = 2048;
constexpr int PW = 3328;
constexpr int P_XS = 0, P_B = 1024, P_C = 1280, P_Q = 1536, P_K = 2048, P_V = 2176, P_CA = 2304, P_CG = 2816;
constexpr float EPS = 1e-5f;

constexpr size_t MiB = 1u << 20;
constexpr size_t WS_CTL = 0;
constexpr size_t WS_WIN = 1 * MiB;
constexpr size_t WS_WOUT = 23 * MiB;
constexpr size_t WS_SSQ = 438 * MiB;
constexpr size_t WS_SSQH = 32 * MiB;
constexpr size_t WS_DT = 34 * MiB;
constexpr size_t WS_XB = 36 * MiB;
constexpr size_t WS_ZY = 100 * MiB;
constexpr size_t WS_P = 228 * MiB;
constexpr size_t WS_END = 440 * MiB;

__device__ __forceinline__ float bf2f(bf16 v) { return __uint_as_float(((unsigned)v) << 16); }
__device__ __forceinline__ bf16 f2bf(float f) { unsigned u = __float_as_uint(f); return (bf16)((u + 0x7fffu + ((u >> 16) & 1u)) >> 16); }
__device__ __forceinline__ float siluf(float v) { return v / (1.f + __expf(-v)); }
__device__ __forceinline__ float sigmf(float v) { return 1.f / (1.f + __expf(-v)); }
__device__ __forceinline__ float wave_sum(float v) {
#pragma unroll
    for (int o = 1; o < 64; o <<= 1) v += __shfl_xor(v, o);
    return v;
}
__device__ __forceinline__ int opaque_tid() { int t = threadIdx.x; asm volatile("" : "+v"(t)); return t; }
__host__ __device__ __forceinline__ int src_col(int np) { return np < 3584 ? np : (np < 5376 ? np + 16 : np - 1792); }

namespace pg8 {
#define PG8_LAS __attribute__((address_space(3)))
typedef unsigned short bf16_t;
typedef short bf16x8 __attribute__((ext_vector_type(8)));
typedef float f32x4 __attribute__((ext_vector_type(4)));
typedef unsigned u32x4 __attribute__((ext_vector_type(4)));
constexpr int BM = 256, BK = 64, HALF = 128, HTB = HALF * BK * 2  , STAGE_BYTES = 8 * HTB, NXCD = 8, WGM = 8;

__host__ __device__ __forceinline__ int lds_byte(int r, int c) { const int st = (r >> 4) * 2 + (c >> 5), rr = r & 15, cc = c & 31, ob = rr * 64 + cc * 2; return st * 1024 + (ob ^ (((ob >> 9) & 1) << 5)); }
__host__ __device__ __forceinline__ void stage_rc(int b, int& R, int& C) { const int st = b / 1024, sb = b % 1024, swz = sb ^ (((sb >> 9) & 1) << 5); R = (st >> 1) * 16 + swz / 64; C = (st & 1) * 32 + (swz % 64) / 2; }
__host__ __device__ __forceinline__ int perm32(int rho) { const int n = rho >> 4, i = rho & 15; return 8 * (i >> 2) + 4 * n + (i & 3); }

struct Unit { int pm, pn; };
struct Gemm { const bf16_t* A; const bf16_t* Bt; int M, N, K; };

struct StaticOrder {
    int nM, nN, nwg, G, c;
    __host__ __device__ void init(int M, int N, int G_, int c_) { nM = M / BM; nN = N / BM; nwg = nM * nN; G = G_; c = c_; }
    __host__ __device__ bool next(int i, Unit& u) const {
        const long L = (long)i * G + c; if (L >= nwg) return false;
        int wgid = (int)L; { const int q = nwg / NXCD, r = nwg % NXCD, xcd = wgid % NXCD, off = wgid / NXCD; wgid = (xcd < r ? xcd * (q + 1) : r * (q + 1) + (xcd - r) * q) + off; }
        const int nig = WGM * nN, gid = wgid / nig, fm = gid * WGM, gsz = (nM - fm) < WGM ? (nM - fm) : WGM;
        u.pm = fm + ((wgid % nig) % gsz); u.pn = (wgid % nig) / gsz; return true;
    }
    __device__ __forceinline__ void a_ready(const Unit&) const {}
    __device__ __forceinline__ void done(const Unit&) const {}
};

__device__ __forceinline__ unsigned cvt_pk_bf16(float lo, float hi) { unsigned r; asm volatile("v_cvt_pk_bf16_f32 %0, %1, %2" : "=v"(r) : "v"(lo), "v"(hi)); return r; }
template <class Epi, class Sched, bool ALIGN_EPI = false, bool SP2 = false>
__device__ __forceinline__ void gemm_phase(PG8_LAS unsigned char* lds, const Gemm g, const Sched& S, const Epi& E) {
    const int tid = opaque_tid(), wid = __builtin_amdgcn_readfirstlane(tid >> 6), lane = tid & 63, wr = wid >> 2, wc = wid & 3, fr = lane & 15, fq = lane >> 4;
    const int K = g.K, nt = K / BK;
    unsigned voffA[2], voffB[2];
#pragma unroll
    for (int i = 0; i < 2; ++i) { int R, C; stage_rc(tid * 16 + i * 8192, R, C); const int Rb = Epi::PERM ? ((R & ~31) + perm32(R & 31)) : R;
        voffA[i] = (unsigned)(R * K + C) * 2u; voffB[i] = (unsigned)(Rb * K + C) * 2u; }
    const size_t kstep = (size_t)(BK * 2);
    const size_t hstep = (size_t)HALF * K * 2;
    const size_t tstep = 2 * hstep;
    const unsigned ldsw = (unsigned)wid * 1024u;
    const int aoff = lds_byte(wr * 64 + fr, fq * 8), boff = lds_byte(wc * 32 + fr, fq * 8);
#define PG8_SA(b, h) (((b) * 2 + (h)) * HTB)
#define PG8_SB(b, h) ((4 + (b) * 2 + (h)) * HTB)
#define PG8_STAGE(bufoff, gbase, voff) do { _Pragma("unroll") for (int _i = 0; _i < 2; ++_i) \
        __builtin_amdgcn_global_load_lds((const unsigned*)((const char*)(gbase) + (voff)[_i]), (PG8_LAS unsigned*)(lds + (bufoff) + ldsw + _i * 8192), 16, 0, 0); } while (0)
#define PG8_LDA(dst, b, h) do { _Pragma("unroll") for (int m = 0; m < 4; ++m) _Pragma("unroll") for (int k = 0; k < 2; ++k) dst[m][k] = *(const PG8_LAS bf16x8*)(lds + PG8_SA(b, h) + aoff + m * 2048 + k * 1024); } while (0)
#define PG8_LDB(dst, b, h) do { _Pragma("unroll") for (int n = 0; n < 2; ++n) _Pragma("unroll") for (int k = 0; k < 2; ++k) dst[n][k] = *(const PG8_LAS bf16x8*)(lds + PG8_SB(b, h) + boff + n * 2048 + k * 1024); } while (0)
#define PG8_MMA(ai, bj, At, Bt) do { __builtin_amdgcn_s_setprio(1); _Pragma("unroll") for (int m = 0; m < 4; ++m) _Pragma("unroll") for (int n = 0; n < 2; ++n) _Pragma("unroll") for (int k = 0; k < 2; ++k) \
        acc[ai][bj][m][n] = __builtin_amdgcn_mfma_f32_16x16x32_bf16(Bt[n][k], At[m][k], acc[ai][bj][m][n], 0, 0, 0); __builtin_amdgcn_s_setprio(0); } while (0)
#define PG8_WAIT_V(n) asm volatile("s_waitcnt vmcnt(" #n ")" ::: "memory")
#define PG8_WAIT_L(n) asm volatile("s_waitcnt lgkmcnt(" #n ")" ::: "memory")
#define PG8_BAR __builtin_amdgcn_s_barrier()
#define PG8_SCHED __builtin_amdgcn_sched_barrier(0)
    Unit cur, nxt; int ui = 0;
    if (!S.next(0, cur)) return;
    f32x4 acc[2][2][4][2];
#pragma unroll
    for (int a = 0; a < 2; ++a)
#pragma unroll
        for (int b = 0; b < 2; ++b)
#pragma unroll
            for (int m = 0; m < 4; ++m)
#pragma unroll
                for (int n = 0; n < 2; ++n) acc[a][b][m][n] = (f32x4){0.f, 0.f, 0.f, 0.f};
    bf16x8 At[4][2], B0[2][2], B1[2][2];
    const char* cA = (const char*)g.A + (size_t)cur.pm * tstep; const char* cB = (const char*)g.Bt + (size_t)cur.pn * tstep;
    S.a_ready(cur);
    if constexpr (SP2) {
        PG8_STAGE(PG8_SB(0, 0), cB, voffB); PG8_STAGE(PG8_SB(0, 1), cB + hstep, voffB); PG8_STAGE(PG8_SA(0, 0), cA, voffA); PG8_STAGE(PG8_SA(0, 1), cA + hstep, voffA);
        if (wr == 1) PG8_BAR;
        PG8_WAIT_V(2); PG8_BAR;
        PG8_STAGE(PG8_SB(1, 0), cB + kstep, voffB); PG8_STAGE(PG8_SA(1, 0), cA + kstep, voffA); PG8_STAGE(PG8_SB(1, 1), cB + hstep + kstep, voffB);
        PG8_WAIT_V(6); PG8_BAR;
    } else {
        PG8_STAGE(PG8_SB(0, 0), cB, voffB); PG8_STAGE(PG8_SA(0, 0), cA, voffA); PG8_STAGE(PG8_SB(0, 1), cB + hstep, voffB); PG8_STAGE(PG8_SA(0, 1), cA + hstep, voffA);
        if (wr == 1) PG8_BAR;
        PG8_WAIT_V(4); PG8_BAR;
        PG8_STAGE(PG8_SB(1, 0), cB + kstep, voffB); PG8_STAGE(PG8_SA(1, 0), cA + kstep, voffA); PG8_STAGE(PG8_SB(1, 1), cB + hstep + kstep, voffB);
        PG8_WAIT_V(6); PG8_BAR;
    }
    for (;;) {
        const bool has_next = S.next(ui + 1, nxt);
        const char* nA = has_next ? (const char*)g.A + (size_t)nxt.pm * tstep : cA; const char* nB = has_next ? (const char*)g.Bt + (size_t)nxt.pn * tstep : cB;
        for (int t = 0; t < nt; t += 2) {
            const bool last = (t == nt - 2);
            const char* a1 = cA + (size_t)(t + 1) * kstep;
            const char* a2 = last ? nA : cA + (size_t)(t + 2) * kstep; const char* b2 = last ? nB : cB + (size_t)(t + 2) * kstep;
            const char* a3 = a2 + kstep; const char* b3 = b2 + kstep;
            if (last && has_next) S.a_ready(nxt);
            if constexpr (SP2) {
            PG8_LDB(B0, 0, 0); PG8_LDB(B1, 0, 1); PG8_SCHED; PG8_LDA(At, 0, 0); PG8_STAGE(PG8_SA(1, 1), a1 + hstep, voffA);
            PG8_WAIT_V(8); PG8_WAIT_L(0); PG8_BAR; PG8_MMA(0, 0, At, B0); PG8_MMA(0, 1, At, B1); PG8_BAR; PG8_SCHED;
            PG8_LDA(At, 0, 1); PG8_STAGE(PG8_SB(0, 0), b2, voffB); PG8_STAGE(PG8_SB(0, 1), b2 + hstep, voffB); PG8_STAGE(PG8_SA(0, 0), a2, voffA);
            PG8_WAIT_V(8); PG8_WAIT_L(0); PG8_BAR; PG8_MMA(1, 0, At, B0); PG8_MMA(1, 1, At, B1); PG8_BAR; PG8_SCHED;
            PG8_LDB(B0, 1, 0); PG8_LDB(B1, 1, 1); PG8_SCHED; PG8_LDA(At, 1, 0); PG8_STAGE(PG8_SA(0, 1), a2 + hstep, voffA);
            PG8_WAIT_V(8); PG8_WAIT_L(0); PG8_BAR; PG8_MMA(0, 0, At, B0); PG8_MMA(0, 1, At, B1); PG8_BAR; PG8_SCHED;
            PG8_LDA(At, 1, 1); PG8_STAGE(PG8_SB(1, 0), b3, voffB); PG8_STAGE(PG8_SB(1, 1), b3 + hstep, voffB); PG8_STAGE(PG8_SA(1, 0), a3, voffA);
            PG8_WAIT_V(8); PG8_WAIT_L(0); PG8_BAR; PG8_MMA(1, 0, At, B0); PG8_MMA(1, 1, At, B1); PG8_BAR; PG8_SCHED;
            } else {
            PG8_LDB(B0, 0, 0); PG8_SCHED; PG8_LDA(At, 0, 0); PG8_STAGE(PG8_SA(1, 1), a1 + hstep, voffA);
            PG8_WAIT_L(8); PG8_BAR; PG8_WAIT_L(0); PG8_MMA(0, 0, At, B0); PG8_BAR; PG8_SCHED;
            PG8_LDB(B1, 0, 1); PG8_STAGE(PG8_SB(0, 0), b2, voffB);
            PG8_BAR; PG8_WAIT_L(0); PG8_MMA(0, 1, At, B1); PG8_BAR;
            PG8_LDA(At, 0, 1); PG8_STAGE(PG8_SA(0, 0), a2, voffA);
            PG8_BAR; PG8_WAIT_L(0); PG8_MMA(1, 0, At, B0); PG8_BAR; PG8_SCHED;
            PG8_STAGE(PG8_SB(0, 1), b2 + hstep, voffB);
            PG8_WAIT_V(6); PG8_BAR; PG8_MMA(1, 1, At, B1); PG8_BAR;
            PG8_LDB(B0, 1, 0); PG8_SCHED; PG8_LDA(At, 1, 0); PG8_STAGE(PG8_SA(0, 1), a2 + hstep, voffA);
            PG8_WAIT_L(8); PG8_BAR; PG8_WAIT_L(0); PG8_MMA(0, 0, At, B0); PG8_BAR; PG8_SCHED;
            PG8_LDB(B1, 1, 1); PG8_STAGE(PG8_SB(1, 0), b3, voffB);
            PG8_BAR; PG8_WAIT_L(0); PG8_MMA(0, 1, At, B1); PG8_BAR;
            PG8_LDA(At, 1, 1); PG8_STAGE(PG8_SA(1, 0), a3, voffA);
            PG8_BAR; PG8_WAIT_L(0); PG8_MMA(1, 0, At, B0); PG8_BAR; PG8_SCHED;
            PG8_STAGE(PG8_SB(1, 1), b3 + hstep, voffB);
            PG8_WAIT_V(6); PG8_BAR; PG8_MMA(1, 1, At, B1); PG8_BAR;
            }
        }
        if constexpr (ALIGN_EPI) { if (wr == 0) PG8_BAR; }
        if constexpr (!Epi::AFTER_DRAIN) { E(acc, cur, wr, wc, fr, fq); S.done(cur); }
        if (!has_next) break;
#pragma unroll
        for (int a = 0; a < 2; ++a)
#pragma unroll
            for (int b = 0; b < 2; ++b)
#pragma unroll
                for (int m = 0; m < 4; ++m)
#pragma unroll
                    for (int n = 0; n < 2; ++n) acc[a][b][m][n] = (f32x4){0.f, 0.f, 0.f, 0.f};
        cur = nxt; cA = nA; cB = nB; ++ui;
        if constexpr (ALIGN_EPI) { if (wr == 1) PG8_BAR; }
    }
    PG8_WAIT_V(0);
    if constexpr (!ALIGN_EPI) { if (wr == 0) PG8_BAR; }
    PG8_BAR;
    if constexpr (Epi::AFTER_DRAIN) { E.fused(acc, cur, wr, wc, fr, fq, lds, wid, lane); S.done(cur); }
#undef PG8_SA
#undef PG8_SB
#undef PG8_STAGE
#undef PG8_LDA
#undef PG8_LDB
#undef PG8_MMA
#undef PG8_WAIT_V
#undef PG8_WAIT_L
#undef PG8_BAR
#undef PG8_SCHED
}
}

typedef float f32x4 __attribute__((ext_vector_type(4)));
typedef unsigned u32x4 __attribute__((ext_vector_type(4)));
struct EpiIn {
    static constexpr bool PERM = true, AFTER_DRAIN = false;
    const float* ssq; bf16* ZY; bf16* P; float* DT;
    __device__ __forceinline__ void operator()(const f32x4 (&acc)[2][2][4][2], const pg8::Unit& u, int wr, int wc, int fr, int fq) const {
        const int row0 = u.pm * 256 + wr * 64 + fr, cin = wc * 32 + 8 * fq;
#pragma unroll
        for (int ai = 0; ai < 2; ++ai)
#pragma unroll
            for (int m = 0; m < 4; ++m) {
                const int row = row0 + ai * 128 + m * 16;
                const f32x4* sp = (const f32x4*)(ssq + (size_t)row * 16);
                const f32x4 s0 = sp[0], s1 = sp[1], s2 = sp[2], s3 = sp[3];
                const float s = ((s0[0] + s0[1]) + (s0[2] + s0[3])) + ((s1[0] + s1[1]) + (s1[2] + s1[3])) + ((s2[0] + s2[1]) + (s2[2] + s2[3])) + ((s3[0] + s3[1]) + (s3[2] + s3[3]));
                const float rstd = rsqrtf(s * (1.f / DM) + EPS);
                if (u.pn < 21) {
                    bf16* rowp = u.pn < 8 ? ZY + (size_t)row * ZYW + u.pn * 256 + cin : P + (size_t)row * PW + (u.pn - 8) * 256 + cin;
#pragma unroll
                    for (int bj = 0; bj < 2; ++bj) {
                        const f32x4 v0 = acc[ai][bj][m][0] * rstd, v1 = acc[ai][bj][m][1] * rstd;
                        u32x4 w; w.x = pg8::cvt_pk_bf16(v0[0], v0[1]); w.y = pg8::cvt_pk_bf16(v0[2], v0[3]); w.z = pg8::cvt_pk_bf16(v1[0], v1[1]); w.w = pg8::cvt_pk_bf16(v1[2], v1[3]);
                        *(u32x4*)(rowp + bj * 128) = w;
                    }
                } else if (cin < 16) {
                    *(f32x4*)(DT + (size_t)row * 16 + cin) = acc[ai][0][m][0] * rstd;
                    *(f32x4*)(DT + (size_t)row * 16 + cin + 4) = acc[ai][0][m][1] * rstd;
                }
            }
    }
};
struct EpiOut {
    static constexpr bool PERM = true, AFTER_DRAIN = false;
    const float* xold; float* xnew; bf16* XB; float* ssq;
    __device__ __forceinline__ void operator()(const f32x4 (&acc)[2][2][4][2], const pg8::Unit& u, int wr, int wc, int fr, int fq) const {
        const int row0 = u.pm * 256 + wr * 64 + fr, col0 = u.pn * 256 + wc * 32 + 8 * fq;
#pragma unroll
        for (int ai = 0; ai < 2; ++ai)
#pragma unroll
            for (int m = 0; m < 4; ++m) {
                const int row = row0 + ai * 128 + m * 16;
                float s = 0.f;
#pragma unroll
                for (int bj = 0; bj < 2; ++bj) {
                    const size_t off = (size_t)row * DM + col0 + bj * 128;
                    const f32x4 v0 = acc[ai][bj][m][0] + *(const f32x4*)(xold + off), v1 = acc[ai][bj][m][1] + *(const f32x4*)(xold + off + 4);
                    *(f32x4*)(xnew + off) = v0; *(f32x4*)(xnew + off + 4) = v1;
                    s += ((v0[0] * v0[0] + v0[1] * v0[1]) + (v0[2] * v0[2] + v0[3] * v0[3])) + ((v1[0] * v1[0] + v1[1] * v1[1]) + (v1[2] * v1[2] + v1[3] * v1[3]));
                    u32x4 w; w.x = pg8::cvt_pk_bf16(v0[0], v0[1]); w.y = pg8::cvt_pk_bf16(v0[2], v0[3]); w.z = pg8::cvt_pk_bf16(v1[0], v1[1]); w.w = pg8::cvt_pk_bf16(v1[2], v1[3]);
                    *(u32x4*)(XB + off) = w;
                }
                s += __shfl_xor(s, 16); s += __shfl_xor(s, 32);
                if (fq == 0) ssq[(size_t)row * 16 + u.pn * 4 + wc] = s;
            }
    }
};

constexpr int NTHR = 512, NWAVE = 8;
constexpr int LDS_BYTES = 147456;

struct Params { const float* in[16]; float* out; unsigned char* ws; };

__device__ __forceinline__ void conv_win_tile(const float* __restrict__ w_in, const float* __restrict__ norm_w, bf16* __restrict__ Win_t, int item, float* tile  ) {
    const int tid = opaque_tid(), l = item / (88 * 16), r = item % (88 * 16), n0 = (r % 88) * 64, k0 = (r / 88) * 64;
    const float* W = w_in + (size_t)l * DM * NIN;
    for (int e = tid; e < 64 * 64; e += NTHR) {
        const int kk = e >> 6, nn = e & 63, np = n0 + nn;
        float v = 0.f;
        if (np < NIN) v = W[(size_t)(k0 + kk) * NIN + src_col(np)] * norm_w[l * DM + k0 + kk];
        tile[kk * 65 + nn] = v;
    }
    __syncthreads();
    bf16* O = Win_t + (size_t)l * NINP * DM;
    for (int e = tid; e < 64 * 64; e += NTHR) {
        const int nn = e >> 6, kk = e & 63;
        O[(size_t)(n0 + nn) * DM + k0 + kk] = f2bf(tile[kk * 65 + nn]);
    }
    __syncthreads();
}
__device__ __forceinline__ void conv_wout_tile(const float* __restrict__ w_out, bf16* __restrict__ Wout_t, int item, float* tile) {
    const int tid = opaque_tid(), l = item / (16 * 32), r = item % (16 * 32), n0 = (r % 16) * 64, k0 = (r / 16) * 64;
    const float* W = w_out + (size_t)l * 2048 * DM;
    for (int e = tid; e < 64 * 64; e += NTHR) {
        const int kk = e >> 6, nn = e & 63;
        tile[kk * 65 + nn] = W[(size_t)(k0 + kk) * DM + n0 + nn];
    }
    __syncthreads();
    bf16* O = Wout_t + (size_t)l * DM * 2048;
    for (int e = tid; e < 64 * 64; e += NTHR) {
        const int nn = e >> 6, kk = e & 63;
        O[(size_t)(n0 + nn) * 2048 + k0 + kk] = f2bf(tile[kk * 65 + nn]);
    }
    __syncthreads();
}
__device__ __forceinline__ void normprep_row(const float* __restrict__ x, bf16* __restrict__ XB, float* __restrict__ SSQ, int row, int lane) {
    const float* xr = x + (size_t)row * DM;
    float s = 0.f;
#pragma unroll
    for (int j = 0; j < 16; ++j) { const float v = xr[j * 64 + lane]; s += v * v; XB[(size_t)row * DM + j * 64 + lane] = f2bf(v); }
    s = wave_sum(s);
    if (lane < 16) SSQ[row * 16 + lane] = lane == 0 ? s : 0.f;
}

struct SsdArgs { const bf16* P; bf16* ZY; const float* DT; float* SSQH; const float* conv_w; const float* conv_b; const float* dt_bias; const float* a_log; const float* dskip; };
__device__ __forceinline__ void ssd_naive_unit(const SsdArgs& a, int unit, float* sm) {
    constexpr int TT = 32;
    float* raw = sm;
    float* act = raw + (TT + 3) * 320;
    float* dts = act + TT * 320;
    float* decs = dts + TT;
    float* gq = decs + TT;
    const int b = unit >> 4, h = unit & 15, g = h >> 3, tid = opaque_tid(), lane = tid & 63, w = tid >> 6;
    const int p = w * 8 + (lane >> 3), ng = lane & 7;
    const float A = -__expf(a.a_log[h]), Dk = a.dskip[h], dtb = a.dt_bias[h];
    float S[16];
#pragma unroll
    for (int i = 0; i < 16; ++i) S[i] = 0.f;
    for (int t0 = 0; t0 < SEQ; t0 += TT) {
        for (int e = tid; e < (TT + 3) * 320; e += NTHR) {
            const int tt = e / 320, c = e % 320, t = t0 - 3 + tt;
            const int col = c < 64 ? (P_XS + h * 64 + c) : (c < 192 ? (P_B + g * 128 + (c - 64)) : (P_C + g * 128 + (c - 192)));
            raw[tt * 320 + c] = t >= 0 ? bf2f(a.P[((size_t)b * SEQ + t) * PW + col]) : 0.f;
        }
        if (tid < TT) {
            const float v = a.DT[((size_t)b * SEQ + t0 + tid) * 16 + h] + dtb;
            const float dt = v > 20.f ? v : log1pf(__expf(v));
            dts[tid] = dt; decs[tid] = __expf(dt * A);
        }
        __syncthreads();
        for (int e = tid; e < TT * 320; e += NTHR) {
            const int tt = e / 320, c = e % 320;
            const int col = c < 64 ? (P_XS + h * 64 + c) : (c < 192 ? (P_B + g * 128 + (c - 64)) : (P_C + g * 128 + (c - 192)));
            float v = a.conv_b[col];
#pragma unroll
            for (int k = 0; k < 4; ++k) v += a.conv_w[k * 1536 + col] * raw[(tt + k) * 320 + c];
            act[tt * 320 + c] = siluf(v);
        }
        __syncthreads();
        for (int tt = 0; tt < TT; ++tt) {
            const float* at = act + tt * 320;
            const float xv = at[p], xdt = xv * dts[tt], dec = decs[tt];
            float yp = 0.f;
#pragma unroll
            for (int i = 0; i < 16; ++i) {
                S[i] = dec * S[i] + xdt * at[64 + ng * 16 + i];
                yp += at[192 + ng * 16 + i] * S[i];
            }
            yp += __shfl_xor(yp, 1); yp += __shfl_xor(yp, 2); yp += __shfl_xor(yp, 4);
            if (ng == 0) {
                const float y = yp + Dk * xv;
                const size_t zi = ((size_t)b * SEQ + t0 + tt) * ZYW + h * 64 + p;
                const float z = bf2f(a.ZY[zi]);
                const float gg = y * siluf(z);
                a.ZY[zi] = f2bf(gg);
                gq[tt * 64 + p] = gg * gg;
            }
        }
        __syncthreads();
        if (tid < TT) { float s = 0.f; for (int i = 0; i < 64; ++i) s += gq[tid * 64 + i]; a.SSQH[((size_t)b * SEQ + t0 + tid) * 16 + h] = s; }
        __syncthreads();
    }
}
__device__ __forceinline__ void ssd_norm_row(bf16* __restrict__ ZY, const float* __restrict__ SSQH, const float* __restrict__ nw, int row, int lane) {
    float s0 = 0.f, s1 = 0.f;
#pragma unroll
    for (int i = 0; i < 8; ++i) { s0 += SSQH[row * 16 + i]; s1 += SSQH[row * 16 + 8 + i]; }
    const float r0 = rsqrtf(s0 * (1.f / 512.f) + EPS), r1 = rsqrtf(s1 * (1.f / 512.f) + EPS);
#pragma unroll
    for (int j = 0; j < 16; ++j) {
        const int c = j * 64 + lane;
        const size_t i = (size_t)row * ZYW + c;
        ZY[i] = f2bf(bf2f(ZY[i]) * (c < 512 ? r0 : r1) * nw[c]);
    }
}

struct AttnArgs { const bf16* P; bf16* ZY; const float* sinks; };
__device__ __forceinline__ void attn_naive_unit(const AttnArgs& a, int unit, float* sm) {
    float* Ks = sm;
    float* Vs = sm + 256 * 64;
    const int nb = unit & 15, g = (unit >> 4) & 1, b = unit >> 5, tid = opaque_tid();
    const int r = tid >> 7, qi = tid & 127;
    for (int e = tid; e < 256 * 64; e += NTHR) {
        const int kr = e >> 6, d = e & 63, t = (nb - 1) * 128 + kr;
        float kv = 0.f, vv = 0.f;
        if (t >= 0) { const size_t base = ((size_t)b * SEQ + t) * PW; kv = bf2f(a.P[base + P_K + g * 64 + d]); vv = bf2f(a.P[base + P_V + g * 64 + d]); }
        Ks[e] = kv; Vs[e] = vv;
    }
    __syncthreads();
    const int t = nb * 128 + qi;
    const size_t prow = ((size_t)b * SEQ + t) * PW;
    float q[64], o[64];
#pragma unroll
    for (int d = 0; d < 64; ++d) { q[d] = bf2f(a.P[prow + P_Q + g * 256 + r * 64 + d]) * 0.125f; o[d] = 0.f; }
    float mx = -1e30f, l = 0.f;
    const int jlo = (t - 127 < 0) ? 0 : t - 127;
    for (int tj = jlo; tj <= t; ++tj) {
        const int kr = tj - (nb - 1) * 128;
        const float* kp = Ks + kr * 64;
        float s = 0.f;
#pragma unroll
        for (int d = 0; d < 64; ++d) s += q[d] * kp[d];
        const float mn = fmaxf(mx, s), f = __expf(mx - mn), pe = __expf(s - mn);
        l = l * f + pe;
        const float* vp = Vs + kr * 64;
#pragma unroll
        for (int d = 0; d < 64; ++d) o[d] = o[d] * f + pe * vp[d];
        mx = mn;
    }
    const float sk = a.sinks[g * 4 + r];
    const float mn = fmaxf(mx, sk), f = __expf(mx - mn);
    l = l * f + __expf(sk - mn);
    const float inv = f / l;
    const size_t zrow = ((size_t)b * SEQ + t) * ZYW + 1024 + g * 256 + r * 64;
#pragma unroll
    for (int d = 0; d < 64; ++d) { const float z = bf2f(a.ZY[zrow + d]); a.ZY[zrow + d] = f2bf(o[d] * inv * siluf(z)); }
    __syncthreads();
}

struct ConfArgs { const bf16* P; bf16* ZY; const float* dw_w; const float* dw_b; const float* ln_w; const float* ln_b; };
__device__ __forceinline__ void conf_naive_unit(const ConfArgs& a, int unit, float* sm) {
    constexpr int TT = 16;
    float* glu = sm;
    float* outb = sm + (TT + 30) * 512;
    const int b = unit >> 7, t0 = (unit & 127) * TT, c = opaque_tid(), lane = c & 63, w = c >> 6;
    for (int tt = 0; tt < TT + 30; ++tt) {
        const int t = t0 - 30 + tt;
        float v = 0.f;
        if (t >= 0) { const size_t base = ((size_t)b * SEQ + t) * PW; v = bf2f(a.P[base + P_CA + c]) * sigmf(bf2f(a.P[base + P_CG + c])); }
        glu[tt * 512 + c] = v;
    }
    float wk[31];
#pragma unroll
    for (int k = 0; k < 31; ++k) wk[k] = a.dw_w[k * 512 + c];
    const float bias = a.dw_b[c];
    for (int tt = 0; tt < TT; ++tt) {
        float v = bias;
#pragma unroll
        for (int k = 0; k < 31; ++k) v += wk[k] * glu[(tt + k) * 512 + c];
        outb[tt * 512 + c] = v;
    }
    __syncthreads();
    for (int tt = w * 2; tt < w * 2 + 2; ++tt) {
        float v[8], s = 0.f;
#pragma unroll
        for (int j = 0; j < 8; ++j) { v[j] = outb[tt * 512 + j * 64 + lane]; s += v[j]; }
        const float mean = wave_sum(s) * (1.f / 512.f);
        float s2 = 0.f;
#pragma unroll
        for (int j = 0; j < 8; ++j) { v[j] -= mean; s2 += v[j] * v[j]; }
        const float rstd = rsqrtf(wave_sum(s2) * (1.f / 512.f) + EPS);
        const size_t zrow = ((size_t)b * SEQ + t0 + tt) * ZYW + 1536;
#pragma unroll
        for (int j = 0; j < 8; ++j) {
            const int ch = j * 64 + lane;
            const float y = siluf(v[j] * rstd * a.ln_w[ch] + a.ln_b[ch]);
            const float z = bf2f(a.ZY[zrow + ch]);
            a.ZY[zrow + ch] = f2bf(y * siluf(z));
        }
    }
    __syncthreads();
}

__device__ __forceinline__ void final_norm_row(float* __restrict__ out, const float* __restrict__ w, const float* __restrict__ SSQ, int row, int lane) {
    float* xr = out + (size_t)row * DM;
    float v[16];
#pragma unroll
    for (int j = 0; j < 16; ++j) v[j] = xr[j * 64 + lane];
    const float rstd = rsqrtf(wave_sum(lane < 16 ? SSQ[row * 16 + lane] : 0.f) * (1.f / DM) + EPS);
#pragma unroll
    for (int j = 0; j < 16; ++j) xr[j * 64 + lane] = v[j] * rstd * w[j * 64 + lane];
}

__global__ __launch_bounds__(NTHR, 2) void mega_fwd(Params p) {
    extern __shared__ __attribute__((aligned(16))) unsigned char lds[];
    cg::grid_group grid = cg::this_grid();
    float* sm = (float*)lds;
    const int bid = blockIdx.x, G = gridDim.x, NGW = G * NWAVE;
#define ROWLOOP(body) do { const int tid_ = opaque_tid(), lane = tid_ & 63, gw_ = bid * NWAVE + __builtin_amdgcn_readfirstlane(tid_ >> 6); for (int row = gw_; row < M; row += NGW) { body; } } while (0)
    const float* x = p.in[0];
    unsigned char* ws = p.ws;
    bf16* Win_t = (bf16*)(ws + WS_WIN); bf16* Wout_t = (bf16*)(ws + WS_WOUT);
    float* SSQ = (float*)(ws + WS_SSQ); float* SSQH = (float*)(ws + WS_SSQH); float* DT = (float*)(ws + WS_DT);
    bf16* XB = (bf16*)(ws + WS_XB); bf16* ZY = (bf16*)(ws + WS_ZY); bf16* P = (bf16*)(ws + WS_P);
    float* out = p.out;

    for (int it = bid; it < DEPTH * 88 * 16; it += G) conv_win_tile(p.in[2], p.in[1], Win_t, it, sm);
    for (int it = bid; it < DEPTH * 16 * 32; it += G) conv_wout_tile(p.in[14], Wout_t, it, sm);
    ROWLOOP(normprep_row(x, XB, SSQ, row, lane));
    grid.sync();

    for (int l = 0; l < DEPTH; ++l) {
        {
            pg8::Gemm g{XB, Win_t + (size_t)l * NINP * DM, M, NINP, DM}; pg8::StaticOrder S; S.init(M, NINP, G, bid);
            EpiIn E{SSQ, ZY, P, DT};
            pg8::gemm_phase<EpiIn, pg8::StaticOrder, true, true>((PG8_LAS unsigned char*)lds, g, S, E);
        }
        grid.sync();
        {
            SsdArgs sa{P, ZY, DT, SSQH, p.in[3] + l * 4 * 1536, p.in[4] + l * 1536, p.in[5] + l * 16, p.in[6] + l * 16, p.in[7] + l * 16};
            for (int u = bid; u < BATCH * 16; u += G) ssd_naive_unit(sa, u, sm);
            AttnArgs aa{P, ZY, p.in[9] + l * 8};
            for (int u = bid; u < BATCH * 2 * 16; u += G) attn_naive_unit(aa, u, sm);
            ConfArgs ca{P, ZY, p.in[10] + l * 31 * 512, p.in[11] + l * 512, p.in[12] + l * 512, p.in[13] + l * 512};
            for (int u = bid; u < BATCH * 128; u += G) conf_naive_unit(ca, u, sm);
        }
        grid.sync();
        ROWLOOP(ssd_norm_row(ZY, SSQH, p.in[8] + l * 1024, row, lane));
        grid.sync();
        {
            pg8::Gemm g{ZY, Wout_t + (size_t)l * DM * 2048, M, DM, 2048}; pg8::StaticOrder S; S.init(M, DM, G, bid);
            EpiOut E{l == 0 ? x : out, out, XB, SSQ};
            pg8::gemm_phase<EpiOut, pg8::StaticOrder, true, true>((PG8_LAS unsigned char*)lds, g, S, E);
        }
        grid.sync();
    }
    ROWLOOP(final_norm_row(out, p.in[15], SSQ, row, lane));
}

extern "C" void kernel_launch(void* const* d_in, const int* in_sizes, int n_in, void* d_out, int out_size, void* d_ws, size_t ws_size, hipStream_t stream) {
    static int grid_blocks = 0;
    if (grid_blocks == 0) {
        if (n_in != 16 || out_size != M * DM || ws_size < WS_END) { fprintf(stderr, "kernel_launch: unexpected shapes (n_in %d out %d ws %zu)\n", n_in, out_size, ws_size); grid_blocks = -1; return; }
        int dev = 0, cus = 0, per_cu = 0;
        (void)hipGetDevice(&dev);
        (void)hipDeviceGetAttribute(&cus, hipDeviceAttributeMultiprocessorCount, dev);
        (void)hipFuncSetAttribute((const void*)mega_fwd, hipFuncAttributeMaxDynamicSharedMemorySize, LDS_BYTES);
        (void)hipOccupancyMaxActiveBlocksPerMultiprocessor(&per_cu, (const void*)mega_fwd, NTHR, LDS_BYTES);
        if (per_cu < 1) { fprintf(stderr, "kernel_launch: occupancy query says %d blocks per CU\n", per_cu); per_cu = 1; }
        grid_blocks = cus * 1;
        fprintf(stderr, "kernel_launch: %d CUs, occupancy %d/CU, grid %d\n", cus, per_cu, grid_blocks);
    }
    if (grid_blocks < 0) return;
    Params p{};
    for (int i = 0; i < 16; ++i) p.in[i] = (const float*)d_in[i];
    p.out = (float*)d_out; p.ws = (unsigned char*)d_ws;
    void* args[] = {&p};
    hipError_t e = hipLaunchCooperativeKernel((const void*)mega_fwd, dim3(grid_blocks), dim3(NTHR), args, LDS_BYTES, stream);
    if (e != hipSuccess) fprintf(stderr, "cooperative launch failed: %s (grid %d)\n", hipGetErrorString(e), grid_blocks);
}
```

```cpp
#include <hip/hip_runtime.h>
#include <hip/hip_cooperative_groups.h>
namespace cg = cooperative_groups;
#include <cstdint>
#include <cstdio>

typedef unsigned short bf16;

constexpr int BATCH = 16, SEQ = 2048, DM = 1024, DEPTH = 2;
constexpr int M = BATCH * SEQ;
constexpr int NIN = 5392, NINP = 5632;
constexpr int ZYW = 2048;
constexpr int PW = 3328;
constexpr int P_XS = 0, P_B = 1024, P_C = 1280, P_Q = 1536, P_K = 2048, P_V = 2176, P_CA = 2304, P_CG = 2816;
constexpr float EPS = 1e-5f;

constexpr size_t MiB = 1u << 20;
constexpr size_t WS_CTL = 0;
constexpr size_t WS_WIN = 1 * MiB;
constexpr size_t WS_WOUT = 23 * MiB;
constexpr size_t WS_SSQ = 438 * MiB;
constexpr size_t WS_SSQH = 32 * MiB;
constexpr size_t WS_DT = 34 * MiB;
constexpr size_t WS_XB = 36 * MiB;
constexpr size_t WS_ZY = 100 * MiB;
constexpr size_t WS_P = 228 * MiB;
constexpr size_t WS_END = 440 * MiB;

__device__ __forceinline__ float bf2f(bf16 v) { return __uint_as_float(((unsigned)v) << 16); }
__device__ __forceinline__ bf16 f2bf(float f) { unsigned u = __float_as_uint(f); return (bf16)((u + 0x7fffu + ((u >> 16) & 1u)) >> 16); }
__device__ __forceinline__ float siluf(float v) { return v / (1.f + __expf(-v)); }
__device__ __forceinline__ float sigmf(float v) { return 1.f / (1.f + __expf(-v)); }
__device__ __forceinline__ float wave_sum(float v) {
#pragma unroll
    for (int o = 1; o < 64; o <<= 1) v += __shfl_xor(v, o);
    return v;
}
__device__ __forceinline__ int opaque_tid() { int t = threadIdx.x; asm volatile("" : "+v"(t)); return t; }
__host__ __device__ __forceinline__ int src_col(int np) { return np < 3584 ? np : (np < 5376 ? np + 16 : np - 1792); }

namespace pg8 {
#define PG8_LAS __attribute__((address_space(3)))
typedef unsigned short bf16_t;
typedef short bf16x8 __attribute__((ext_vector_type(8)));
typedef float f32x4 __attribute__((ext_vector_type(4)));
typedef unsigned u32x4 __attribute__((ext_vector_type(4)));
constexpr int BM = 256, BK = 64, HALF = 128, HTB = HALF * BK * 2  , STAGE_BYTES = 8 * HTB, NXCD = 8, WGM = 8;

__host__ __device__ __forceinline__ int lds_byte(int r, int c) { const int st = (r >> 4) * 2 + (c >> 5), rr = r & 15, cc = c & 31, ob = rr * 64 + cc * 2; return st * 1024 + (ob ^ (((ob >> 9) & 1) << 5)); }
__host__ __device__ __forceinline__ void stage_rc(int b, int& R, int& C) { const int st = b / 1024, sb = b % 1024, swz = sb ^ (((sb >> 9) & 1) << 5); R = (st >> 1) * 16 + swz / 64; C = (st & 1) * 32 + (swz % 64) / 2; }
__host__ __device__ __forceinline__ int perm32(int rho) { const int n = rho >> 4, i = rho & 15; return 8 * (i >> 2) + 4 * n + (i & 3); }

struct Unit { int pm, pn; };
struct Gemm { const bf16_t* A; const bf16_t* Bt; int M, N, K; };

struct StaticOrder {
    int nM, nN, nwg, G, c;
    __host__ __device__ void init(int M, int N, int G_, int c_) { nM = M / BM; nN = N / BM; nwg = nM * nN; G = G_; c = c_; }
    __host__ __device__ bool next(int i, Unit& u) const {
        const long L = (long)i * G + c; if (L >= nwg) return false;
        int wgid = (int)L; { const int q = nwg / NXCD, r = nwg % NXCD, xcd = wgid % NXCD, off = wgid / NXCD; wgid = (xcd < r ? xcd * (q + 1) : r * (q + 1) + (xcd - r) * q) + off; }
        const int nig = WGM * nN, gid = wgid / nig, fm = gid * WGM, gsz = (nM - fm) < WGM ? (nM - fm) : WGM;
        u.pm = fm + ((wgid % nig) % gsz); u.pn = (wgid % nig) / gsz; return true;
    }
    __device__ __forceinline__ void a_ready(const Unit&) const {}
    __device__ __forceinline__ void done(const Unit&) const {}
};

__device__ __forceinline__ unsigned cvt_pk_bf16(float lo, float hi) { unsigned r; asm volatile("v_cvt_pk_bf16_f32 %0, %1, %2" : "=v"(r) : "v"(lo), "v"(hi)); return r; }
template <class Epi, class Sched, bool ALIGN_EPI = false, bool SP2 = false>
__device__ __forceinline__ void gemm_phase(PG8_LAS unsigned char* lds, const Gemm g, const Sched& S, const Epi& E) {
    const int tid = opaque_tid(), wid = __builtin_amdgcn_readfirstlane(tid >> 6), lane = tid & 63, wr = wid >> 2, wc = wid & 3, fr = lane & 15, fq = lane >> 4;
    const int K = g.K, nt = K / BK;
    unsigned voffA[2], voffB[2];
#pragma unroll
    for (int i = 0; i < 2; ++i) { int R, C; stage_rc(tid * 16 + i * 8192, R, C); const int Rb = Epi::PERM ? ((R & ~31) + perm32(R & 31)) : R;
        voffA[i] = (unsigned)(R * K + C) * 2u; voffB[i] = (unsigned)(Rb * K + C) * 2u; }
    const size_t kstep = (size_t)(BK * 2);
    const size_t hstep = (size_t)HALF * K * 2;
    const size_t tstep = 2 * hstep;
    const unsigned ldsw = (unsigned)wid * 1024u;
    const int aoff = lds_byte(wr * 64 + fr, fq * 8), boff = lds_byte(wc * 32 + fr, fq * 8);
#define PG8_SA(b, h) (((b) * 2 + (h)) * HTB)
#define PG8_SB(b, h) ((4 + (b) * 2 + (h)) * HTB)
#define PG8_STAGE(bufoff, gbase, voff) do { _Pragma("unroll") for (int _i = 0; _i < 2; ++_i) \
        __builtin_amdgcn_global_load_lds((const unsigned*)((const char*)(gbase) + (voff)[_i]), (PG8_LAS unsigned*)(lds + (bufoff) + ldsw + _i * 8192), 16, 0, 0); } while (0)
#define PG8_LDA(dst, b, h) do { _Pragma("unroll") for (int m = 0; m < 4; ++m) _Pragma("unroll") for (int k = 0; k < 2; ++k) dst[m][k] = *(const PG8_LAS bf16x8*)(lds + PG8_SA(b, h) + aoff + m * 2048 + k * 1024); } while (0)
#define PG8_LDB(dst, b, h) do { _Pragma("unroll") for (int n = 0; n < 2; ++n) _Pragma("unroll") for (int k = 0; k < 2; ++k) dst[n][k] = *(const PG8_LAS bf16x8*)(lds + PG8_SB(b, h) + boff + n * 2048 + k * 1024); } while (0)
#define PG8_MMA(ai, bj, At, Bt) do { __builtin_amdgcn_s_setprio(1); _Pragma("unroll") for (int m = 0; m < 4; ++m) _Pragma("unroll") for (int n = 0; n < 2; ++n) _Pragma("unroll") for (int k = 0; k < 2; ++k) \
        acc[ai][bj][m][n] = __builtin_amdgcn_mfma_f32_16x16x32_bf16(Bt[n][k], At[m][k], acc[ai][bj][m][n], 0, 0, 0); __builtin_amdgcn_s_setprio(0); } while (0)
#define PG8_WAIT_V(n) asm volatile("s_waitcnt vmcnt(" #n ")" ::: "memory")
#define PG8_WAIT_L(n) asm volatile("s_waitcnt lgkmcnt(" #n ")" ::: "memory")
#define PG8_BAR __builtin_amdgcn_s_barrier()
#define PG8_SCHED __builtin_amdgcn_sched_barrier(0)
    Unit cur, nxt; int ui = 0;
    if (!S.next(0, cur)) return;
    f32x4 acc[2][2][4][2];
#pragma unroll
    for (int a = 0; a < 2; ++a)
#pragma unroll
        for (int b = 0; b < 2; ++b)
#pragma unroll
            for (int m = 0; m < 4; ++m)
#pragma unroll
                for (int n = 0; n < 2; ++n) acc[a][b][m][n] = (f32x4){0.f, 0.f, 0.f, 0.f};
    bf16x8 At[4][2], B0[2][2], B1[2][2];
    const char* cA = (const char*)g.A + (size_t)cur.pm * tstep; const char* cB = (const char*)g.Bt + (size_t)cur.pn * tstep;
    S.a_ready(cur);
    if constexpr (SP2) {
        PG8_STAGE(PG8_SB(0, 0), cB, voffB); PG8_STAGE(PG8_SB(0, 1), cB + hstep, voffB); PG8_STAGE(PG8_SA(0, 0), cA, voffA); PG8_STAGE(PG8_SA(0, 1), cA + hstep, voffA);
        if (wr == 1) PG8_BAR;
        PG8_WAIT_V(2); PG8_BAR;
        PG8_STAGE(PG8_SB(1, 0), cB + kstep, voffB); PG8_STAGE(PG8_SA(1, 0), cA + kstep, voffA); PG8_STAGE(PG8_SB(1, 1), cB + hstep + kstep, voffB);
        PG8_WAIT_V(6); PG8_BAR;
    } else {
        PG8_STAGE(PG8_SB(0, 0), cB, voffB); PG8_STAGE(PG8_SA(0, 0), cA, voffA); PG8_STAGE(PG8_SB(0, 1), cB + hstep, voffB); PG8_STAGE(PG8_SA(0, 1), cA + hstep, voffA);
        if (wr == 1) PG8_BAR;
        PG8_WAIT_V(4); PG8_BAR;
        PG8_STAGE(PG8_SB(1, 0), cB + kstep, voffB); PG8_STAGE(PG8_SA(1, 0), cA + kstep, voffA); PG8_STAGE(PG8_SB(1, 1), cB + hstep + kstep, voffB);
        PG8_WAIT_V(6); PG8_BAR;
    }
    for (;;) {
        const bool has_next = S.next(ui + 1, nxt);
        const char* nA = has_next ? (const char*)g.A + (size_t)nxt.pm * tstep : cA; const char* nB = has_next ? (const char*)g.Bt + (size_t)nxt.pn * tstep : cB;
        for (int t = 0; t < nt; t += 2) {
            const bool last = (t == nt - 2);
            const char* a1 = cA + (size_t)(t + 1) * kstep;
            const char* a2 = last ? nA : cA + (size_t)(t + 2) * kstep; const char* b2 = last ? nB : cB + (size_t)(t + 2) * kstep;
            const char* a3 = a2 + kstep; const char* b3 = b2 + kstep;
            if (last && has_next) S.a_ready(nxt);
            if constexpr (SP2) {
            PG8_LDB(B0, 0, 0); PG8_LDB(B1, 0, 1); PG8_SCHED; PG8_LDA(At, 0, 0); PG8_STAGE(PG8_SA(1, 1), a1 + hstep, voffA);
            PG8_WAIT_V(8); PG8_WAIT_L(0); PG8_BAR; PG8_MMA(0, 0, At, B0); PG8_MMA(0, 1, At, B1); PG8_BAR; PG8_SCHED;
            PG8_LDA(At, 0, 1); PG8_STAGE(PG8_SB(0, 0), b2, voffB); PG8_STAGE(PG8_SB(0, 1), b2 + hstep, voffB); PG8_STAGE(PG8_SA(0, 0), a2, voffA);
            PG8_WAIT_V(8); PG8_WAIT_L(0); PG8_BAR; PG8_MMA(1, 0, At, B0); PG8_MMA(1, 1, At, B1); PG8_BAR; PG8_SCHED;
            PG8_LDB(B0, 1, 0); PG8_LDB(B1, 1, 1); PG8_SCHED; PG8_LDA(At, 1, 0); PG8_STAGE(PG8_SA(0, 1), a2 + hstep, voffA);
            PG8_WAIT_V(8); PG8_WAIT_L(0); PG8_BAR; PG8_MMA(0, 0, At, B0); PG8_MMA(0, 1, At, B1); PG8_BAR; PG8_SCHED;
            PG8_LDA(At, 1, 1); PG8_STAGE(PG8_SB(1, 0), b3, voffB); PG8_STAGE(PG8_SB(1, 1), b3 + hstep, voffB); PG8_STAGE(PG8_SA(1, 0), a3, voffA);
            PG8_WAIT_V(8); PG8_WAIT_L(0); PG8_BAR; PG8_MMA(1, 0, At, B0); PG8_MMA(1, 1, At, B1); PG8_BAR; PG8_SCHED;
            } else {
            PG8_LDB(B0, 0, 0); PG8_SCHED; PG8_LDA(At, 0, 0); PG8_STAGE(PG8_SA(1, 1), a1 + hstep, voffA);
            PG8_WAIT_L(8); PG8_BAR; PG8_WAIT_L(0); PG8_MMA(0, 0, At, B0); PG8_BAR; PG8_SCHED;
            PG8_LDB(B1, 0, 1); PG8_STAGE(PG8_SB(0, 0), b2, voffB);
            PG8_BAR; PG8_WAIT_L(0); PG8_MMA(0, 1, At, B1); PG8_BAR;
            PG8_LDA(At, 0, 1); PG8_STAGE(PG8_SA(0, 0), a2, voffA);
            PG8_BAR; PG8_WAIT_L(0); PG8_MMA(1, 0, At, B0); PG8_BAR; PG8_SCHED;
            PG8_STAGE(PG8_SB(0, 1), b2 + hstep, voffB);
            PG8_WAIT_V(6); PG8_BAR; PG8_MMA(1, 1, At, B1); PG8_BAR;
            PG8_LDB(B0, 1, 0); PG8_SCHED; PG8_LDA(At, 1, 0); PG8_STAGE(PG8_SA(0, 1), a2 + hstep, voffA);
            PG8_WAIT_L(8); PG8_BAR; PG8_WAIT_L(0); PG8_MMA(0, 0, At, B0); PG8_BAR; PG8_SCHED;
            PG8_LDB(B1, 1, 1); PG8_STAGE(PG8_SB(1, 0), b3, voffB);
            PG8_BAR; PG8_WAIT_L(0); PG8_MMA(0, 1, At, B1); PG8_BAR;
            PG8_LDA(At, 1, 1); PG8_STAGE(PG8_SA(1, 0), a3, voffA);
            PG8_BAR; PG8_WAIT_L(0); PG8_MMA(1, 0, At, B0); PG8_BAR; PG8_SCHED;
            PG8_STAGE(PG8_SB(1, 1), b3 + hstep, voffB);
            PG8_WAIT_V(6); PG8_BAR; PG8_MMA(1, 1, At, B1); PG8_BAR;
            }
        }
        if constexpr (ALIGN_EPI) { if (wr == 0) PG8_BAR; }
        if constexpr (!Epi::AFTER_DRAIN) { E(acc, cur, wr, wc, fr, fq); S.done(cur); }
        if (!has_next) break;
#pragma unroll
        for (int a = 0; a < 2; ++a)
#pragma unroll
            for (int b = 0; b < 2; ++b)
#pragma unroll
                for (int m = 0; m < 4; ++m)
#pragma unroll
                    for (int n = 0; n < 2; ++n) acc[a][b][m][n] = (f32x4){0.f, 0.f, 0.f, 0.f};
        cur = nxt; cA = nA; cB = nB; ++ui;
        if constexpr (ALIGN_EPI) { if (wr == 1) PG8_BAR; }
    }
    PG8_WAIT_V(0);
    if constexpr (!ALIGN_EPI) { if (wr == 0) PG8_BAR; }
    PG8_BAR;
    if constexpr (Epi::AFTER_DRAIN) { E.fused(acc, cur, wr, wc, fr, fq, lds, wid, lane); S.done(cur); }
#undef PG8_SA
#undef PG8_SB
#undef PG8_STAGE
#undef PG8_LDA
#undef PG8_LDB
#undef PG8_MMA
#undef PG8_WAIT_V
#undef PG8_WAIT_L
#undef PG8_BAR
#undef PG8_SCHED
}
}

typedef float f32x4 __attribute__((ext_vector_type(4)));
typedef unsigned u32x4 __attribute__((ext_vector_type(4)));
struct EpiIn {
    static constexpr bool PERM = true, AFTER_DRAIN = false;
    const float* ssq; bf16* ZY; bf16* P; float* DT;
    __device__ __forceinline__ void operator()(const f32x4 (&acc)[2][2][4][2], const pg8::Unit& u, int wr, int wc, int fr, int fq) const {
        const int row0 = u.pm * 256 + wr * 64 + fr, cin = wc * 32 + 8 * fq;
#pragma unroll
        for (int ai = 0; ai < 2; ++ai)
#pragma unroll
            for (int m = 0; m < 4; ++m) {
                const int row = row0 + ai * 128 + m * 16;
                const f32x4* sp = (const f32x4*)(ssq + (size_t)row * 16);
                const f32x4 s0 = sp[0], s1 = sp[1], s2 = sp[2], s3 = sp[3];
                const float s = ((s0[0] + s0[1]) + (s0[2] + s0[3])) + ((s1[0] + s1[1]) + (s1[2] + s1[3])) + ((s2[0] + s2[1]) + (s2[2] + s2[3])) + ((s3[0] + s3[1]) + (s3[2] + s3[3]));
                const float rstd = rsqrtf(s * (1.f / DM) + EPS);
                if (u.pn < 21) {
                    bf16* rowp = u.pn < 8 ? ZY + (size_t)row * ZYW + u.pn * 256 + cin : P + (size_t)row * PW + (u.pn - 8) * 256 + cin;
#pragma unroll
                    for (int bj = 0; bj < 2; ++bj) {
                        const f32x4 v0 = acc[ai][bj][m][0] * rstd, v1 = acc[ai][bj][m][1] * rstd;
                        u32x4 w; w.x = pg8::cvt_pk_bf16(v0[0], v0[1]); w.y = pg8::cvt_pk_bf16(v0[2], v0[3]); w.z = pg8::cvt_pk_bf16(v1[0], v1[1]); w.w = pg8::cvt_pk_bf16(v1[2], v1[3]);
                        *(u32x4*)(rowp + bj * 128) = w;
                    }
                } else if (cin < 16) {
                    *(f32x4*)(DT + (size_t)row * 16 + cin) = acc[ai][0][m][0] * rstd;
                    *(f32x4*)(DT + (size_t)row * 16 + cin + 4) = acc[ai][0][m][1] * rstd;
                }
            }
    }
};
struct EpiOut {
    static constexpr bool PERM = true, AFTER_DRAIN = false;
    const float* xold; float* xnew; bf16* XB; float* ssq;
    __device__ __forceinline__ void operator()(const f32x4 (&acc)[2][2][4][2], const pg8::Unit& u, int wr, int wc, int fr, int fq) const {
        const int row0 = u.pm * 256 + wr * 64 + fr, col0 = u.pn * 256 + wc * 32 + 8 * fq;
#pragma unroll
        for (int ai = 0; ai < 2; ++ai)
#pragma unroll
            for (int m = 0; m < 4; ++m) {
                const int row = row0 + ai * 128 + m * 16;
                float s = 0.f;
#pragma unroll
                for (int bj = 0; bj < 2; ++bj) {
                    const size_t off = (size_t)row * DM + col0 + bj * 128;
                    const f32x4 v0 = acc[ai][bj][m][0] + *(const f32x4*)(xold + off), v1 = acc[ai][bj][m][1] + *(const f32x4*)(xold + off + 4);
                    *(f32x4*)(xnew + off) = v0; *(f32x4*)(xnew + off + 4) = v1;
                    s += ((v0[0] * v0[0] + v0[1] * v0[1]) + (v0[2] * v0[2] + v0[3] * v0[3])) + ((v1[0] * v1[0] + v1[1] * v1[1]) + (v1[2] * v1[2] + v1[3] * v1[3]));
                    u32x4 w; w.x = pg8::cvt_pk_bf16(v0[0], v0[1]); w.y = pg8::cvt_pk_bf16(v0[2], v0[3]); w.z = pg8::cvt_pk_bf16(v1[0], v1[1]); w.w = pg8::cvt_pk_bf16(v1[2], v1[3]);
                    *(u32x4*)(XB + off) = w;
                }
                s += __shfl_xor(s, 16); s += __shfl_xor(s, 32);
                if (fq == 0) ssq[(size_t)row * 16 + u.pn * 4 + wc] = s;
            }
    }
};

constexpr int NTHR = 512, NWAVE = 8;
constexpr int LDS_BYTES = 147456;

struct Params { const float* in[16]; float* out; unsigned char* ws; };

__device__ __forceinline__ void conv_win_tile(const float* __restrict__ w_in, const float* __restrict__ norm_w, bf16* __restrict__ Win_t, int item, float* tile  ) {
    const int tid = opaque_tid(), l = item / (88 * 16), r = item % (88 * 16), n0 = (r % 88) * 64, k0 = (r / 88) * 64;
    const float* W = w_in + (size_t)l * DM * NIN;
    for (int e = tid; e < 64 * 64; e += NTHR) {
        const int kk = e >> 6, nn = e & 63, np = n0 + nn;
        float v = 0.f;
        if (np < NIN) v = W[(size_t)(k0 + kk) * NIN + src_col(np)] * norm_w[l * DM + k0 + kk];
        tile[kk * 65 + nn] = v;
    }
    __syncthreads();
    bf16* O = Win_t + (size_t)l * NINP * DM;
    for (int e = tid; e < 64 * 64; e += NTHR) {
        const int nn = e >> 6, kk = e & 63;
        O[(size_t)(n0 + nn) * DM + k0 + kk] = f2bf(tile[kk * 65 + nn]);
    }
    __syncthreads();
}
__device__ __forceinline__ void conv_wout_tile(const float* __restrict__ w_out, bf16* __restrict__ Wout_t, int item, float* tile) {
    const int tid = opaque_tid(), l = item / (16 * 32), r = item % (16 * 32), n0 = (r % 16) * 64, k0 = (r / 16) * 64;
    const float* W = w_out + (size_t)l * 2048 * DM;
    for (int e = tid; e < 64 * 64; e += NTHR) {
        const int kk = e >> 6, nn = e & 63;
        tile[kk * 65 + nn] = W[(size_t)(k0 + kk) * DM + n0 + nn];
    }
    __syncthreads();
    bf16* O = Wout_t + (size_t)l * DM * 2048;
    for (int e = tid; e < 64 * 64; e += NTHR) {
        const int nn = e >> 6, kk = e & 63;
        O[(size_t)(n0 + nn) * 2048 + k0 + kk] = f2bf(tile[kk * 65 + nn]);
    }
    __syncthreads();
}
__device__ __forceinline__ void normprep_row(const float* __restrict__ x, bf16* __restrict__ XB, float* __restrict__ SSQ, int row, int lane) {
    const float* xr = x + (size_t)row * DM;
    float s = 0.f;
#pragma unroll
    for (int j = 0; j < 16; ++j) { const float v = xr[j * 64 + lane]; s += v * v; XB[(size_t)row * DM + j * 64 + lane] = f2bf(v); }
    s = wave_sum(s);
    if (lane < 16) SSQ[row * 16 + lane] = lane == 0 ? s : 0.f;
}

struct SsdArgs { const bf16* P; bf16* ZY; const float* DT; float* SSQH; const float* conv_w; const float* conv_b; const float* dt_bias; const float* a_log; const float* dskip; };
__device__ __forceinline__ void ssd_naive_unit(const SsdArgs& a, int unit, float* sm) {
    constexpr int TT = 32;
    float* raw = sm;
    float* act = raw + (TT + 3) * 320;
    float* dts = act + TT * 320;
    float* decs = dts + TT;
    float* gq = decs + TT;
    const int b = unit >> 4, h = unit & 15, g = h >> 3, tid = opaque_tid(), lane = tid & 63, w = tid >> 6;
    const int p = w * 8 + (lane >> 3), ng = lane & 7;
    const float A = -__expf(a.a_log[h]), Dk = a.dskip[h], dtb = a.dt_bias[h];
    float S[16];
#pragma unroll
    for (int i = 0; i < 16; ++i) S[i] = 0.f;
    for (int t0 = 0; t0 < SEQ; t0 += TT) {
        for (int e = tid; e < (TT + 3) * 320; e += NTHR) {
            const int tt = e / 320, c = e % 320, t = t0 - 3 + tt;
            const int col = c < 64 ? (P_XS + h * 64 + c) : (c < 192 ? (P_B + g * 128 + (c - 64)) : (P_C + g * 128 + (c - 192)));
            raw[tt * 320 + c] = t >= 0 ? bf2f(a.P[((size_t)b * SEQ + t) * PW + col]) : 0.f;
        }
        if (tid < TT) {
            const float v = a.DT[((size_t)b * SEQ + t0 + tid) * 16 + h] + dtb;
            const float dt = v > 20.f ? v : log1pf(__expf(v));
            dts[tid] = dt; decs[tid] = __expf(dt * A);
        }
        __syncthreads();
        for (int e = tid; e < TT * 320; e += NTHR) {
            const int tt = e / 320, c = e % 320;
            const int col = c < 64 ? (P_XS + h * 64 + c) : (c < 192 ? (P_B + g * 128 + (c - 64)) : (P_C + g * 128 + (c - 192)));
            float v = a.conv_b[col];
#pragma unroll
            for (int k = 0; k < 4; ++k) v += a.conv_w[k * 1536 + col] * raw[(tt + k) * 320 + c];
            act[tt * 320 + c] = siluf(v);
        }
        __syncthreads();
        for (int tt = 0; tt < TT; ++tt) {
            const float* at = act + tt * 320;
            const float xv = at[p], xdt = xv * dts[tt], dec = decs[tt];
            float yp = 0.f;
#pragma unroll
            for (int i = 0; i < 16; ++i) {
                S[i] = dec * S[i] + xdt * at[64 + ng * 16 + i];
                yp += at[192 + ng * 16 + i] * S[i];
            }
            yp += __shfl_xor(yp, 1); yp += __shfl_xor(yp, 2); yp += __shfl_xor(yp, 4);
            if (ng == 0) {
                const float y = yp + Dk * xv;
                const size_t zi = ((size_t)b * SEQ + t0 + tt) * ZYW + h * 64 + p;
                const float z = bf2f(a.ZY[zi]);
                const float gg = y * siluf(z);
                a.ZY[zi] = f2bf(gg);
                gq[tt * 64 + p] = gg * gg;
            }
        }
        __syncthreads();
        if (tid < TT) { float s = 0.f; for (int i = 0; i < 64; ++i) s += gq[tid * 64 + i]; a.SSQH[((size_t)b * SEQ + t0 + tid) * 16 + h] = s; }
        __syncthreads();
    }
}
__device__ __forceinline__ void ssd_norm_row(bf16* __restrict__ ZY, const float* __restrict__ SSQH, const float* __restrict__ nw, int row, int lane) {
    float v[16], s0 = 0.f, s1 = 0.f;
#pragma unroll
    for (int j = 0; j < 16; ++j) { v[j] = bf2f(ZY[(size_t)row * ZYW + j * 64 + lane]); if (j < 8) s0 += v[j] * v[j]; else s1 += v[j] * v[j]; }
    s0 = wave_sum(s0); s1 = wave_sum(s1);
    const float r0 = rsqrtf(s0 * (1.f / 512.f) + EPS), r1 = rsqrtf(s1 * (1.f / 512.f) + EPS);
#pragma unroll
    for (int j = 0; j < 16; ++j) { const int c = j * 64 + lane; ZY[(size_t)row * ZYW + c] = f2bf(v[j] * (j < 8 ? r0 : r1) * nw[c]); }
}

struct AttnArgs { const bf16* P; bf16* ZY; const float* sinks; };
__device__ __forceinline__ void attn_naive_unit(const AttnArgs& a, int unit, float* sm, bf16* yref) {
    float* Ks = sm;
    float* Vs = sm + 256 * 64;
    const int nb = unit & 15, g = (unit >> 4) & 1, b = unit >> 5, tid = opaque_tid();
    const int r = tid >> 7, qi = tid & 127;
    for (int e = tid; e < 256 * 64; e += NTHR) {
        const int kr = e >> 6, d = e & 63, t = (nb - 1) * 128 + kr;
        float kv = 0.f, vv = 0.f;
        if (t >= 0) { const size_t base = ((size_t)b * SEQ + t) * PW; kv = bf2f(a.P[base + P_K + g * 64 + d]); vv = bf2f(a.P[base + P_V + g * 64 + d]); }
        Ks[e] = kv; Vs[e] = vv;
    }
    __syncthreads();
    const int t = nb * 128 + qi;
    const size_t prow = ((size_t)b * SEQ + t) * PW;
    float q[64], o[64];
#pragma unroll
    for (int d = 0; d < 64; ++d) { q[d] = bf2f(a.P[prow + P_Q + g * 256 + r * 64 + d]) * 0.125f; o[d] = 0.f; }
    float mx = -1e30f, l = 0.f;
    const int jlo = (t - 127 < 0) ? 0 : t - 127;
    for (int tj = jlo; tj <= t; ++tj) {
        const int kr = tj - (nb - 1) * 128;
        const float* kp = Ks + kr * 64;
        float s = 0.f;
#pragma unroll
        for (int d = 0; d < 64; ++d) s += q[d] * kp[d];
        const float mn = fmaxf(mx, s), f = __expf(mx - mn), pe = __expf(s - mn);
        l = l * f + pe;
        const float* vp = Vs + kr * 64;
#pragma unroll
        for (int d = 0; d < 64; ++d) o[d] = o[d] * f + pe * vp[d];
        mx = mn;
    }
    const float sk = a.sinks[g * 4 + r];
    const float mn = fmaxf(mx, sk), f = __expf(mx - mn);
    l = l * f + __expf(sk - mn);
    const float inv = f / l;
    const size_t zrow = ((size_t)b * SEQ + t) * ZYW + 1024 + g * 256 + r * 64;
#pragma unroll
    for (int d = 0; d < 64; ++d) { const float z = bf2f(a.ZY[zrow + d]); yref[((size_t)b * SEQ + t) * 512 + g * 256 + r * 64 + d] = f2bf(o[d] * inv * siluf(z)); }
    __syncthreads();
}


typedef short bf16x8 __attribute__((ext_vector_type(8)));
typedef short s16x4 __attribute__((ext_vector_type(4)));
typedef float f32x16 __attribute__((ext_vector_type(16)));
#define LAS __attribute__((address_space(3)))
__device__ __forceinline__ int crow(int r, int hi) { return (r & 3) + 8 * (r >> 2) + 4 * hi; }
constexpr int AT_KP = 144, AT_VP = 520;
constexpr int AT_K = 0, AT_V = 256 * AT_KP, AT_W = AT_V + 64 * AT_VP;
__device__ __forceinline__ void attn_unit(const AttnArgs& a, int unit, LAS unsigned char* lds) {
    const int tid = opaque_tid(), lane = tid & 63, wid = __builtin_amdgcn_readfirstlane(tid >> 6), c32 = lane & 31, hi = lane >> 5;
    const int nb = unit & 15, g = (unit >> 4) & 1, b = unit >> 5;
    for (int e = tid; e < 2048; e += NTHR) {
        const int key = e >> 3, ch = e & 7, t = (nb - 1) * 128 + key;
        u32x4 kv = {0u, 0u, 0u, 0u}, vv = {0u, 0u, 0u, 0u};
        if (t >= 0) { const bf16* base = a.P + ((size_t)b * SEQ + t) * PW; kv = *(const u32x4*)(base + P_K + g * 64 + ch * 8); vv = *(const u32x4*)(base + P_V + g * 64 + ch * 8); }
        *(LAS u32x4*)(lds + AT_K + key * AT_KP + ch * 16) = kv;
#pragma unroll
        for (int i = 0; i < 4; ++i) {
            *(LAS unsigned short*)(lds + AT_V + (ch * 8 + 2 * i) * AT_VP + key * 2) = (unsigned short)(vv[i] & 0xffffu);
            *(LAS unsigned short*)(lds + AT_V + (ch * 8 + 2 * i + 1) * AT_VP + key * 2) = (unsigned short)(vv[i] >> 16);
        }
    }
    __syncthreads();
    LAS float* wsf = (LAS float*)(lds + AT_W) + wid * 32;
    const float C2 = 0.125f * 1.4426950408889634f, NEG = -1e30f;
#pragma unroll 1
    for (int gi2 = 0; gi2 < 2; ++gi2) {
        const int gi = wid + 8 * gi2, head = gi >> 2, qo = (gi & 3) * 32;
        const size_t tok0 = (size_t)b * SEQ + nb * 128 + qo;
        const bf16* qp = a.P + (tok0 + c32) * PW + P_Q + g * 256 + head * 64 + hi * 8;
        bf16x8 qf[4];
#pragma unroll
        for (int ks = 0; ks < 4; ++ks) qf[ks] = *(const bf16x8*)(qp + ks * 16);
        f32x16 S[5];
#pragma unroll
        for (int j = 0; j < 5; ++j) {
            f32x16 acc = {0.f, 0.f, 0.f, 0.f, 0.f, 0.f, 0.f, 0.f, 0.f, 0.f, 0.f, 0.f, 0.f, 0.f, 0.f, 0.f};
#pragma unroll
            for (int ks = 0; ks < 4; ++ks) {
                const bf16x8 kf = *(const LAS bf16x8*)(lds + AT_K + (qo + 32 * j + c32) * AT_KP + ks * 32 + hi * 16);
                acc = __builtin_amdgcn_mfma_f32_32x32x16_bf16(kf, qf[ks], acc, 0, 0, 0);
            }
            S[j] = acc;
        }
        float mx = NEG;
#pragma unroll
        for (int j = 0; j < 5; ++j) {
            const bool dead = (nb == 0) && (qo + 32 * j < 128);
#pragma unroll
            for (int r = 0; r < 16; ++r) {
                float v = S[j][r] * C2;
                const int kr = crow(r, hi);
                if (j == 0 && !(kr > c32)) v = NEG;
                if (j == 4 && !(kr <= c32)) v = NEG;
                if (dead) v = NEG;
                S[j][r] = v; mx = fmaxf(mx, v);
            }
        }
        mx = fmaxf(mx, __shfl_xor(mx, 32));
        const float sink2 = a.sinks[g * 4 + head] * 1.4426950408889634f;
        mx = fmaxf(mx, sink2);
        float l = 0.f;
#pragma unroll
        for (int j = 0; j < 5; ++j)
#pragma unroll
            for (int r = 0; r < 16; ++r) { const float pe = __builtin_amdgcn_exp2f(S[j][r] - mx); l += pe; S[j][r] = pe; }
        l += __shfl_xor(l, 32);
        l += __builtin_amdgcn_exp2f(sink2 - mx);
        if (hi == 0) wsf[c32] = 1.f / l;
        f32x16 o[2];
#pragma unroll
        for (int dh = 0; dh < 2; ++dh) o[dh] = (f32x16){0.f, 0.f, 0.f, 0.f, 0.f, 0.f, 0.f, 0.f, 0.f, 0.f, 0.f, 0.f, 0.f, 0.f, 0.f, 0.f};
#pragma unroll
        for (int j = 0; j < 5; ++j)
#pragma unroll
            for (int s2 = 0; s2 < 2; ++s2) {
                u32x4 pw;
                pw.x = pg8::cvt_pk_bf16(S[j][8 * s2 + 0], S[j][8 * s2 + 1]); pw.y = pg8::cvt_pk_bf16(S[j][8 * s2 + 2], S[j][8 * s2 + 3]);
                pw.z = pg8::cvt_pk_bf16(S[j][8 * s2 + 4], S[j][8 * s2 + 5]); pw.w = pg8::cvt_pk_bf16(S[j][8 * s2 + 6], S[j][8 * s2 + 7]);
                const bf16x8 pa = __builtin_bit_cast(bf16x8, pw);
#pragma unroll
                for (int dh = 0; dh < 2; ++dh) {
                    const LAS unsigned char* vp = lds + AT_V + (dh * 32 + c32) * AT_VP + (qo + 32 * j + 16 * s2 + 4 * hi) * 2;
                    const s16x4 v0 = *(const LAS s16x4*)vp, v1 = *(const LAS s16x4*)(vp + 16);
                    const bf16x8 vf = {v0[0], v0[1], v0[2], v0[3], v1[0], v1[1], v1[2], v1[3]};
                    o[dh] = __builtin_amdgcn_mfma_f32_32x32x16_bf16(pa, vf, o[dh], 0, 0, 0);
                }
            }
#pragma unroll
        for (int r = 0; r < 16; ++r) {
            const int qr = crow(r, hi);
            const float inv = wsf[qr];
            bf16* zp = a.ZY + (tok0 + qr) * ZYW + 1024 + g * 256 + head * 64 + c32;
#pragma unroll
            for (int dh = 0; dh < 2; ++dh) { const float z = bf2f(zp[dh * 32]); zp[dh * 32] = f2bf(o[dh][r] * inv * siluf(z)); }
        }
    }
    __syncthreads();
}


typedef short v4i16_t __attribute__((ext_vector_type(4)));
constexpr int SD_BP = 272, SD_XP = 144;
constexpr int SD_BM = 0, SD_CM = SD_BM + 128 * SD_BP, SD_XT = SD_CM + 128 * SD_BP, SD_SL = SD_XT + 64 * SD_BP, SD_XS = SD_SL + 64 * SD_BP, SD_F = SD_XS + 128 * SD_XP;
constexpr int SD_ACS = SD_F, SD_DTE = SD_F + 512, SD_CW = SD_F + 1024, SD_END = SD_CW + 5 * 320 * 4;
static_assert(SD_END <= LDS_BYTES, "SSD LDS map");
__device__ __forceinline__ float softplusf(float v) { return v > 20.f ? v : log1pf(__expf(v)); }
__device__ __forceinline__ float bflo(unsigned w) { return __uint_as_float(w << 16); }
__device__ __forceinline__ float bfhi(unsigned w) { return __uint_as_float(w & 0xffff0000u); }
__device__ __forceinline__ void ssd_unit(const SsdArgs& a, int unit, LAS unsigned char* lds) {
    const int tid = opaque_tid(), lane = tid & 63, wid = __builtin_amdgcn_readfirstlane(tid >> 6), c32 = lane & 31, hi = lane >> 5;
    const int b = unit >> 4, h = unit & 15, g = h >> 3;
    const float LOG2E = 1.4426950408889634f;
    const float A2 = -__expf(a.a_log[h]) * LOG2E, Dk = a.dskip[h], dtb = a.dt_bias[h];
    LAS float* acs2 = (LAS float*)(lds + SD_ACS);
    LAS float* dte = (LAS float*)(lds + SD_DTE);
    LAS float* cwl = (LAS float*)(lds + SD_CW);
    for (int e = tid; e < 5 * 320; e += NTHR) {
        const int k = e / 320, c = e - k * 320;
        const int col = c < 64 ? (P_XS + h * 64 + c) : (c < 192 ? (P_B + g * 128 + (c - 64)) : (P_C + g * 128 + (c - 192)));
        cwl[e] = k < 4 ? a.conv_w[k * 1536 + col] : a.conv_b[col];
    }
    for (int e = tid; e < 64 * SD_BP / 4; e += NTHR) ((LAS unsigned*)(lds + SD_SL))[e] = 0u;
    const int it = wid >> 1, ph = wid & 1, pt = wid >> 2, nt = wid & 3;
    f32x16 St = {0.f, 0.f, 0.f, 0.f, 0.f, 0.f, 0.f, 0.f, 0.f, 0.f, 0.f, 0.f, 0.f, 0.f, 0.f, 0.f};
    __syncthreads();
#pragma unroll 1
    for (int ch = 0; ch < SEQ / 128; ++ch) {
        const int t0 = ch * 128;
        const size_t row0 = (size_t)b * SEQ + t0;
#pragma unroll 1
        for (int item = tid; item < 1280; item += NTHR) {
            const int tg = item / 40, cc = item - tg * 40, j0 = tg * 4;
            const int col = cc < 8 ? (P_XS + h * 64 + cc * 8) : (cc < 24 ? (P_B + g * 128 + (cc - 8) * 8) : (P_C + g * 128 + (cc - 24) * 8));
            u32x4 raw[7];
#pragma unroll
            for (int k = 0; k < 7; ++k) {
                const int t = t0 + j0 - 3 + k;
                raw[k] = (u32x4){0u, 0u, 0u, 0u};
                if (t >= 0) raw[k] = *(const u32x4*)(a.P + ((size_t)b * SEQ + t) * PW + col);
            }
            float dtv[4] = {0.f, 0.f, 0.f, 0.f};
            if (cc < 8) {
#pragma unroll
                for (int tt = 0; tt < 4; ++tt) dtv[tt] = softplusf(a.DT[(row0 + j0 + tt) * 16 + h] + dtb);
            }
            u32x4 ob[4];
#pragma unroll
            for (int e2 = 0; e2 < 4; ++e2) {
                const int c0 = cc * 8 + 2 * e2;
                float w0[5], w1[5];
#pragma unroll
                for (int k = 0; k < 5; ++k) { w0[k] = cwl[k * 320 + c0]; w1[k] = cwl[k * 320 + c0 + 1]; }
                float x0[7], x1[7];
#pragma unroll
                for (int k = 0; k < 7; ++k) { x0[k] = bflo(raw[k][e2]); x1[k] = bfhi(raw[k][e2]); }
                float y0[4], y1[4];
#pragma unroll
                for (int tt = 0; tt < 4; ++tt) {
                    float v0 = w0[4], v1 = w1[4];
#pragma unroll
                    for (int k = 0; k < 4; ++k) { v0 += w0[k] * x0[tt + k]; v1 += w1[k] * x1[tt + k]; }
                    y0[tt] = siluf(v0); y1[tt] = siluf(v1);
                    ob[tt][e2] = pg8::cvt_pk_bf16(y0[tt], y1[tt]);
                }
                if (cc < 8) {
                    typedef unsigned u32x2 __attribute__((ext_vector_type(2)));
                    u32x2 q0, q1;
                    q0.x = pg8::cvt_pk_bf16(y0[0] * dtv[0], y0[1] * dtv[1]); q0.y = pg8::cvt_pk_bf16(y0[2] * dtv[2], y0[3] * dtv[3]);
                    q1.x = pg8::cvt_pk_bf16(y1[0] * dtv[0], y1[1] * dtv[1]); q1.y = pg8::cvt_pk_bf16(y1[2] * dtv[2], y1[3] * dtv[3]);
                    *(LAS u32x2*)(lds + SD_XT + c0 * SD_BP + j0 * 2) = q0;
                    *(LAS u32x2*)(lds + SD_XT + (c0 + 1) * SD_BP + j0 * 2) = q1;
                }
            }
            if (cc < 8) {
#pragma unroll
                for (int tt = 0; tt < 4; ++tt) *(LAS u32x4*)(lds + SD_XS + (j0 + tt) * SD_XP + cc * 16) = ob[tt];
            } else if (cc < 24) {
#pragma unroll
                for (int tt = 0; tt < 4; ++tt) *(LAS u32x4*)(lds + SD_BM + (j0 + tt) * SD_BP + (cc - 8) * 16) = ob[tt];
            } else {
#pragma unroll
                for (int tt = 0; tt < 4; ++tt) *(LAS u32x4*)(lds + SD_CM + (j0 + tt) * SD_BP + (cc - 24) * 16) = ob[tt];
            }
        }
        if (wid == 7) {
            const float a0 = softplusf(a.DT[(row0 + 2 * lane) * 16 + h] + dtb) * A2, a1 = softplusf(a.DT[(row0 + 2 * lane + 1) * 16 + h] + dtb) * A2;
            const float sp = a0 + a1;
            float incl = sp;
#pragma unroll
            for (int o = 1; o < 64; o <<= 1) { const float tv = __shfl_up(incl, o); if (lane >= o) incl += tv; }
            const float c0v = incl - a1, tot = __shfl(incl, 63);
            acs2[2 * lane] = c0v; acs2[2 * lane + 1] = incl;
            dte[2 * lane] = __builtin_amdgcn_exp2f(tot - c0v); dte[2 * lane + 1] = __builtin_amdgcn_exp2f(tot - incl);
        }
        __syncthreads();
        {
            bf16x8 cf[8];
#pragma unroll
            for (int ks = 0; ks < 8; ++ks) cf[ks] = *(const LAS bf16x8*)(lds + SD_CM + (32 * it + c32) * SD_BP + ks * 32 + hi * 16);
            f32x16 Yd = {0.f, 0.f, 0.f, 0.f, 0.f, 0.f, 0.f, 0.f, 0.f, 0.f, 0.f, 0.f, 0.f, 0.f, 0.f, 0.f};
            const float ai = acs2[32 * it + c32];
#pragma unroll
            for (int jt = 0; jt < 4; ++jt) {
                if (jt <= it) {
                    f32x16 X = {0.f, 0.f, 0.f, 0.f, 0.f, 0.f, 0.f, 0.f, 0.f, 0.f, 0.f, 0.f, 0.f, 0.f, 0.f, 0.f};
#pragma unroll
                    for (int ks = 0; ks < 8; ++ks) {
                        const bf16x8 bfr = *(const LAS bf16x8*)(lds + SD_BM + (32 * jt + c32) * SD_BP + ks * 32 + hi * 16);
                        X = __builtin_amdgcn_mfma_f32_32x32x16_bf16(bfr, cf[ks], X, 0, 0, 0);
                    }
#pragma unroll
                    for (int r = 0; r < 16; ++r) {
                        const int jr = crow(r, hi);
                        float f = __builtin_amdgcn_exp2f(ai - acs2[32 * jt + jr]);
                        if (jt == it && jr > c32) f = 0.f;
                        X[r] *= f;
                    }
#pragma unroll
                    for (int s2 = 0; s2 < 2; ++s2) {
                        u32x4 pw;
                        pw.x = pg8::cvt_pk_bf16(X[8 * s2 + 0], X[8 * s2 + 1]); pw.y = pg8::cvt_pk_bf16(X[8 * s2 + 2], X[8 * s2 + 3]);
                        pw.z = pg8::cvt_pk_bf16(X[8 * s2 + 4], X[8 * s2 + 5]); pw.w = pg8::cvt_pk_bf16(X[8 * s2 + 6], X[8 * s2 + 7]);
                        const LAS unsigned char* vp = lds + SD_XT + (32 * ph + c32) * SD_BP + (32 * jt + 16 * s2 + 4 * hi) * 2;
                        const s16x4 v0 = *(const LAS s16x4*)vp, v1 = *(const LAS s16x4*)(vp + 16);
                        const bf16x8 vf = {v0[0], v0[1], v0[2], v0[3], v1[0], v1[1], v1[2], v1[3]};
                        Yd = __builtin_amdgcn_mfma_f32_32x32x16_bf16(__builtin_bit_cast(bf16x8, pw), vf, Yd, 0, 0, 0);
                    }
                }
            }
            f32x16 Yo = {0.f, 0.f, 0.f, 0.f, 0.f, 0.f, 0.f, 0.f, 0.f, 0.f, 0.f, 0.f, 0.f, 0.f, 0.f, 0.f};
#pragma unroll
            for (int ks = 0; ks < 8; ++ks) {
                const bf16x8 sf = *(const LAS bf16x8*)(lds + SD_SL + (32 * ph + c32) * SD_BP + ks * 32 + hi * 16);
                Yo = __builtin_amdgcn_mfma_f32_32x32x16_bf16(cf[ks], sf, Yo, 0, 0, 0);
            }
            const int pcol = 32 * ph + c32;
#pragma unroll
            for (int r = 0; r < 16; ++r) {
                const int i = 32 * it + crow(r, hi);
                const float xs = bf2f(*(const LAS unsigned short*)(lds + SD_XS + i * SD_XP + pcol * 2));
                const float y = Yd[r] + __builtin_amdgcn_exp2f(acs2[i]) * Yo[r] + Dk * xs;
                bf16* zp = a.ZY + (row0 + i) * ZYW + h * 64 + pcol;
                const float z = bf2f(*zp);
                *zp = f2bf(y * siluf(z));
            }
        }
        __syncthreads();
        {
            const float dec = __builtin_amdgcn_exp2f(acs2[127]);
#pragma unroll
            for (int r = 0; r < 16; ++r) St[r] *= dec;
            const int i16 = lane & 15, gsel = (lane >> 4) & 1;
#pragma unroll
            for (int ks = 0; ks < 8; ++ks) {
                const u32x4 xr = *(const LAS u32x4*)(lds + SD_XT + (32 * pt + c32) * SD_BP + ks * 32 + hi * 16);
                const f32x4 f0 = *(const LAS f32x4*)(lds + SD_DTE + (16 * ks + 8 * hi) * 4), f1 = *(const LAS f32x4*)(lds + SD_DTE + (16 * ks + 8 * hi + 4) * 4);
                u32x4 aw;
                aw.x = pg8::cvt_pk_bf16(bflo(xr.x) * f0[0], bfhi(xr.x) * f0[1]); aw.y = pg8::cvt_pk_bf16(bflo(xr.y) * f0[2], bfhi(xr.y) * f0[3]);
                aw.z = pg8::cvt_pk_bf16(bflo(xr.z) * f1[0], bfhi(xr.z) * f1[1]); aw.w = pg8::cvt_pk_bf16(bflo(xr.w) * f1[2], bfhi(xr.w) * f1[3]);
                const LAS unsigned char* bp = lds + SD_BM + (16 * ks + 8 * hi + (i16 >> 2)) * SD_BP + (32 * nt + 16 * gsel + 4 * (i16 & 3)) * 2;
                const v4i16_t t0v = __builtin_amdgcn_ds_read_tr16_b64_v4i16((LAS v4i16_t*)bp);
                const v4i16_t t1v = __builtin_amdgcn_ds_read_tr16_b64_v4i16((LAS v4i16_t*)(bp + 4 * SD_BP));
                const bf16x8 bfr = {t0v[0], t0v[1], t0v[2], t0v[3], t1v[0], t1v[1], t1v[2], t1v[3]};
                St = __builtin_amdgcn_mfma_f32_32x32x16_bf16(__builtin_bit_cast(bf16x8, aw), bfr, St, 0, 0, 0);
            }
#pragma unroll
            for (int r = 0; r < 16; ++r) *(LAS unsigned short*)(lds + SD_SL + (32 * pt + crow(r, hi)) * SD_BP + (32 * nt + c32) * 2) = f2bf(St[r]);
        }
        __syncthreads();
    }
}

struct ConfArgs { const bf16* P; bf16* ZY; const float* dw_w; const float* dw_b; const float* ln_w; const float* ln_b; };
__device__ __forceinline__ void conf_naive_unit(const ConfArgs& a, int unit, float* sm) {
    constexpr int TT = 16;
    float* glu = sm;
    float* outb = sm + (TT + 30) * 512;
    const int b = unit >> 7, t0 = (unit & 127) * TT, c = opaque_tid(), lane = c & 63, w = c >> 6;
    for (int tt = 0; tt < TT + 30; ++tt) {
        const int t = t0 - 30 + tt;
        float v = 0.f;
        if (t >= 0) { const size_t base = ((size_t)b * SEQ + t) * PW; v = bf2f(a.P[base + P_CA + c]) * sigmf(bf2f(a.P[base + P_CG + c])); }
        glu[tt * 512 + c] = v;
    }
    float wk[31];
#pragma unroll
    for (int k = 0; k < 31; ++k) wk[k] = a.dw_w[k * 512 + c];
    const float bias = a.dw_b[c];
    for (int tt = 0; tt < TT; ++tt) {
        float v = bias;
#pragma unroll
        for (int k = 0; k < 31; ++k) v += wk[k] * glu[(tt + k) * 512 + c];
        outb[tt * 512 + c] = v;
    }
    __syncthreads();
    for (int tt = w * 2; tt < w * 2 + 2; ++tt) {
        float v[8], s = 0.f;
#pragma unroll
        for (int j = 0; j < 8; ++j) { v[j] = outb[tt * 512 + j * 64 + lane]; s += v[j]; }
        const float mean = wave_sum(s) * (1.f / 512.f);
        float s2 = 0.f;
#pragma unroll
        for (int j = 0; j < 8; ++j) { v[j] -= mean; s2 += v[j] * v[j]; }
        const float rstd = rsqrtf(wave_sum(s2) * (1.f / 512.f) + EPS);
        const size_t zrow = ((size_t)b * SEQ + t0 + tt) * ZYW + 1536;
#pragma unroll
        for (int j = 0; j < 8; ++j) {
            const int ch = j * 64 + lane;
            const float y = siluf(v[j] * rstd * a.ln_w[ch] + a.ln_b[ch]);
            const float z = bf2f(a.ZY[zrow + ch]);
            a.ZY[zrow + ch] = f2bf(y * siluf(z));
        }
    }
    __syncthreads();
}

__device__ __forceinline__ void final_norm_row(float* __restrict__ out, const float* __restrict__ w, const float* __restrict__ SSQ, int row, int lane) {
    float* xr = out + (size_t)row * DM;
    float v[16];
#pragma unroll
    for (int j = 0; j < 16; ++j) v[j] = xr[j * 64 + lane];
    const float rstd = rsqrtf(wave_sum(lane < 16 ? SSQ[row * 16 + lane] : 0.f) * (1.f / DM) + EPS);
#pragma unroll
    for (int j = 0; j < 16; ++j) xr[j * 64 + lane] = v[j] * rstd * w[j * 64 + lane];
}

__global__ __launch_bounds__(NTHR, 2) void mega_fwd(Params p) {
    extern __shared__ __attribute__((aligned(16))) unsigned char lds[];
    cg::grid_group grid = cg::this_grid();
    float* sm = (float*)lds;
    const int bid = blockIdx.x, G = gridDim.x, NGW = G * NWAVE;
#define ROWLOOP(body) do { const int tid_ = opaque_tid(), lane = tid_ & 63, gw_ = bid * NWAVE + __builtin_amdgcn_readfirstlane(tid_ >> 6); for (int row = gw_; row < M; row += NGW) { body; } } while (0)
    const float* x = p.in[0];
    unsigned char* ws = p.ws;
    bf16* Win_t = (bf16*)(ws + WS_WIN); bf16* Wout_t = (bf16*)(ws + WS_WOUT);
    float* SSQ = (float*)(ws + WS_SSQ); float* SSQH = (float*)(ws + WS_SSQH); float* DT = (float*)(ws + WS_DT);
    bf16* XB = (bf16*)(ws + WS_XB); bf16* ZY = (bf16*)(ws + WS_ZY); bf16* P = (bf16*)(ws + WS_P);
    float* out = p.out;

#ifdef DBG_ATTN
    if (bid == 0 && threadIdx.x == 0) *(unsigned*)(ws + WS_CTL) = 0u;
#endif
    for (int it = bid; it < DEPTH * 88 * 16; it += G) conv_win_tile(p.in[2], p.in[1], Win_t, it, sm);
    for (int it = bid; it < DEPTH * 16 * 32; it += G) conv_wout_tile(p.in[14], Wout_t, it, sm);
    ROWLOOP(normprep_row(x, XB, SSQ, row, lane));
    grid.sync();

    for (int l = 0; l < DEPTH; ++l) {
        {
            pg8::Gemm g{XB, Win_t + (size_t)l * NINP * DM, M, NINP, DM}; pg8::StaticOrder S; S.init(M, NINP, G, bid);
            EpiIn E{SSQ, ZY, P, DT};
            pg8::gemm_phase<EpiIn, pg8::StaticOrder, true, true>((PG8_LAS unsigned char*)lds, g, S, E);
        }
        grid.sync();
        {
            SsdArgs sa{P, ZY, DT, SSQH, p.in[3] + l * 4 * 1536, p.in[4] + l * 1536, p.in[5] + l * 16, p.in[6] + l * 16, p.in[7] + l * 16};
            for (int u = bid; u < BATCH * 16; u += G) ssd_unit(sa, u, (LAS unsigned char*)lds);
            AttnArgs aa{P, ZY, p.in[9] + l * 8};
#ifdef DBG_ATTN
            bf16* yref = (bf16*)(ws + 440 * MiB);
            for (int u = bid; u < BATCH * 2 * 16; u += G) attn_naive_unit(aa, u, sm, yref);
#endif
            for (int u = bid; u < BATCH * 2 * 16; u += G) attn_unit(aa, u, (LAS unsigned char*)lds);
#ifdef DBG_ATTN
            __syncthreads();
            {
                unsigned bad = 0u;
                for (int u = bid; u < BATCH * 2 * 16; u += G) {
                    const int nb = u & 15, g = (u >> 4) & 1, b = u >> 5;
                    for (int e = opaque_tid(); e < 128 * 256; e += NTHR) {
                        const int qi = e >> 8, c = e & 255; const size_t tok = (size_t)b * SEQ + nb * 128 + qi;
                        const float ref = bf2f(yref[tok * 512 + g * 256 + c]), got = bf2f(ZY[tok * ZYW + 1024 + g * 256 + c]);
                        if (!(fabsf(ref - got) <= 0.02f * fabsf(ref) + 0.01f)) bad = 1u;
                    }
                }
                if (bad) atomicOr((unsigned*)(ws + WS_CTL), 1u);
            }
#endif
            ConfArgs ca{P, ZY, p.in[10] + l * 31 * 512, p.in[11] + l * 512, p.in[12] + l * 512, p.in[13] + l * 512};
            for (int u = bid; u < BATCH * 128; u += G) conf_naive_unit(ca, u, sm);
        }
        grid.sync();
        ROWLOOP(ssd_norm_row(ZY, SSQH, p.in[8] + l * 1024, row, lane));
        grid.sync();
        {
            pg8::Gemm g{ZY, Wout_t + (size_t)l * DM * 2048, M, DM, 2048}; pg8::StaticOrder S; S.init(M, DM, G, bid);
            EpiOut E{l == 0 ? x : out, out, XB, SSQ};
            pg8::gemm_phase<EpiOut, pg8::StaticOrder, true, true>((PG8_LAS unsigned char*)lds, g, S, E);
        }
        grid.sync();
    }
    ROWLOOP(final_norm_row(out, p.in[15], SSQ, row, lane));
#ifdef DBG_ATTN
    grid.sync();
    if (__hip_atomic_load((unsigned*)(ws + WS_CTL), __ATOMIC_RELAXED, __HIP_MEMORY_SCOPE_AGENT) != 0u && threadIdx.x == 0) out[(size_t)bid * 1024] = 1e6f;
#endif
}

extern "C" void kernel_launch(void* const* d_in, const int* in_sizes, int n_in, void* d_out, int out_size, void* d_ws, size_t ws_size, hipStream_t stream) {
    static int grid_blocks = 0;
    if (grid_blocks == 0) {
        if (n_in != 16 || out_size != M * DM || ws_size < WS_END) { fprintf(stderr, "kernel_launch: unexpected shapes (n_in %d out %d ws %zu)\n", n_in, out_size, ws_size); grid_blocks = -1; return; }
        int dev = 0, cus = 0, per_cu = 0;
        (void)hipGetDevice(&dev);
        (void)hipDeviceGetAttribute(&cus, hipDeviceAttributeMultiprocessorCount, dev);
        (void)hipFuncSetAttribute((const void*)mega_fwd, hipFuncAttributeMaxDynamicSharedMemorySize, LDS_BYTES);
        (void)hipOccupancyMaxActiveBlocksPerMultiprocessor(&per_cu, (const void*)mega_fwd, NTHR, LDS_BYTES);
        if (per_cu < 1) { fprintf(stderr, "kernel_launch: occupancy query says %d blocks per CU\n", per_cu); per_cu = 1; }
        grid_blocks = cus * 1;
        fprintf(stderr, "kernel_launch: %d CUs, occupancy %d/CU, grid %d\n", cus, per_cu, grid_blocks);
    }
    if (grid_blocks < 0) return;
    Params p{};
    for (int i = 0; i < 16; ++i) p.in[i] = (const float*)d_in[i];
    p.out = (float*)d_out; p.ws = (unsigned char*)d_ws;
    void* args[] = {&p};
    hipError_t e = hipLaunchCooperativeKernel((const void*)mega_fwd, dim3(grid_blocks), dim3(NTHR), args, LDS_BYTES, stream);
    if (e != hipSuccess) fprintf(stderr, "cooperative launch failed: %s (grid %d)\n", hipGetErrorString(e), grid_blocks);
}
```

```cpp
#define REP_PHASE 0
#include <hip/hip_runtime.h>
#include <cstdint>
#include <cstdio>

typedef unsigned short bf16;

constexpr int BATCH = 16, SEQ = 2048, DM = 1024, DEPTH = 2;
constexpr int M = BATCH * SEQ;
constexpr int NIN = 5392, NINP = 5632;
constexpr int ZYW = 2048;
constexpr int PW = 3328;
constexpr int P_XS = 0, P_B = 1024, P_C = 1280, P_Q = 1536, P_K = 2048, P_V = 2176, P_CA = 2304, P_CG = 2816;
constexpr float EPS = 1e-5f;

constexpr size_t MiB = 1u << 20;
constexpr size_t WS_CTL = 0;
constexpr size_t WS_WIN = 1 * MiB;
constexpr size_t WS_WOUT = 23 * MiB;
constexpr size_t WS_SSQ = 438 * MiB;
constexpr size_t WS_SSQH = 32 * MiB;
constexpr size_t WS_DT = 34 * MiB;
constexpr size_t WS_XB = 36 * MiB;
constexpr size_t WS_ZY = 100 * MiB;
constexpr size_t WS_P = 228 * MiB;
constexpr size_t WS_END = 440 * MiB;

__device__ __forceinline__ float bf2f(bf16 v) { return __uint_as_float(((unsigned)v) << 16); }
__device__ __forceinline__ float bflo(unsigned w) { return __uint_as_float(w << 16); }
__device__ __forceinline__ float bfhi(unsigned w) { return __uint_as_float(w & 0xffff0000u); }
__device__ __forceinline__ bf16 f2bf(float f) { unsigned u = __float_as_uint(f); return (bf16)((u + 0x7fffu + ((u >> 16) & 1u)) >> 16); }
__device__ __forceinline__ float sigmf(float v) { return __builtin_amdgcn_rcpf(1.f + __builtin_amdgcn_exp2f(v * -1.4426950408889634f)); }
__device__ __forceinline__ float siluf(float v) { return v * sigmf(v); }
__device__ __forceinline__ float wave_sum(float v) {
#pragma unroll
    for (int o = 1; o < 64; o <<= 1) v += __shfl_xor(v, o);
    return v;
}
__device__ __forceinline__ int opaque_tid() { int t = threadIdx.x; asm volatile("" : "+v"(t)); return t; }
__host__ __device__ __forceinline__ int src_col(int np) { return np < 3584 ? np : (np < 5376 ? np + 16 : np - 1792); }

namespace pg8 {
#define PG8_LAS __attribute__((address_space(3)))
typedef unsigned short bf16_t;
typedef short bf16x8 __attribute__((ext_vector_type(8)));
typedef float f32x4 __attribute__((ext_vector_type(4)));
typedef unsigned u32x4 __attribute__((ext_vector_type(4)));
constexpr int BM = 256, BK = 64, HALF = 128, HTB = HALF * BK * 2  , STAGE_BYTES = 8 * HTB, NXCD = 8, WGM = 8;

__host__ __device__ __forceinline__ int lds_byte(int r, int c) { const int st = (r >> 4) * 2 + (c >> 5), rr = r & 15, cc = c & 31, ob = rr * 64 + cc * 2; return st * 1024 + (ob ^ (((ob >> 9) & 1) << 5)); }
__host__ __device__ __forceinline__ void stage_rc(int b, int& R, int& C) { const int st = b / 1024, sb = b % 1024, swz = sb ^ (((sb >> 9) & 1) << 5); R = (st >> 1) * 16 + swz / 64; C = (st & 1) * 32 + (swz % 64) / 2; }
__host__ __device__ __forceinline__ int perm32(int rho) { const int n = rho >> 4, i = rho & 15; return 8 * (i >> 2) + 4 * n + (i & 3); }

struct Unit { int pm, pn; };
struct Gemm { const bf16_t* A; const bf16_t* Bt; int M, N, K; };

struct StaticOrder {
    int nM, nN, nwg, G, c;
    __host__ __device__ void init(int M, int N, int G_, int c_) { nM = M / BM; nN = N / BM; nwg = nM * nN; G = G_; c = c_; }
    __host__ __device__ bool next(int i, Unit& u) const {
        const long L = (long)i * G + c; if (L >= nwg) return false;
        int wgid = (int)L; { const int q = nwg / NXCD, r = nwg % NXCD, xcd = wgid % NXCD, off = wgid / NXCD; wgid = (xcd < r ? xcd * (q + 1) : r * (q + 1) + (xcd - r) * q) + off; }
        const int nig = WGM * nN, gid = wgid / nig, fm = gid * WGM, gsz = (nM - fm) < WGM ? (nM - fm) : WGM;
        u.pm = fm + ((wgid % nig) % gsz); u.pn = (wgid % nig) / gsz; return true;
    }
    __device__ __forceinline__ void a_ready(const Unit&) const {}
    __device__ __forceinline__ void done(const Unit&) const {}
};

__device__ __forceinline__ unsigned cvt_pk_bf16(float lo, float hi) { unsigned r; asm volatile("v_cvt_pk_bf16_f32 %0, %1, %2" : "=v"(r) : "v"(lo), "v"(hi)); return r; }
template <class Epi, class Sched, bool ALIGN_EPI = false, bool SP2 = false>
__device__ __forceinline__ void gemm_phase(PG8_LAS unsigned char* lds, const Gemm g, const Sched& S, const Epi& E) {
    const int tid = opaque_tid(), wid = __builtin_amdgcn_readfirstlane(tid >> 6), lane = tid & 63, wr = wid >> 2, wc = wid & 3, fr = lane & 15, fq = lane >> 4;
    const int K = g.K, nt = K / BK;
    unsigned voffA[2], voffB[2];
#pragma unroll
    for (int i = 0; i < 2; ++i) { int R, C; stage_rc(tid * 16 + i * 8192, R, C); const int Rb = Epi::PERM ? ((R & ~31) + perm32(R & 31)) : R;
        voffA[i] = (unsigned)(R * K + C) * 2u; voffB[i] = (unsigned)(Rb * K + C) * 2u; }
    const size_t kstep = (size_t)(BK * 2);
    const size_t hstep = (size_t)HALF * K * 2;
    const size_t tstep = 2 * hstep;
    const unsigned ldsw = (unsigned)wid * 1024u;
    const int aoff = lds_byte(wr * 64 + fr, fq * 8), boff = lds_byte(wc * 32 + fr, fq * 8);
#define PG8_SA(b, h) (((b) * 2 + (h)) * HTB)
#define PG8_SB(b, h) ((4 + (b) * 2 + (h)) * HTB)
#define PG8_STAGE(bufoff, gbase, voff) do { _Pragma("unroll") for (int _i = 0; _i < 2; ++_i) \
        __builtin_amdgcn_global_load_lds((const unsigned*)((const char*)(gbase) + (voff)[_i]), (PG8_LAS unsigned*)(lds + (bufoff) + ldsw + _i * 8192), 16, 0, 0); } while (0)
#define PG8_LDA(dst, b, h) do { _Pragma("unroll") for (int m = 0; m < 4; ++m) _Pragma("unroll") for (int k = 0; k < 2; ++k) dst[m][k] = *(const PG8_LAS bf16x8*)(lds + PG8_SA(b, h) + aoff + m * 2048 + k * 1024); } while (0)
#define PG8_LDB(dst, b, h) do { _Pragma("unroll") for (int n = 0; n < 2; ++n) _Pragma("unroll") for (int k = 0; k < 2; ++k) dst[n][k] = *(const PG8_LAS bf16x8*)(lds + PG8_SB(b, h) + boff + n * 2048 + k * 1024); } while (0)
#define PG8_MMA(ai, bj, At, Bt) do { __builtin_amdgcn_s_setprio(1); _Pragma("unroll") for (int m = 0; m < 4; ++m) _Pragma("unroll") for (int n = 0; n < 2; ++n) _Pragma("unroll") for (int k = 0; k < 2; ++k) \
        acc[ai][bj][m][n] = __builtin_amdgcn_mfma_f32_16x16x32_bf16(Bt[n][k], At[m][k], acc[ai][bj][m][n], 0, 0, 0); __builtin_amdgcn_s_setprio(0); } while (0)
#define PG8_WAIT_V(n) asm volatile("s_waitcnt vmcnt(" #n ")" ::: "memory")
#define PG8_WAIT_L(n) asm volatile("s_waitcnt lgkmcnt(" #n ")" ::: "memory")
#define PG8_BAR __builtin_amdgcn_s_barrier()
#define PG8_SCHED __builtin_amdgcn_sched_barrier(0)
    Unit cur, nxt; int ui = 0;
    if (!S.next(0, cur)) return;
    f32x4 acc[2][2][4][2];
#pragma unroll
    for (int a = 0; a < 2; ++a)
#pragma unroll
        for (int b = 0; b < 2; ++b)
#pragma unroll
            for (int m = 0; m < 4; ++m)
#pragma unroll
                for (int n = 0; n < 2; ++n) acc[a][b][m][n] = (f32x4){0.f, 0.f, 0.f, 0.f};
    bf16x8 At[4][2], B0[2][2], B1[2][2];
    const char* cA = (const char*)g.A + (size_t)cur.pm * tstep; const char* cB = (const char*)g.Bt + (size_t)cur.pn * tstep;
    if constexpr (Epi::KSCALE) E.prep(cur, lds, wid, wr, fr, fq);
    S.a_ready(cur);
    if constexpr (SP2) {
        PG8_STAGE(PG8_SB(0, 0), cB, voffB); PG8_STAGE(PG8_SB(0, 1), cB + hstep, voffB); PG8_STAGE(PG8_SA(0, 0), cA, voffA); PG8_STAGE(PG8_SA(0, 1), cA + hstep, voffA);
        if (wr == 1) PG8_BAR;
        PG8_WAIT_V(2); PG8_BAR;
        PG8_STAGE(PG8_SB(1, 0), cB + kstep, voffB); PG8_STAGE(PG8_SA(1, 0), cA + kstep, voffA); PG8_STAGE(PG8_SB(1, 1), cB + hstep + kstep, voffB);
        PG8_WAIT_V(6); PG8_BAR;
    } else {
        PG8_STAGE(PG8_SB(0, 0), cB, voffB); PG8_STAGE(PG8_SA(0, 0), cA, voffA); PG8_STAGE(PG8_SB(0, 1), cB + hstep, voffB); PG8_STAGE(PG8_SA(0, 1), cA + hstep, voffA);
        if (wr == 1) PG8_BAR;
        PG8_WAIT_V(4); PG8_BAR;
        PG8_STAGE(PG8_SB(1, 0), cB + kstep, voffB); PG8_STAGE(PG8_SA(1, 0), cA + kstep, voffA); PG8_STAGE(PG8_SB(1, 1), cB + hstep + kstep, voffB);
        PG8_WAIT_V(6); PG8_BAR;
    }
    for (;;) {
        const bool has_next = S.next(ui + 1, nxt);
        const char* nA = has_next ? (const char*)g.A + (size_t)nxt.pm * tstep : cA; const char* nB = has_next ? (const char*)g.Bt + (size_t)nxt.pn * tstep : cB;
        for (int t = 0; t < nt; t += 2) {
            const bool last = (t == nt - 2);
            const char* a1 = cA + (size_t)(t + 1) * kstep;
            const char* a2 = last ? nA : cA + (size_t)(t + 2) * kstep; const char* b2 = last ? nB : cB + (size_t)(t + 2) * kstep;
            const char* a3 = a2 + kstep; const char* b3 = b2 + kstep;
            if (last && has_next) S.a_ready(nxt);
            if constexpr (SP2) {
            PG8_LDB(B0, 0, 0); PG8_LDB(B1, 0, 1); PG8_SCHED; PG8_LDA(At, 0, 0); PG8_STAGE(PG8_SA(1, 1), a1 + hstep, voffA);
            PG8_WAIT_V(8); PG8_WAIT_L(0); PG8_BAR; PG8_MMA(0, 0, At, B0); PG8_MMA(0, 1, At, B1); PG8_BAR; PG8_SCHED;
            PG8_LDA(At, 0, 1); PG8_STAGE(PG8_SB(0, 0), b2, voffB); PG8_STAGE(PG8_SB(0, 1), b2 + hstep, voffB); PG8_STAGE(PG8_SA(0, 0), a2, voffA);
            PG8_WAIT_V(8); PG8_WAIT_L(0); PG8_BAR; PG8_MMA(1, 0, At, B0); PG8_MMA(1, 1, At, B1); PG8_BAR; PG8_SCHED;
            PG8_LDB(B0, 1, 0); PG8_LDB(B1, 1, 1); PG8_SCHED; PG8_LDA(At, 1, 0); PG8_STAGE(PG8_SA(0, 1), a2 + hstep, voffA);
            PG8_WAIT_V(8); PG8_WAIT_L(0); PG8_BAR; PG8_MMA(0, 0, At, B0); PG8_MMA(0, 1, At, B1); PG8_BAR; PG8_SCHED;
            PG8_LDA(At, 1, 1); PG8_STAGE(PG8_SB(1, 0), b3, voffB); PG8_STAGE(PG8_SB(1, 1), b3 + hstep, voffB); PG8_STAGE(PG8_SA(1, 0), a3, voffA);
            PG8_WAIT_V(8); PG8_WAIT_L(0); PG8_BAR; PG8_MMA(1, 0, At, B0); PG8_MMA(1, 1, At, B1); PG8_BAR; PG8_SCHED;
            } else {
            PG8_LDB(B0, 0, 0); PG8_SCHED; PG8_LDA(At, 0, 0); PG8_STAGE(PG8_SA(1, 1), a1 + hstep, voffA);
            PG8_WAIT_L(8); PG8_BAR; PG8_WAIT_L(0); PG8_MMA(0, 0, At, B0); PG8_BAR; PG8_SCHED;
            PG8_LDB(B1, 0, 1); PG8_STAGE(PG8_SB(0, 0), b2, voffB);
            PG8_BAR; PG8_WAIT_L(0); PG8_MMA(0, 1, At, B1); PG8_BAR;
            PG8_LDA(At, 0, 1); PG8_STAGE(PG8_SA(0, 0), a2, voffA);
            PG8_BAR; PG8_WAIT_L(0); PG8_MMA(1, 0, At, B0); PG8_BAR; PG8_SCHED;
            PG8_STAGE(PG8_SB(0, 1), b2 + hstep, voffB);
            PG8_WAIT_V(6); PG8_BAR; PG8_MMA(1, 1, At, B1); PG8_BAR;
            PG8_LDB(B0, 1, 0); PG8_SCHED; PG8_LDA(At, 1, 0); PG8_STAGE(PG8_SA(0, 1), a2 + hstep, voffA);
            PG8_WAIT_L(8); PG8_BAR; PG8_WAIT_L(0); PG8_MMA(0, 0, At, B0); PG8_BAR; PG8_SCHED;
            PG8_LDB(B1, 1, 1); PG8_STAGE(PG8_SB(1, 0), b3, voffB);
            PG8_BAR; PG8_WAIT_L(0); PG8_MMA(0, 1, At, B1); PG8_BAR;
            PG8_LDA(At, 1, 1); PG8_STAGE(PG8_SA(1, 0), a3, voffA);
            PG8_BAR; PG8_WAIT_L(0); PG8_MMA(1, 0, At, B0); PG8_BAR; PG8_SCHED;
            PG8_STAGE(PG8_SB(1, 1), b3 + hstep, voffB);
            PG8_WAIT_V(6); PG8_BAR; PG8_MMA(1, 1, At, B1); PG8_BAR;
            }
            if constexpr (Epi::KSCALE) { if (t == Epi::KS_T0 || t == Epi::KS_T1) E.kscale(acc, t == Epi::KS_T0 ? 0 : 1, lds, wid, fr); }
        }
        if constexpr (ALIGN_EPI) { if (wr == 0) PG8_BAR; }
        if constexpr (!Epi::AFTER_DRAIN) { E(acc, cur, wr, wc, fr, fq); S.done(cur); }
        if constexpr (Epi::KSCALE) { if (has_next) E.prep(nxt, lds, wid, wr, fr, fq); }
        if (!has_next) break;
#pragma unroll
        for (int a = 0; a < 2; ++a)
#pragma unroll
            for (int b = 0; b < 2; ++b)
#pragma unroll
                for (int m = 0; m < 4; ++m)
#pragma unroll
                    for (int n = 0; n < 2; ++n) acc[a][b][m][n] = (f32x4){0.f, 0.f, 0.f, 0.f};
        cur = nxt; cA = nA; cB = nB; ++ui;
        if constexpr (ALIGN_EPI) { if (wr == 1) PG8_BAR; }
    }
    PG8_WAIT_V(0);
    if constexpr (!ALIGN_EPI) { if (wr == 0) PG8_BAR; }
    PG8_BAR;
    if constexpr (Epi::AFTER_DRAIN) { E.fused(acc, cur, wr, wc, fr, fq, lds, wid, lane); S.done(cur); }
#undef PG8_SA
#undef PG8_SB
#undef PG8_STAGE
#undef PG8_LDA
#undef PG8_LDB
#undef PG8_MMA
#undef PG8_WAIT_V
#undef PG8_WAIT_L
#undef PG8_BAR
#undef PG8_SCHED
}
}

typedef float f32x4 __attribute__((ext_vector_type(4)));
typedef unsigned u32x4 __attribute__((ext_vector_type(4)));
struct EpiIn {
    static constexpr bool PERM = true, AFTER_DRAIN = false, KSCALE = false; static constexpr int KS_T0 = -1, KS_T1 = -1;
    const float* ssq; bf16* ZY; bf16* P; float* DT;
    __device__ __forceinline__ void operator()(const f32x4 (&acc)[2][2][4][2], const pg8::Unit& u, int wr, int wc, int fr, int fq) const {
        const int row0 = u.pm * 256 + wr * 64 + fr, cin = wc * 32 + 8 * fq;
#pragma unroll
        for (int ai = 0; ai < 2; ++ai)
#pragma unroll
            for (int m = 0; m < 4; ++m) {
                const int row = row0 + ai * 128 + m * 16;
                const f32x4* sp = (const f32x4*)(ssq + (size_t)row * 16);
                const f32x4 s0 = sp[0], s1 = sp[1], s2 = sp[2], s3 = sp[3];
                const float s = ((s0[0] + s0[1]) + (s0[2] + s0[3])) + ((s1[0] + s1[1]) + (s1[2] + s1[3])) + ((s2[0] + s2[1]) + (s2[2] + s2[3])) + ((s3[0] + s3[1]) + (s3[2] + s3[3]));
                const float rstd = rsqrtf(s * (1.f / DM) + EPS);
                if (u.pn < 21) {
                    bf16* rowp = u.pn < 8 ? ZY + (size_t)row * ZYW + u.pn * 256 + cin : P + (size_t)row * PW + (u.pn - 8) * 256 + cin;
#pragma unroll
                    for (int bj = 0; bj < 2; ++bj) {
                        const f32x4 v0 = acc[ai][bj][m][0] * rstd, v1 = acc[ai][bj][m][1] * rstd;
                        u32x4 w; w.x = pg8::cvt_pk_bf16(v0[0], v0[1]); w.y = pg8::cvt_pk_bf16(v0[2], v0[3]); w.z = pg8::cvt_pk_bf16(v1[0], v1[1]); w.w = pg8::cvt_pk_bf16(v1[2], v1[3]);
                        *(u32x4*)(rowp + bj * 128) = w;
                    }
                } else if (cin < 16) {
                    *(f32x4*)(DT + (size_t)row * 16 + cin) = acc[ai][0][m][0] * rstd;
                    *(f32x4*)(DT + (size_t)row * 16 + cin + 4) = acc[ai][0][m][1] * rstd;
                }
            }
    }
};
constexpr int KS_LDS = 131072;
struct EpiOut {
    static constexpr bool PERM = true, AFTER_DRAIN = false, KSCALE = true; static constexpr int KS_T0 = 6, KS_T1 = 14;
    const float* xin; bf16* XB; float* ssq; const float* ssqh;
    __device__ __forceinline__ void prep(const pg8::Unit& u, PG8_LAS unsigned char* lds, int wid, int wr, int fr, int fq) const {
        if (fq == 0) {
            PG8_LAS float* dst = (PG8_LAS float*)(lds + KS_LDS) + (wid * 16 + fr) * 16;
#pragma unroll
            for (int ai = 0; ai < 2; ++ai)
#pragma unroll
                for (int m = 0; m < 4; ++m) {
                    const f32x4* sp = (const f32x4*)(ssqh + (size_t)(u.pm * 256 + ai * 128 + wr * 64 + m * 16 + fr) * 16);
                    const f32x4 s0 = sp[0], s1 = sp[1], s2 = sp[2], s3 = sp[3];
                    const float r0 = rsqrtf((((s0[0] + s0[1]) + (s0[2] + s0[3])) + ((s1[0] + s1[1]) + (s1[2] + s1[3]))) * (1.f / 512.f) + EPS);
                    const float r1 = rsqrtf((((s2[0] + s2[1]) + (s2[2] + s2[3])) + ((s3[0] + s3[1]) + (s3[2] + s3[3]))) * (1.f / 512.f) + EPS);
                    dst[ai * 4 + m] = r0 / r1; dst[8 + ai * 4 + m] = r1;
                }
        }
    }
    __device__ __forceinline__ void kscale(f32x4 (&acc)[2][2][4][2], int which, PG8_LAS unsigned char* lds, int wid, int fr) const {
        const PG8_LAS f32x4* src = (const PG8_LAS f32x4*)((PG8_LAS float*)(lds + KS_LDS) + (wid * 16 + fr) * 16 + which * 8);
        const f32x4 fa = src[0], fb = src[1];
#pragma unroll
        for (int m = 0; m < 4; ++m)
#pragma unroll
            for (int bj = 0; bj < 2; ++bj)
#pragma unroll
                for (int n = 0; n < 2; ++n) { acc[0][bj][m][n] *= fa[m]; acc[1][bj][m][n] *= fb[m]; }
    }
    __device__ __forceinline__ void operator()(const f32x4 (&acc)[2][2][4][2], const pg8::Unit& u, int wr, int wc, int fr, int fq) const {
        const int row0 = u.pm * 256 + wr * 64 + fr, col0 = u.pn * 256 + wc * 32 + 8 * fq;
#pragma unroll
        for (int ai = 0; ai < 2; ++ai)
#pragma unroll
            for (int m = 0; m < 4; ++m) {
                const int row = row0 + ai * 128 + m * 16;
                float s = 0.f;
#pragma unroll
                for (int bj = 0; bj < 2; ++bj) {
                    const size_t off = (size_t)row * DM + col0 + bj * 128;
                    f32x4 v0, v1;
                    if (xin) { v0 = acc[ai][bj][m][0] + *(const f32x4*)(xin + off); v1 = acc[ai][bj][m][1] + *(const f32x4*)(xin + off + 4); }
                    else { const u32x4 xo = *(const u32x4*)(XB + off);
                           v0 = acc[ai][bj][m][0] + (f32x4){bflo(xo.x), bfhi(xo.x), bflo(xo.y), bfhi(xo.y)}; v1 = acc[ai][bj][m][1] + (f32x4){bflo(xo.z), bfhi(xo.z), bflo(xo.w), bfhi(xo.w)}; }
                    s += ((v0[0] * v0[0] + v0[1] * v0[1]) + (v0[2] * v0[2] + v0[3] * v0[3])) + ((v1[0] * v1[0] + v1[1] * v1[1]) + (v1[2] * v1[2] + v1[3] * v1[3]));
                    u32x4 w; w.x = pg8::cvt_pk_bf16(v0[0], v0[1]); w.y = pg8::cvt_pk_bf16(v0[2], v0[3]); w.z = pg8::cvt_pk_bf16(v1[0], v1[1]); w.w = pg8::cvt_pk_bf16(v1[2], v1[3]);
                    *(u32x4*)(XB + off) = w;
                }
                s += __shfl_xor(s, 16); s += __shfl_xor(s, 32);
                if (fq == 0) ssq[(size_t)row * 16 + u.pn * 4 + wc] = s;
            }
    }
};

constexpr int NTHR = 512, NWAVE = 8;
constexpr int LDS_BYTES = 163840;
constexpr int MISC_OFF = LDS_BYTES - 64;
constexpr int CW_BAR = 1024;
constexpr size_t CTL_ZERO_BYTES = 65536;

struct Params { const float* in[16]; float* out; unsigned char* ws; };

__device__ __forceinline__ void conv_win_tile(const float* __restrict__ w_in, const float* __restrict__ norm_w, bf16* __restrict__ Win_t, int item, float* tile  ) {
    const int tid = opaque_tid(), l = item / (88 * 16), r = item % (88 * 16), n0 = (r % 88) * 64, k0 = (r / 88) * 64;
    const float* W = w_in + (size_t)l * DM * NIN;
    for (int e = tid; e < 64 * 64; e += NTHR) {
        const int kk = e >> 6, nn = e & 63, np = n0 + nn;
        float v = 0.f;
        if (np < NIN) v = W[(size_t)(k0 + kk) * NIN + src_col(np)] * norm_w[l * DM + k0 + kk];
        tile[kk * 65 + nn] = v;
    }
    __syncthreads();
    bf16* O = Win_t + (size_t)l * NINP * DM;
    for (int e = tid; e < 64 * 64; e += NTHR) {
        const int nn = e >> 6, kk = e & 63;
        O[(size_t)(n0 + nn) * DM + k0 + kk] = f2bf(tile[kk * 65 + nn]);
    }
    __syncthreads();
}
__device__ __forceinline__ void conv_wout_tile(const float* __restrict__ w_out, const float* __restrict__ ssd_nw, bf16* __restrict__ Wout_t, int item, float* tile) {
    const int tid = opaque_tid(), l = item / (16 * 32), r = item % (16 * 32), n0 = (r % 16) * 64, k0 = (r / 16) * 64;
    const float* W = w_out + (size_t)l * 2048 * DM;
    for (int e = tid; e < 64 * 64; e += NTHR) {
        const int kk = e >> 6, nn = e & 63;
        tile[kk * 65 + nn] = W[(size_t)(k0 + kk) * DM + n0 + nn] * (k0 + kk < 1024 ? ssd_nw[l * 1024 + k0 + kk] : 1.f);
    }
    __syncthreads();
    bf16* O = Wout_t + (size_t)l * DM * 2048;
    for (int e = tid; e < 64 * 64; e += NTHR) {
        const int nn = e >> 6, kk = e & 63;
        O[(size_t)(n0 + nn) * 2048 + k0 + kk] = f2bf(tile[kk * 65 + nn]);
    }
    __syncthreads();
}
__device__ __forceinline__ void normprep_row(const float* __restrict__ x, bf16* __restrict__ XB, float* __restrict__ SSQ, int row, int lane) {
    const float* xr = x + (size_t)row * DM;
    float s = 0.f;
#pragma unroll
    for (int j = 0; j < 16; ++j) { const float v = xr[j * 64 + lane]; s += v * v; XB[(size_t)row * DM + j * 64 + lane] = f2bf(v); }
    s = wave_sum(s);
    if (lane < 16) SSQ[row * 16 + lane] = lane == 0 ? s : 0.f;
}

struct SsdArgs { const bf16* P; bf16* ZY; const float* DT; float* SSQH; const float* conv_w; const float* conv_b; const float* dt_bias; const float* a_log; const float* dskip; };
__device__ __forceinline__ void ssd_naive_unit(const SsdArgs& a, int unit, float* sm) {
    constexpr int TT = 32;
    float* raw = sm;
    float* act = raw + (TT + 3) * 320;
    float* dts = act + TT * 320;
    float* decs = dts + TT;
    float* gq = decs + TT;
    const int b = unit >> 4, h = unit & 15, g = h >> 3, tid = opaque_tid(), lane = tid & 63, w = tid >> 6;
    const int p = w * 8 + (lane >> 3), ng = lane & 7;
    const float A = -__expf(a.a_log[h]), Dk = a.dskip[h], dtb = a.dt_bias[h];
    float S[16];
#pragma unroll
    for (int i = 0; i < 16; ++i) S[i] = 0.f;
    for (int t0 = 0; t0 < SEQ; t0 += TT) {
        for (int e = tid; e < (TT + 3) * 320; e += NTHR) {
            const int tt = e / 320, c = e % 320, t = t0 - 3 + tt;
            const int col = c < 64 ? (P_XS + h * 64 + c) : (c < 192 ? (P_B + g * 128 + (c - 64)) : (P_C + g * 128 + (c - 192)));
            raw[tt * 320 + c] = t >= 0 ? bf2f(a.P[((size_t)b * SEQ + t) * PW + col]) : 0.f;
        }
        if (tid < TT) {
            const float v = a.DT[((size_t)b * SEQ + t0 + tid) * 16 + h] + dtb;
            const float dt = v > 20.f ? v : log1pf(__expf(v));
            dts[tid] = dt; decs[tid] = __expf(dt * A);
        }
        __syncthreads();
        for (int e = tid; e < TT * 320; e += NTHR) {
            const int tt = e / 320, c = e % 320;
            const int col = c < 64 ? (P_XS + h * 64 + c) : (c < 192 ? (P_B + g * 128 + (c - 64)) : (P_C + g * 128 + (c - 192)));
            float v = a.conv_b[col];
#pragma unroll
            for (int k = 0; k < 4; ++k) v += a.conv_w[k * 1536 + col] * raw[(tt + k) * 320 + c];
            act[tt * 320 + c] = siluf(v);
        }
        __syncthreads();
        for (int tt = 0; tt < TT; ++tt) {
            const float* at = act + tt * 320;
            const float xv = at[p], xdt = xv * dts[tt], dec = decs[tt];
            float yp = 0.f;
#pragma unroll
            for (int i = 0; i < 16; ++i) {
                S[i] = dec * S[i] + xdt * at[64 + ng * 16 + i];
                yp += at[192 + ng * 16 + i] * S[i];
            }
            yp += __shfl_xor(yp, 1); yp += __shfl_xor(yp, 2); yp += __shfl_xor(yp, 4);
            if (ng == 0) {
                const float y = yp + Dk * xv;
                const size_t zi = ((size_t)b * SEQ + t0 + tt) * ZYW + h * 64 + p;
                const float z = bf2f(a.ZY[zi]);
                const float gg = y * siluf(z);
                a.ZY[zi] = f2bf(gg);
                gq[tt * 64 + p] = gg * gg;
            }
        }
        __syncthreads();
        if (tid < TT) { float s = 0.f; for (int i = 0; i < 64; ++i) s += gq[tid * 64 + i]; a.SSQH[((size_t)b * SEQ + t0 + tid) * 16 + h] = s; }
        __syncthreads();
    }
}
__device__ __forceinline__ void ssd_norm_row(bf16* ZY, const float* __restrict__ SSQH, const float* __restrict__ nw, int row, int lane, bf16* yo, int yp) {
    float v[16], s0 = 0.f, s1 = 0.f;
#pragma unroll
    for (int j = 0; j < 16; ++j) { v[j] = bf2f(ZY[(size_t)row * ZYW + j * 64 + lane]); if (j < 8) s0 += v[j] * v[j]; else s1 += v[j] * v[j]; }
    s0 = wave_sum(s0); s1 = wave_sum(s1);
    const float r0 = rsqrtf(s0 * (1.f / 512.f) + EPS), r1 = rsqrtf(s1 * (1.f / 512.f) + EPS);
#pragma unroll
    for (int j = 0; j < 16; ++j) { const int c = j * 64 + lane; yo[(size_t)row * yp + c] = f2bf(v[j] * (j < 8 ? r0 : r1) * nw[c]); }
}

struct AttnArgs { const bf16* P; bf16* ZY; const float* sinks; };
__device__ __forceinline__ void attn_naive_unit(const AttnArgs& a, int unit, float* sm, bf16* yref) {
    float* Ks = sm;
    float* Vs = sm + 256 * 64;
    const int nb = unit & 15, g = (unit >> 4) & 1, b = unit >> 5, tid = opaque_tid();
    const int r = tid >> 7, qi = tid & 127;
    for (int e = tid; e < 256 * 64; e += NTHR) {
        const int kr = e >> 6, d = e & 63, t = (nb - 1) * 128 + kr;
        float kv = 0.f, vv = 0.f;
        if (t >= 0) { const size_t base = ((size_t)b * SEQ + t) * PW; kv = bf2f(a.P[base + P_K + g * 64 + d]); vv = bf2f(a.P[base + P_V + g * 64 + d]); }
        Ks[e] = kv; Vs[e] = vv;
    }
    __syncthreads();
    const int t = nb * 128 + qi;
    const size_t prow = ((size_t)b * SEQ + t) * PW;
    float q[64], o[64];
#pragma unroll
    for (int d = 0; d < 64; ++d) { q[d] = bf2f(a.P[prow + P_Q + g * 256 + r * 64 + d]) * 0.125f; o[d] = 0.f; }
    float mx = -1e30f, l = 0.f;
    const int jlo = (t - 127 < 0) ? 0 : t - 127;
    for (int tj = jlo; tj <= t; ++tj) {
        const int kr = tj - (nb - 1) * 128;
        const float* kp = Ks + kr * 64;
        float s = 0.f;
#pragma unroll
        for (int d = 0; d < 64; ++d) s += q[d] * kp[d];
        const float mn = fmaxf(mx, s), f = __expf(mx - mn), pe = __expf(s - mn);
        l = l * f + pe;
        const float* vp = Vs + kr * 64;
#pragma unroll
        for (int d = 0; d < 64; ++d) o[d] = o[d] * f + pe * vp[d];
        mx = mn;
    }
    const float sk = a.sinks[g * 4 + r];
    const float mn = fmaxf(mx, sk), f = __expf(mx - mn);
    l = l * f + __expf(sk - mn);
    const float inv = f / l;
    const size_t zrow = ((size_t)b * SEQ + t) * ZYW + 1024 + g * 256 + r * 64;
#pragma unroll
    for (int d = 0; d < 64; ++d) { const float z = bf2f(a.ZY[zrow + d]); yref[((size_t)b * SEQ + t) * 512 + g * 256 + r * 64 + d] = f2bf(o[d] * inv * siluf(z)); }
    __syncthreads();
}


typedef short bf16x8 __attribute__((ext_vector_type(8)));
typedef short s16x4 __attribute__((ext_vector_type(4)));
typedef float f32x16 __attribute__((ext_vector_type(16)));
#define LAS __attribute__((address_space(3)))
__device__ __forceinline__ int crow(int r, int hi) { return (r & 3) + 8 * (r >> 2) + 4 * hi; }
constexpr int AT_KP = 144, AT_VP = 520;
constexpr int AT_K = 0, AT_V = 256 * AT_KP, AT_W = AT_V + 64 * AT_VP;
__device__ __forceinline__ void attn_unit(const AttnArgs& a, int unit, LAS unsigned char* lds, bf16* ybase, int ypitch) {
    const int tid = opaque_tid(), lane = tid & 63, wid = __builtin_amdgcn_readfirstlane(tid >> 6), c32 = lane & 31, hi = lane >> 5;
    const int nb = unit & 15, g = (unit >> 4) & 1, b = unit >> 5;
    for (int e = tid; e < 2048; e += NTHR) {
        const int key = e >> 3, ch = e & 7, t = (nb - 1) * 128 + key;
        u32x4 kv = {0u, 0u, 0u, 0u}, vv = {0u, 0u, 0u, 0u};
        if (t >= 0) { const bf16* base = a.P + ((size_t)b * SEQ + t) * PW; kv = *(const u32x4*)(base + P_K + g * 64 + ch * 8); vv = *(const u32x4*)(base + P_V + g * 64 + ch * 8); }
        *(LAS u32x4*)(lds + AT_K + key * AT_KP + ch * 16) = kv;
#pragma unroll
        for (int i = 0; i < 4; ++i) {
            *(LAS unsigned short*)(lds + AT_V + (ch * 8 + 2 * i) * AT_VP + key * 2) = (unsigned short)(vv[i] & 0xffffu);
            *(LAS unsigned short*)(lds + AT_V + (ch * 8 + 2 * i + 1) * AT_VP + key * 2) = (unsigned short)(vv[i] >> 16);
        }
    }
    __syncthreads();
    LAS float* wsf = (LAS float*)(lds + AT_W) + wid * 32;
    const float C2 = 0.125f * 1.4426950408889634f, NEG = -1e30f;
#pragma unroll 1
    for (int gi2 = 0; gi2 < 2; ++gi2) {
        const int gi = wid + 8 * gi2, head = gi >> 2, qo = (gi & 3) * 32;
        const size_t tok0 = (size_t)b * SEQ + nb * 128 + qo;
        const bf16* qp = a.P + (tok0 + c32) * PW + P_Q + g * 256 + head * 64 + hi * 8;
        bf16x8 qf[4];
#pragma unroll
        for (int ks = 0; ks < 4; ++ks) qf[ks] = *(const bf16x8*)(qp + ks * 16);
        f32x16 S[5];
#pragma unroll
        for (int j = 0; j < 5; ++j) {
            f32x16 acc = {0.f, 0.f, 0.f, 0.f, 0.f, 0.f, 0.f, 0.f, 0.f, 0.f, 0.f, 0.f, 0.f, 0.f, 0.f, 0.f};
#pragma unroll
            for (int ks = 0; ks < 4; ++ks) {
                const bf16x8 kf = *(const LAS bf16x8*)(lds + AT_K + (qo + 32 * j + c32) * AT_KP + ks * 32 + hi * 16);
                acc = __builtin_amdgcn_mfma_f32_32x32x16_bf16(kf, qf[ks], acc, 0, 0, 0);
            }
            S[j] = acc;
        }
        float mx = NEG;
#pragma unroll
        for (int j = 0; j < 5; ++j) {
            const bool dead = (nb == 0) && (qo + 32 * j < 128);
#pragma unroll
            for (int r = 0; r < 16; ++r) {
                float v = S[j][r] * C2;
                const int kr = crow(r, hi);
                if (j == 0 && !(kr > c32)) v = NEG;
                if (j == 4 && !(kr <= c32)) v = NEG;
                if (dead) v = NEG;
                S[j][r] = v; mx = fmaxf(mx, v);
            }
        }
        mx = fmaxf(mx, __shfl_xor(mx, 32));
        const float sink2 = a.sinks[g * 4 + head] * 1.4426950408889634f;
        mx = fmaxf(mx, sink2);
        float l = 0.f;
#pragma unroll
        for (int j = 0; j < 5; ++j)
#pragma unroll
            for (int r = 0; r < 16; ++r) { const float pe = __builtin_amdgcn_exp2f(S[j][r] - mx); l += pe; S[j][r] = pe; }
        l += __shfl_xor(l, 32);
        l += __builtin_amdgcn_exp2f(sink2 - mx);
        if (hi == 0) wsf[c32] = 1.f / l;
        f32x16 o[2];
#pragma unroll
        for (int dh = 0; dh < 2; ++dh) o[dh] = (f32x16){0.f, 0.f, 0.f, 0.f, 0.f, 0.f, 0.f, 0.f, 0.f, 0.f, 0.f, 0.f, 0.f, 0.f, 0.f, 0.f};
#pragma unroll
        for (int j = 0; j < 5; ++j)
#pragma unroll
            for (int s2 = 0; s2 < 2; ++s2) {
                u32x4 pw;
                pw.x = pg8::cvt_pk_bf16(S[j][8 * s2 + 0], S[j][8 * s2 + 1]); pw.y = pg8::cvt_pk_bf16(S[j][8 * s2 + 2], S[j][8 * s2 + 3]);
                pw.z = pg8::cvt_pk_bf16(S[j][8 * s2 + 4], S[j][8 * s2 + 5]); pw.w = pg8::cvt_pk_bf16(S[j][8 * s2 + 6], S[j][8 * s2 + 7]);
                const bf16x8 pa = __builtin_bit_cast(bf16x8, pw);
#pragma unroll
                for (int dh = 0; dh < 2; ++dh) {
                    const LAS unsigned char* vp = lds + AT_V + (dh * 32 + c32) * AT_VP + (qo + 32 * j + 16 * s2 + 4 * hi) * 2;
                    const s16x4 v0 = *(const LAS s16x4*)vp, v1 = *(const LAS s16x4*)(vp + 16);
                    const bf16x8 vf = {v0[0], v0[1], v0[2], v0[3], v1[0], v1[1], v1[2], v1[3]};
                    o[dh] = __builtin_amdgcn_mfma_f32_32x32x16_bf16(pa, vf, o[dh], 0, 0, 0);
                }
            }
#pragma unroll
        for (int r = 0; r < 16; ++r) {
            const int qr = crow(r, hi);
            const float inv = wsf[qr];
            const bf16* zp = a.ZY + (tok0 + qr) * ZYW + 1024 + g * 256 + head * 64 + c32;
            bf16* yp = ybase + (tok0 + qr) * ypitch + g * 256 + head * 64 + c32;
#pragma unroll
            for (int dh = 0; dh < 2; ++dh) { const float z = bf2f(zp[dh * 32]); yp[dh * 32] = f2bf(o[dh][r] * inv * siluf(z)); }
        }
    }
    __syncthreads();
}


typedef short v4i16_t __attribute__((ext_vector_type(4)));
typedef unsigned u32x2 __attribute__((ext_vector_type(2)));
constexpr int SD_BP = 272, SD_XP = 144;
constexpr int SD_BM = 0, SD_CM = SD_BM + 128 * SD_BP, SD_XT = SD_CM + 128 * SD_BP, SD_SL = SD_XT + 64 * SD_BP, SD_XS = SD_SL + 64 * SD_BP, SD_ZT = SD_XS + 128 * SD_XP, SD_F = SD_ZT + 128 * SD_XP;
constexpr int SD_ACS = SD_F, SD_DTE = SD_F + 1024, SD_DTL = SD_F + 2048, SD_SQ = SD_F + 3072  , SD_CW = SD_F + 4096, SD_END = SD_CW + 5 * 320 * 4;
static_assert(SD_END <= MISC_OFF, "SSD LDS map");
__device__ __forceinline__ float softplusf(float v) { return v > 20.f ? v : log1pf(__expf(v)); }
__device__ __forceinline__ void ssd_dt_chunk(const SsdArgs& a, LAS unsigned char* lds, size_t row0, int h, int par, int lane, float A2, float dtb) {
    LAS float* acs2 = (LAS float*)(lds + SD_ACS) + par * 128; LAS float* dte = (LAS float*)(lds + SD_DTE) + par * 128; LAS float* dtl = (LAS float*)(lds + SD_DTL) + par * 128;
    const float d0 = softplusf(a.DT[(row0 + 2 * lane) * 16 + h] + dtb), d1 = softplusf(a.DT[(row0 + 2 * lane + 1) * 16 + h] + dtb);
    const float a0 = d0 * A2, a1 = d1 * A2, sp = a0 + a1;
    float incl = sp;
#pragma unroll
    for (int o = 1; o < 64; o <<= 1) { const float tv = __shfl_up(incl, o); if (lane >= o) incl += tv; }
    const float c0v = incl - a1, tot = __shfl(incl, 63);
    dtl[2 * lane] = d0; dtl[2 * lane + 1] = d1;
    acs2[2 * lane] = c0v; acs2[2 * lane + 1] = incl;
    dte[2 * lane] = __builtin_amdgcn_exp2f(tot - c0v); dte[2 * lane + 1] = __builtin_amdgcn_exp2f(tot - incl);
}
__device__ __forceinline__ void ssd_unit(const SsdArgs& a, int unit, LAS unsigned char* lds, bf16* ybase, int ypitch, float* ssqh) {
    const int tid = opaque_tid(), lane = tid & 63, wid = __builtin_amdgcn_readfirstlane(tid >> 6), c32 = lane & 31, hi = lane >> 5;
    const int b = unit >> 4, h = unit & 15, g = h >> 3;
    const float LOG2E = 1.4426950408889634f;
    const float A2 = -__expf(a.a_log[h]) * LOG2E, Dk = a.dskip[h], dtb = a.dt_bias[h];
    LAS float* cwl = (LAS float*)(lds + SD_CW);
    for (int e = tid; e < 5 * 320; e += NTHR) {
        const int k = e / 320, c = e - k * 320;
        const int col = c < 64 ? (P_XS + h * 64 + c) : (c < 192 ? (P_B + g * 128 + (c - 64)) : (P_C + g * 128 + (c - 192)));
        cwl[e] = k < 4 ? a.conv_w[k * 1536 + col] : a.conv_b[col];
    }
    for (int e = tid; e < 64 * SD_BP / 4; e += NTHR) ((LAS unsigned*)(lds + SD_SL))[e] = 0u;
    if (wid == 7) ssd_dt_chunk(a, lds, (size_t)b * SEQ, h, 0, lane, A2, dtb);
    const int it = wid >> 1, ph = wid & 1, pt = wid >> 2, nt = wid & 3;
    f32x16 St = {0.f, 0.f, 0.f, 0.f, 0.f, 0.f, 0.f, 0.f, 0.f, 0.f, 0.f, 0.f, 0.f, 0.f, 0.f, 0.f};
    __syncthreads();
#pragma unroll 1
    for (int ch = 0; ch < SEQ / 128; ++ch) {
        const int t0 = ch * 128, par = ch & 1;
        const size_t row0 = (size_t)b * SEQ + t0;
        const LAS float* acs2 = (const LAS float*)(lds + SD_ACS) + par * 128; const LAS float* dte = (const LAS float*)(lds + SD_DTE) + par * 128; const LAS float* dtl = (const LAS float*)(lds + SD_DTL) + par * 128;
        if (wid < 5) {
            const int tg = tid / 40, cc = tid - tg * 40, j0 = tg * 16;
            const int col = cc < 8 ? (P_XS + h * 64 + cc * 8) : (cc < 24 ? (P_B + g * 128 + (cc - 8) * 8) : (P_C + g * 128 + (cc - 24) * 8));
            const bf16* src = a.P + ((size_t)b * SEQ) * PW + col;
            u32x4 raw[19];
#pragma unroll
            for (int k = 0; k < 19; ++k) {
                const int t = t0 + j0 - 3 + k;
                raw[k] = (u32x4){0u, 0u, 0u, 0u};
                if (t >= 0) raw[k] = *(const u32x4*)(src + (size_t)t * PW);
            }
            const int dstb = cc < 8 ? (SD_XS + cc * 16) : (cc < 24 ? (SD_BM + (cc - 8) * 16) : (SD_CM + (cc - 24) * 16));
            const int dpitch = cc < 8 ? SD_XP : SD_BP;
            LAS unsigned char* dst = lds + dstb + j0 * dpitch;
#pragma unroll
            for (int e2 = 0; e2 < 4; ++e2) {
                const int c0 = cc * 8 + 2 * e2;
                float w0[5], w1[5];
#pragma unroll
                for (int k = 0; k < 5; ++k) { w0[k] = cwl[k * 320 + c0]; w1[k] = cwl[k * 320 + c0 + 1]; }
                float x0[19], x1[19];
#pragma unroll
                for (int k = 0; k < 19; ++k) { x0[k] = bflo(raw[k][e2]); x1[k] = bfhi(raw[k][e2]); }
#pragma unroll
                for (int q4 = 0; q4 < 4; ++q4) {
                    float y0[4], y1[4];
#pragma unroll
                    for (int q = 0; q < 4; ++q) {
                        const int tt = 4 * q4 + q;
                        float v0 = w0[4], v1 = w1[4];
#pragma unroll
                        for (int k = 0; k < 4; ++k) { v0 += w0[k] * x0[tt + k]; v1 += w1[k] * x1[tt + k]; }
                        y0[q] = siluf(v0); y1[q] = siluf(v1);
                        *(LAS unsigned*)(dst + tt * dpitch + e2 * 4) = pg8::cvt_pk_bf16(y0[q], y1[q]);
                    }
                    if (cc < 8) {
                        const f32x4 d4 = *(const LAS f32x4*)(dtl + j0 + 4 * q4);
                        u32x2 q0, q1;
                        q0.x = pg8::cvt_pk_bf16(y0[0] * d4[0], y0[1] * d4[1]); q0.y = pg8::cvt_pk_bf16(y0[2] * d4[2], y0[3] * d4[3]);
                        q1.x = pg8::cvt_pk_bf16(y1[0] * d4[0], y1[1] * d4[1]); q1.y = pg8::cvt_pk_bf16(y1[2] * d4[2], y1[3] * d4[3]);
                        *(LAS u32x2*)(lds + SD_XT + c0 * SD_BP + (j0 + 4 * q4) * 2) = q0;
                        *(LAS u32x2*)(lds + SD_XT + (c0 + 1) * SD_BP + (j0 + 4 * q4) * 2) = q1;
                    }
                }
            }
        } else {
            const int t3 = tid - 320;
            u32x4 yv[6], zv[6];
#pragma unroll
            for (int q = 0; q < 6; ++q) {
                const int e = t3 + 192 * q, r = e >> 3, c8 = e & 7;
                if (e < 1024) {
                    zv[q] = *(const u32x4*)(a.ZY + (row0 + r) * ZYW + h * 64 + c8 * 8);
                    yv[q] = *(const LAS u32x4*)(lds + SD_ZT + r * SD_XP + c8 * 16);
                }
            }
#pragma unroll
            for (int q = 0; q < 6; ++q) {
                const int e = t3 + 192 * q, r = e >> 3, c8 = e & 7;
                if (e < 1024) {
                    if (ch > 0) *(u32x4*)(ybase + (row0 - 128 + r) * ypitch + h * 64 + c8 * 8) = yv[q];
                    *(LAS u32x4*)(lds + SD_ZT + r * SD_XP + c8 * 16) = zv[q];
                }
            }
            if (wid == 7 && ch + 1 < SEQ / 128) ssd_dt_chunk(a, lds, row0 + 128, h, par ^ 1, lane, A2, dtb);
        }
        __syncthreads();
        {
            bf16x8 cf[8];
#pragma unroll
            for (int ks = 0; ks < 8; ++ks) cf[ks] = *(const LAS bf16x8*)(lds + SD_CM + (32 * it + c32) * SD_BP + ks * 32 + hi * 16);
            f32x16 Yd = {0.f, 0.f, 0.f, 0.f, 0.f, 0.f, 0.f, 0.f, 0.f, 0.f, 0.f, 0.f, 0.f, 0.f, 0.f, 0.f};
            const float ai = acs2[32 * it + c32];
#pragma unroll
            for (int jt = 0; jt < 4; ++jt) {
                if (jt <= it) {
                    f32x16 X = {0.f, 0.f, 0.f, 0.f, 0.f, 0.f, 0.f, 0.f, 0.f, 0.f, 0.f, 0.f, 0.f, 0.f, 0.f, 0.f};
#pragma unroll
                    for (int ks = 0; ks < 8; ++ks) {
                        const bf16x8 bfr = *(const LAS bf16x8*)(lds + SD_BM + (32 * jt + c32) * SD_BP + ks * 32 + hi * 16);
                        X = __builtin_amdgcn_mfma_f32_32x32x16_bf16(bfr, cf[ks], X, 0, 0, 0);
                    }
#pragma unroll
                    for (int r4 = 0; r4 < 4; ++r4) {
                        const f32x4 aj = *(const LAS f32x4*)(acs2 + 32 * jt + 8 * r4 + 4 * hi);
#pragma unroll
                        for (int q = 0; q < 4; ++q) {
                            const int r = 4 * r4 + q, jr = 8 * r4 + 4 * hi + q;
                            float f = __builtin_amdgcn_exp2f(ai - aj[q]);
                            if (jt == it && jr > c32) f = 0.f;
                            X[r] *= f;
                        }
                    }
#pragma unroll
                    for (int s2 = 0; s2 < 2; ++s2) {
                        u32x4 pw;
                        pw.x = pg8::cvt_pk_bf16(X[8 * s2 + 0], X[8 * s2 + 1]); pw.y = pg8::cvt_pk_bf16(X[8 * s2 + 2], X[8 * s2 + 3]);
                        pw.z = pg8::cvt_pk_bf16(X[8 * s2 + 4], X[8 * s2 + 5]); pw.w = pg8::cvt_pk_bf16(X[8 * s2 + 6], X[8 * s2 + 7]);
                        const LAS unsigned char* vp = lds + SD_XT + (32 * ph + c32) * SD_BP + (32 * jt + 16 * s2 + 4 * hi) * 2;
                        const s16x4 v0 = *(const LAS s16x4*)vp, v1 = *(const LAS s16x4*)(vp + 16);
                        const bf16x8 vf = {v0[0], v0[1], v0[2], v0[3], v1[0], v1[1], v1[2], v1[3]};
                        Yd = __builtin_amdgcn_mfma_f32_32x32x16_bf16(__builtin_bit_cast(bf16x8, pw), vf, Yd, 0, 0, 0);
                    }
                }
            }
            f32x16 Yo = {0.f, 0.f, 0.f, 0.f, 0.f, 0.f, 0.f, 0.f, 0.f, 0.f, 0.f, 0.f, 0.f, 0.f, 0.f, 0.f};
#pragma unroll
            for (int ks = 0; ks < 8; ++ks) {
                const bf16x8 sf = *(const LAS bf16x8*)(lds + SD_SL + (32 * ph + c32) * SD_BP + ks * 32 + hi * 16);
                Yo = __builtin_amdgcn_mfma_f32_32x32x16_bf16(cf[ks], sf, Yo, 0, 0, 0);
            }
            const int pcol = 32 * ph + c32;
#pragma unroll
            for (int r4 = 0; r4 < 4; ++r4) {
                const f32x4 ac = *(const LAS f32x4*)(acs2 + 32 * it + 8 * r4 + 4 * hi);
#pragma unroll
                for (int q = 0; q < 4; ++q) {
                    const int r = 4 * r4 + q, i = 32 * it + 8 * r4 + 4 * hi + q;
                    const float xs = bf2f(*(const LAS unsigned short*)(lds + SD_XS + i * SD_XP + pcol * 2));
                    const float y = Yd[r] + __builtin_amdgcn_exp2f(ac[q]) * Yo[r] + Dk * xs;
                    LAS unsigned short* zp = (LAS unsigned short*)(lds + SD_ZT + i * SD_XP + pcol * 2);
                    const float gg = y * siluf(bf2f(*zp));
                    *zp = f2bf(gg);
                    float sq = gg * gg;
                    sq += __shfl_xor(sq, 1); sq += __shfl_xor(sq, 2); sq += __shfl_xor(sq, 4); sq += __shfl_xor(sq, 8); sq += __shfl_xor(sq, 16);
                    if (c32 == 0) ((LAS float*)(lds + SD_SQ))[ph * 128 + i] = sq;
                }
            }
        }
        __syncthreads();
        if (ssqh != nullptr && tid < 128) ssqh[(row0 + tid) * 16 + h] = ((const LAS float*)(lds + SD_SQ))[tid] + ((const LAS float*)(lds + SD_SQ))[128 + tid];
        {
            const float dec = __builtin_amdgcn_exp2f(acs2[127]);
#pragma unroll
            for (int r = 0; r < 16; ++r) St[r] *= dec;
            const int i16 = lane & 15, gsel = (lane >> 4) & 1;
#pragma unroll
            for (int ks = 0; ks < 8; ++ks) {
                const u32x4 xr = *(const LAS u32x4*)(lds + SD_XT + (32 * pt + c32) * SD_BP + ks * 32 + hi * 16);
                const f32x4 f0 = *(const LAS f32x4*)(dte + 16 * ks + 8 * hi), f1 = *(const LAS f32x4*)(dte + 16 * ks + 8 * hi + 4);
                u32x4 aw;
                aw.x = pg8::cvt_pk_bf16(bflo(xr.x) * f0[0], bfhi(xr.x) * f0[1]); aw.y = pg8::cvt_pk_bf16(bflo(xr.y) * f0[2], bfhi(xr.y) * f0[3]);
                aw.z = pg8::cvt_pk_bf16(bflo(xr.z) * f1[0], bfhi(xr.z) * f1[1]); aw.w = pg8::cvt_pk_bf16(bflo(xr.w) * f1[2], bfhi(xr.w) * f1[3]);
                const LAS unsigned char* bp = lds + SD_BM + (16 * ks + 8 * hi + (i16 >> 2)) * SD_BP + (32 * nt + 16 * gsel + 4 * (i16 & 3)) * 2;
                const v4i16_t t0v = __builtin_amdgcn_ds_read_tr16_b64_v4i16((LAS v4i16_t*)bp);
                const v4i16_t t1v = __builtin_amdgcn_ds_read_tr16_b64_v4i16((LAS v4i16_t*)(bp + 4 * SD_BP));
                const bf16x8 bfr = {t0v[0], t0v[1], t0v[2], t0v[3], t1v[0], t1v[1], t1v[2], t1v[3]};
                St = __builtin_amdgcn_mfma_f32_32x32x16_bf16(__builtin_bit_cast(bf16x8, aw), bfr, St, 0, 0, 0);
            }
#pragma unroll
            for (int r = 0; r < 16; ++r) *(LAS unsigned short*)(lds + SD_SL + (32 * pt + crow(r, hi)) * SD_BP + (32 * nt + c32) * 2) = f2bf(St[r]);
        }
        __syncthreads();
    }
    for (int e = tid; e < 1024; e += NTHR) {
        const int r = e >> 3, c8 = e & 7;
        *(u32x4*)(ybase + ((size_t)b * SEQ + SEQ - 128 + r) * ypitch + h * 64 + c8 * 8) = *(const LAS u32x4*)(lds + SD_ZT + r * SD_XP + c8 * 16);
    }
    __syncthreads();
}

struct ConfArgs { const bf16* P; bf16* ZY; const float* dw_w; const float* dw_b; const float* ln_w; const float* ln_b; };
__device__ __forceinline__ void conf_naive_unit(const ConfArgs& a, int unit, float* sm) {
    constexpr int TT = 16;
    float* glu = sm;
    float* outb = sm + (TT + 30) * 512;
    const int b = unit >> 7, t0 = (unit & 127) * TT, c = opaque_tid(), lane = c & 63, w = c >> 6;
    for (int tt = 0; tt < TT + 30; ++tt) {
        const int t = t0 - 30 + tt;
        float v = 0.f;
        if (t >= 0) { const size_t base = ((size_t)b * SEQ + t) * PW; v = bf2f(a.P[base + P_CA + c]) * sigmf(bf2f(a.P[base + P_CG + c])); }
        glu[tt * 512 + c] = v;
    }
    float wk[31];
#pragma unroll
    for (int k = 0; k < 31; ++k) wk[k] = a.dw_w[k * 512 + c];
    const float bias = a.dw_b[c];
    for (int tt = 0; tt < TT; ++tt) {
        float v = bias;
#pragma unroll
        for (int k = 0; k < 31; ++k) v += wk[k] * glu[(tt + k) * 512 + c];
        outb[tt * 512 + c] = v;
    }
    __syncthreads();
    for (int tt = w * 2; tt < w * 2 + 2; ++tt) {
        float v[8], s = 0.f;
#pragma unroll
        for (int j = 0; j < 8; ++j) { v[j] = outb[tt * 512 + j * 64 + lane]; s += v[j]; }
        const float mean = wave_sum(s) * (1.f / 512.f);
        float s2 = 0.f;
#pragma unroll
        for (int j = 0; j < 8; ++j) { v[j] -= mean; s2 += v[j] * v[j]; }
        const float rstd = rsqrtf(wave_sum(s2) * (1.f / 512.f) + EPS);
        const size_t zrow = ((size_t)b * SEQ + t0 + tt) * ZYW + 1536;
#pragma unroll
        for (int j = 0; j < 8; ++j) {
            const int ch = j * 64 + lane;
            const float y = siluf(v[j] * rstd * a.ln_w[ch] + a.ln_b[ch]);
            const float z = bf2f(a.ZY[zrow + ch]);
            a.ZY[zrow + ch] = f2bf(y * siluf(z));
        }
    }
    __syncthreads();
}


typedef float f32x2 __attribute__((ext_vector_type(2)));
constexpr int CF_TT = 64, CF_ROWS = CF_TT + 30, CF_GLU = 0, CF_OUT = CF_ROWS * 1024, CF_END = CF_OUT + CF_TT * 1024;
static_assert(CF_END <= MISC_OFF, "conformer LDS map");
__device__ __forceinline__ void conf_unit(const ConfArgs& a, int unit, LAS unsigned char* lds, bf16* ybase, int ypitch) {
    const int tid = opaque_tid(), lane = tid & 63, wid = __builtin_amdgcn_readfirstlane(tid >> 6);
    const int b = unit >> 5, t0 = (unit & 31) * CF_TT;
#pragma unroll 2
    for (int item = tid; item < CF_ROWS * 64; item += NTHR) {
        const int row = item >> 6, c8 = item & 63, t = t0 - 30 + row;
        u32x4 o = {0u, 0u, 0u, 0u};
        if (t >= 0) {
            const bf16* base = a.P + ((size_t)b * SEQ + t) * PW;
            const u32x4 va = *(const u32x4*)(base + P_CA + c8 * 8), vg = *(const u32x4*)(base + P_CG + c8 * 8);
#pragma unroll
            for (int e = 0; e < 4; ++e) o[e] = pg8::cvt_pk_bf16(bflo(va[e]) * sigmf(bflo(vg[e])), bfhi(va[e]) * sigmf(bfhi(vg[e])));
        }
        *(LAS u32x4*)(lds + CF_GLU + row * 1024 + c8 * 16) = o;
    }
    __syncthreads();
    {
        const int cp = tid & 255, th = tid >> 8;
        f32x2 w2[31];
#pragma unroll
        for (int k = 0; k < 31; ++k) w2[k] = *(const f32x2*)(a.dw_w + k * 512 + 2 * cp);
        const f32x2 bias2 = *(const f32x2*)(a.dw_b + 2 * cp);
#pragma unroll 1
        for (int bb = 0; bb < 2; ++bb) {
            const int r0 = th * 32 + bb * 16;
            f32x2 acc[16];
#pragma unroll
            for (int o = 0; o < 16; ++o) acc[o] = bias2;
#pragma unroll
            for (int r = 0; r < 46; ++r) {
                const unsigned xw = *(const LAS unsigned*)(lds + CF_GLU + (r0 + r) * 1024 + cp * 4);
                const f32x2 x2 = {bflo(xw), bfhi(xw)};
#pragma unroll
                for (int o = 0; o < 16; ++o) { if (r - o >= 0 && r - o <= 30) acc[o] += w2[r - o] * x2; }
            }
#pragma unroll
            for (int o = 0; o < 16; ++o) *(LAS unsigned*)(lds + CF_OUT + (r0 + o) * 1024 + cp * 4) = pg8::cvt_pk_bf16(acc[o].x, acc[o].y);
        }
    }
    __syncthreads();
    {
        const f32x4 lw0 = *(const f32x4*)(a.ln_w + lane * 8), lw1 = *(const f32x4*)(a.ln_w + lane * 8 + 4), lb0 = *(const f32x4*)(a.ln_b + lane * 8), lb1 = *(const f32x4*)(a.ln_b + lane * 8 + 4);
        const float lw[8] = {lw0[0], lw0[1], lw0[2], lw0[3], lw1[0], lw1[1], lw1[2], lw1[3]}, lb[8] = {lb0[0], lb0[1], lb0[2], lb0[3], lb1[0], lb1[1], lb1[2], lb1[3]};
#pragma unroll 2
        for (int q = 0; q < 8; ++q) {
            const int tt = wid * 8 + q;
            const u32x4 xv = *(const LAS u32x4*)(lds + CF_OUT + tt * 1024 + lane * 16);
            const u32x4 zv = *(const u32x4*)(a.ZY + ((size_t)b * SEQ + t0 + tt) * ZYW + 1536 + lane * 8);
            bf16* yp = ybase + ((size_t)b * SEQ + t0 + tt) * ypitch + lane * 8;
            float v[8], s = 0.f, s2 = 0.f;
#pragma unroll
            for (int e = 0; e < 4; ++e) { v[2 * e] = bflo(xv[e]); v[2 * e + 1] = bfhi(xv[e]); }
#pragma unroll
            for (int e = 0; e < 8; ++e) { s += v[e]; s2 += v[e] * v[e]; }
            s = wave_sum(s); s2 = wave_sum(s2);
            const float mean = s * (1.f / 512.f), var = fmaxf(s2 * (1.f / 512.f) - mean * mean, 0.f), rstd = rsqrtf(var + EPS);
            u32x4 ov;
#pragma unroll
            for (int e = 0; e < 4; ++e) {
                const float y0 = siluf((v[2 * e] - mean) * rstd * lw[2 * e] + lb[2 * e]) * siluf(bflo(zv[e]));
                const float y1 = siluf((v[2 * e + 1] - mean) * rstd * lw[2 * e + 1] + lb[2 * e + 1]) * siluf(bfhi(zv[e]));
                ov[e] = pg8::cvt_pk_bf16(y0, y1);
            }
            *(u32x4*)yp = ov;
        }
    }
    __syncthreads();
}

typedef unsigned u32x2f __attribute__((ext_vector_type(2)));
__device__ __forceinline__ void final_norm_rows(const bf16* __restrict__ XB, float* __restrict__ out, const float* __restrict__ w, const float* __restrict__ SSQ, int gw, int NGW, int lane) {
    f32x4 wv[4];
#pragma unroll
    for (int j = 0; j < 4; ++j) wv[j] = *(const f32x4*)(w + 4 * lane + 256 * j);
#pragma unroll 2
    for (int row = gw; row < M; row += NGW) {
        u32x2f xv[4];
#pragma unroll
        for (int j = 0; j < 4; ++j) xv[j] = *(const u32x2f*)(XB + (size_t)row * DM + 4 * lane + 256 * j);
        const float rstd = rsqrtf(wave_sum(lane < 16 ? SSQ[row * 16 + lane] : 0.f) * (1.f / DM) + EPS);
#pragma unroll
        for (int j = 0; j < 4; ++j) {
            const f32x4 o = {bflo(xv[j].x) * rstd * wv[j][0], bfhi(xv[j].x) * rstd * wv[j][1], bflo(xv[j].y) * rstd * wv[j][2], bfhi(xv[j].y) * rstd * wv[j][3]};
            *(f32x4*)(out + (size_t)row * DM + 4 * lane + 256 * j) = o;
        }
    }
}

#define GAS __attribute__((address_space(1)))
typedef GAS unsigned gu32;
#define RLX_AGENT __ATOMIC_RELAXED, __HIP_MEMORY_SCOPE_AGENT
#define XB_TMO      128
#define XB_XCNT(j)  (256  + 64 * (j))
#define XB_XSUB(j)  (1280 + 64 * (j))
#define XB_XGEN(j)  (2304 + 64 * (j))
#define XB_TOP      3328
#define XB_TOPGEN   3392
#define XCD_BAR_WORDS 3456
#define XB_SPIN_CAP (1u << 18)

__device__ __forceinline__ unsigned xb_ld(unsigned* p)              { return __hip_atomic_load(p, __ATOMIC_RELAXED, __HIP_MEMORY_SCOPE_AGENT); }
__device__ __forceinline__ unsigned xb_add(unsigned* p, unsigned v) { return __hip_atomic_fetch_add(p, v, __ATOMIC_RELAXED, __HIP_MEMORY_SCOPE_AGENT); }
__device__ __forceinline__ unsigned xb_xcc_id() { return (unsigned)__builtin_amdgcn_s_getreg((3 << 11) | 20) & 0xFu; }
#define XB_SPIN(cond, bar) do { unsigned _sp = 0; while (cond) { __builtin_amdgcn_s_sleep(1); \
    if ((++_sp & 255u) == 0u) { if (xb_ld(&(bar)[XB_TMO])) break; if (_sp > XB_SPIN_CAP) { atomicAdd(&(bar)[XB_TMO], 1u); break; } } } } while (0)

struct XcdBarrier {
    unsigned* bar; unsigned x;
    volatile LAS unsigned* st;
};

__device__ __forceinline__ XcdBarrier xcd_barrier_post(unsigned* bar, volatile LAS unsigned* st) {
    XcdBarrier b; b.bar = bar; b.x = xb_xcc_id(); b.st = st;
    if (threadIdx.x == 0) (void)xb_add(&bar[XB_XCNT(b.x)], 1u);
    return b;
}
__device__ __forceinline__ void xcd_barrier_complete(unsigned* bar, unsigned x, unsigned& nloc, unsigned& nx) {
    const unsigned G = gridDim.x * gridDim.y * gridDim.z;
    unsigned sum, cnt, mine, sp = 0u;
    for (;;) {
        sum = 0u; cnt = 0u; mine = 0u;
#pragma unroll
        for (unsigned j = 0; j < 16; ++j) { const unsigned c = xb_ld(&bar[XB_XCNT(j)]); sum += c; cnt += (c > 0u) ? 1u : 0u; mine = (j == x) ? c : mine; }
        if (sum == G) break;
        __builtin_amdgcn_s_sleep(1);
        if ((++sp & 255u) == 0u) { if (xb_ld(&bar[XB_TMO])) break; if (sp > XB_SPIN_CAP) { atomicAdd(&bar[XB_TMO], 1u); break; } }
    }
    nloc = mine > 0u ? mine : 1u; nx = cnt > 0u ? cnt : 1u;
}

__device__ __forceinline__ void xcd_barrier(const XcdBarrier& b) {
    asm volatile("s_waitcnt vmcnt(0)" ::: "memory");
    __syncthreads();
    if (threadIdx.x == 0) {
        unsigned* bar = b.bar;
        __builtin_amdgcn_s_waitcnt(0);
        unsigned nloc = b.st[0], nx = b.st[1];
        if (nloc == 0u) { xcd_barrier_complete(bar, b.x, nloc, nx); b.st[0] = nloc; b.st[1] = nx; }
        const unsigned old = xb_add(&bar[XB_XSUB(b.x)], 1u);
        const unsigned gen = old / nloc;
        if (old + 1u == (gen + 1u) * nloc) {
            __builtin_amdgcn_fence(__ATOMIC_RELEASE, "agent");
            asm volatile("s_waitcnt vmcnt(0)" ::: "memory");
            const unsigned og = xb_add(&bar[XB_TOP], 1u);
            const unsigned tg = og / nx;
            if (og + 1u == (tg + 1u) * nx) xb_add(&bar[XB_TOPGEN], 1u);
            else XB_SPIN(xb_ld(&bar[XB_TOPGEN]) == tg, bar);
            __builtin_amdgcn_fence(__ATOMIC_ACQUIRE, "agent");
            xb_add(&bar[XB_XGEN(b.x)], 1u);
            asm volatile("s_waitcnt vmcnt(0)" ::: "memory");
        } else {
            XB_SPIN(xb_ld(&bar[XB_XGEN(b.x)]) == gen, bar);
            __builtin_amdgcn_fence(__ATOMIC_ACQUIRE, "agent");
            asm volatile("s_waitcnt vmcnt(0)" ::: "memory");
        }
    }
    __syncthreads();
}

__global__ __launch_bounds__(NTHR, 2) void mega_fwd(Params p) {
    extern __shared__ __attribute__((aligned(16))) unsigned char lds[];
    float* sm = (float*)lds;
    volatile LAS unsigned* MISC = (volatile LAS unsigned*)((LAS unsigned char*)lds + MISC_OFF);
    if (threadIdx.x < 16) MISC[threadIdx.x] = 0u;
    __syncthreads();
    { const XcdBarrier b0 = xcd_barrier_post((unsigned*)(p.ws + WS_CTL) + CW_BAR, MISC + 8); if (threadIdx.x == 0) MISC[10] = b0.x; }
    __syncthreads();
#define GRID_SYNC() do { XcdBarrier b_; b_.bar = (unsigned*)(p.ws + WS_CTL) + CW_BAR; b_.st = MISC + 8; b_.x = MISC[10]; xcd_barrier(b_); } while (0)
    const int bid = blockIdx.x, G = gridDim.x, NGW = G * NWAVE;
#define ROWLOOP(body) do { const int tid_ = opaque_tid(), lane = tid_ & 63, gw_ = bid * NWAVE + __builtin_amdgcn_readfirstlane(tid_ >> 6); for (int row = gw_; row < M; row += NGW) { body; } } while (0)
    const float* x = p.in[0];
    unsigned char* ws = p.ws;
    bf16* Win_t = (bf16*)(ws + WS_WIN); bf16* Wout_t = (bf16*)(ws + WS_WOUT);
    float* SSQ = (float*)(ws + WS_SSQ); float* SSQH = (float*)(ws + WS_SSQH); float* DT = (float*)(ws + WS_DT);
    bf16* XB = (bf16*)(ws + WS_XB); bf16* ZY = (bf16*)(ws + WS_ZY); bf16* P = (bf16*)(ws + WS_P);
    float* out = p.out;

#ifdef DBG_ATTN
    if (bid == 0 && threadIdx.x == 0) *(unsigned*)(ws + WS_CTL) = 0u;
#endif
#if REP_PHASE == 5
    for (int it = bid; it < DEPTH * 88 * 16; it += G) conv_win_tile(p.in[2], p.in[1], Win_t, it, sm);
    for (int it = bid; it < DEPTH * 16 * 32; it += G) conv_wout_tile(p.in[14], p.in[8], Wout_t, it, sm);
    ROWLOOP(normprep_row(x, XB, SSQ, row, lane));
#endif
    for (int it = bid; it < DEPTH * 88 * 16; it += G) conv_win_tile(p.in[2], p.in[1], Win_t, it, sm);
    for (int it = bid; it < DEPTH * 16 * 32; it += G) conv_wout_tile(p.in[14], p.in[8], Wout_t, it, sm);
    ROWLOOP(normprep_row(x, XB, SSQ, row, lane));
    GRID_SYNC();

    for (int l = 0; l < DEPTH; ++l) {
        {
            pg8::Gemm g{XB, Win_t + (size_t)l * NINP * DM, M, NINP, DM}; pg8::StaticOrder S; S.init(M, NINP, G, bid);
            EpiIn E{SSQ, ZY, P, DT};
#if REP_PHASE == 4
            pg8::gemm_phase<EpiIn, pg8::StaticOrder, true, true>((PG8_LAS unsigned char*)lds, g, S, E);
#endif
            pg8::gemm_phase<EpiIn, pg8::StaticOrder, true, true>((PG8_LAS unsigned char*)lds, g, S, E);
        }
        GRID_SYNC();
        {
            SsdArgs sa{P, ZY, DT, SSQH, p.in[3] + l * 4 * 1536, p.in[4] + l * 1536, p.in[5] + l * 16, p.in[6] + l * 16, p.in[7] + l * 16};
#if REP_PHASE == 1
            for (int u = bid; u < BATCH * 16; u += G) ssd_unit(sa, u, (LAS unsigned char*)lds, (bf16*)(ws + 440 * MiB), 1024, nullptr);
#endif
            for (int u = bid; u < BATCH * 16; u += G) ssd_unit(sa, u, (LAS unsigned char*)lds, ZY, ZYW, SSQH);
            AttnArgs aa{P, ZY, p.in[9] + l * 8};
#ifdef DBG_ATTN
            bf16* yref = (bf16*)(ws + 440 * MiB);
            for (int u = bid; u < BATCH * 2 * 16; u += G) attn_naive_unit(aa, u, sm, yref);
#endif
#if REP_PHASE == 2
            for (int u = bid; u < BATCH * 2 * 16; u += G) attn_unit(aa, u, (LAS unsigned char*)lds, (bf16*)(ws + 440 * MiB), 512);
#endif
            for (int u = bid; u < BATCH * 2 * 16; u += G) attn_unit(aa, u, (LAS unsigned char*)lds, ZY + 1024, ZYW);
#ifdef DBG_ATTN
            __syncthreads();
            {
                unsigned bad = 0u;
                for (int u = bid; u < BATCH * 2 * 16; u += G) {
                    const int nb = u & 15, g = (u >> 4) & 1, b = u >> 5;
                    for (int e = opaque_tid(); e < 128 * 256; e += NTHR) {
                        const int qi = e >> 8, c = e & 255; const size_t tok = (size_t)b * SEQ + nb * 128 + qi;
                        const float ref = bf2f(yref[tok * 512 + g * 256 + c]), got = bf2f(ZY[tok * ZYW + 1024 + g * 256 + c]);
                        if (!(fabsf(ref - got) <= 0.02f * fabsf(ref) + 0.01f)) bad = 1u;
                    }
                }
                if (bad) atomicOr((unsigned*)(ws + WS_CTL), 1u);
            }
#endif
            ConfArgs ca{P, ZY, p.in[10] + l * 31 * 512, p.in[11] + l * 512, p.in[12] + l * 512, p.in[13] + l * 512};
#if REP_PHASE == 3
            for (int u = bid; u < BATCH * 32; u += G) conf_unit(ca, u, (LAS unsigned char*)lds, (bf16*)(ws + 440 * MiB), 512);
#endif
            for (int u = bid; u < BATCH * 32; u += G) conf_unit(ca, u, (LAS unsigned char*)lds, ZY + 1536, ZYW);
        }
        GRID_SYNC();
        {
            pg8::Gemm g{ZY, Wout_t + (size_t)l * DM * 2048, M, DM, 2048}; pg8::StaticOrder S; S.init(M, DM, G, bid);
            EpiOut E{l == 0 ? x : nullptr, XB, SSQ, SSQH};
#if REP_PHASE == 6
            if (l == 0) pg8::gemm_phase<EpiOut, pg8::StaticOrder, true, true>((PG8_LAS unsigned char*)lds, g, S, E);
#endif
            pg8::gemm_phase<EpiOut, pg8::StaticOrder, true, true>((PG8_LAS unsigned char*)lds, g, S, E);
        }
        GRID_SYNC();
    }
    { const int tid_ = opaque_tid(); final_norm_rows(XB, out, p.in[15], SSQ, bid * NWAVE + __builtin_amdgcn_readfirstlane(tid_ >> 6), NGW, tid_ & 63); }
#ifdef DBG_ATTN
    GRID_SYNC();
    if (__hip_atomic_load((unsigned*)(ws + WS_CTL), __ATOMIC_RELAXED, __HIP_MEMORY_SCOPE_AGENT) != 0u && threadIdx.x == 0) out[(size_t)bid * 1024] = 1e6f;
#endif
}

extern "C" void kernel_launch(void* const* d_in, const int* in_sizes, int n_in, void* d_out, int out_size, void* d_ws, size_t ws_size, hipStream_t stream) {
    static int grid_blocks = 0;
    if (grid_blocks == 0) {
        if (n_in != 16 || out_size != M * DM || ws_size < WS_END) { fprintf(stderr, "kernel_launch: unexpected shapes (n_in %d out %d ws %zu)\n", n_in, out_size, ws_size); grid_blocks = -1; return; }
        int dev = 0, cus = 0, per_cu = 0;
        (void)hipGetDevice(&dev);
        (void)hipDeviceGetAttribute(&cus, hipDeviceAttributeMultiprocessorCount, dev);
        (void)hipFuncSetAttribute((const void*)mega_fwd, hipFuncAttributeMaxDynamicSharedMemorySize, LDS_BYTES);
        (void)hipOccupancyMaxActiveBlocksPerMultiprocessor(&per_cu, (const void*)mega_fwd, NTHR, LDS_BYTES);
        if (per_cu < 1) { fprintf(stderr, "kernel_launch: occupancy query says %d blocks per CU\n", per_cu); per_cu = 1; }
        grid_blocks = cus * 1;
        fprintf(stderr, "kernel_launch: %d CUs, occupancy %d/CU, grid %d\n", cus, per_cu, grid_blocks);
    }
    if (grid_blocks < 0) return;
    Params p{};
    for (int i = 0; i < 16; ++i) p.in[i] = (const float*)d_in[i];
    p.out = (float*)d_out; p.ws = (unsigned char*)d_ws;
    if (hipMemsetAsync((char*)d_ws + WS_CTL, 0, CTL_ZERO_BYTES, stream) != hipSuccess) { fprintf(stderr, "kernel_launch: memset of the control words failed\n"); return; }
    hipLaunchKernelGGL(mega_fwd, dim3(grid_blocks), dim3(NTHR), LDS_BYTES, stream, p);
    const hipError_t e = hipPeekAtLastError();
    if (e != hipSuccess) fprintf(stderr, "launch failed: %s (grid %d)\n", hipGetErrorString(e), grid_blocks);
}
```

```cpp
#define STAGGER_IN 0
#define SSD_PROBE 0
#define SGB_VALU 10
#define REP_PHASE 0
#include <hip/hip_runtime.h>
#include <cstdint>
#include <cstdio>

typedef unsigned short bf16;

constexpr int BATCH = 16, SEQ = 2048, DM = 1024, DEPTH = 2;
constexpr int M = BATCH * SEQ;
constexpr int NIN = 5392, NINP = 5632;
constexpr int ZYW = 2048;
constexpr int PW = 3328;
constexpr int P_XS = 0, P_B = 1024, P_C = 1280, P_Q = 1536, P_K = 2048, P_V = 2176, P_CA = 2304, P_CG = 2816;
constexpr float EPS = 1e-5f;

constexpr size_t MiB = 1u << 20;
constexpr size_t WS_CTL = 0;
constexpr size_t WS_WIN = 1 * MiB;
constexpr size_t WS_WOUT = 23 * MiB;
constexpr size_t WS_SSQ = 438 * MiB;
constexpr size_t WS_XS = 512 * 1024;
constexpr size_t WS_SSQH = 32 * MiB;
constexpr size_t WS_DT = 34 * MiB;
constexpr size_t WS_XB = 36 * MiB;
constexpr size_t WS_ZY = 100 * MiB;
constexpr size_t WS_P = 228 * MiB;
constexpr size_t WS_BC = 440 * MiB;
constexpr size_t WS_END = 472 * MiB;

__device__ __forceinline__ float bf2f(bf16 v) { return __uint_as_float(((unsigned)v) << 16); }
typedef float f32x2_t_ __attribute__((ext_vector_type(2))); typedef __bf16 bf16x2_t_ __attribute__((ext_vector_type(2)));
__device__ __forceinline__ unsigned cvtpk(float lo, float hi) { const f32x2_t_ v = {lo, hi}; return __builtin_bit_cast(unsigned, __builtin_convertvector(v, bf16x2_t_)); }
__device__ __forceinline__ float bflo(unsigned w) { return __uint_as_float(w << 16); }
__device__ __forceinline__ float bfhi(unsigned w) { return __uint_as_float(w & 0xffff0000u); }
__device__ __forceinline__ bf16 f2bf(float f) { unsigned u = __float_as_uint(f); return (bf16)((u + 0x7fffu + ((u >> 16) & 1u)) >> 16); }
__device__ __forceinline__ float sigmf(float v) { return __builtin_amdgcn_rcpf(1.f + __builtin_amdgcn_exp2f(v * -1.4426950408889634f)); }
__device__ __forceinline__ float siluf(float v) { return v * sigmf(v); }
template <int CTRL, int ROWMASK> __device__ __forceinline__ float dpp_add(float v) {
    return v + __builtin_bit_cast(float, __builtin_amdgcn_update_dpp(0, __builtin_bit_cast(int, v), CTRL, ROWMASK, 0xf, false));
}
__device__ __forceinline__ float half_sum_dpp(float v) {
    v = dpp_add<0x111, 0xf>(v); v = dpp_add<0x112, 0xf>(v); v = dpp_add<0x114, 0xf>(v); v = dpp_add<0x118, 0xf>(v);
    return dpp_add<0x142, 0xa>(v);
}
__device__ __forceinline__ float wave_sum(float v) {
    v = half_sum_dpp(v);
    v = dpp_add<0x143, 0xc>(v);
    return __builtin_bit_cast(float, __builtin_amdgcn_readlane(__builtin_bit_cast(int, v), 63));
}
__device__ __forceinline__ int lane_id() { int l; asm volatile("v_mbcnt_lo_u32_b32 %0, -1, 0\n\tv_mbcnt_hi_u32_b32 %0, -1, %0" : "=v"(l)); return l; }
__device__ __forceinline__ int opaque_tid(int wv) { int t = wv * 64 + lane_id(); asm volatile("" : "+v"(t)); return t; }
__host__ __device__ __forceinline__ int src_col(int np) {
    if (np < 3584) return np;
    if (np < 4352) return np + 16;
    if (np < 5376) { const int q = (np - 4352) >> 8, w = (np - 4352) & 255; return 4368 + (w < 128 ? 128 * q + w : 512 + 128 * q + (w - 128)); }
    return np - 1792;
}

namespace pg8 {
#define PG8_LAS __attribute__((address_space(3)))
typedef unsigned short bf16_t;
typedef short bf16x8 __attribute__((ext_vector_type(8)));
typedef float f32x4 __attribute__((ext_vector_type(4)));
typedef unsigned u32x4 __attribute__((ext_vector_type(4)));
constexpr int BM = 256, BK = 64, HALF = 128, HTB = HALF * BK * 2  , STAGE_BYTES = 8 * HTB, NXCD = 8, WGM = 8;

__host__ __device__ __forceinline__ int lds_byte(int r, int c) { const int st = (r >> 4) * 2 + (c >> 5), rr = r & 15, cc = c & 31, ob = rr * 64 + cc * 2; return st * 1024 + (ob ^ (((ob >> 9) & 1) << 5)); }
__host__ __device__ __forceinline__ void stage_rc(int b, int& R, int& C) { const int st = b / 1024, sb = b % 1024, swz = sb ^ (((sb >> 9) & 1) << 5); R = (st >> 1) * 16 + swz / 64; C = (st & 1) * 32 + (swz % 64) / 2; }
__host__ __device__ __forceinline__ int perm32(int rho) { const int n = rho >> 4, i = rho & 15; return 8 * (i >> 2) + 4 * n + (i & 3); }

struct Unit { int pm, pn; };
struct Gemm { const bf16_t* A; const bf16_t* Bt; int M, N, K; };

struct StaticOrder {
    int nM, nN, nwg, G, c;
    __host__ __device__ void init(int M, int N, int G_, int c_) { nM = M / BM; nN = N / BM; nwg = nM * nN; G = G_; c = c_; }
    __host__ __device__ bool next(int i, Unit& u) const {
        const long L = (long)i * G + c; if (L >= nwg) return false;
        int wgid = (int)L; { const int q = nwg / NXCD, r = nwg % NXCD, xcd = wgid % NXCD, off = wgid / NXCD; wgid = (xcd < r ? xcd * (q + 1) : r * (q + 1) + (xcd - r) * q) + off; }
        const int nig = WGM * nN, gid = wgid / nig, fm = gid * WGM, gsz = (nM - fm) < WGM ? (nM - fm) : WGM;
        u.pm = fm + ((wgid % nig) % gsz); u.pn = (wgid % nig) / gsz; return true;
    }
    __device__ __forceinline__ void a_ready(const Unit&) const {}
    __device__ __forceinline__ void done(const Unit&) const {}
};

__device__ __forceinline__ unsigned cvt_pk_bf16(float lo, float hi) { unsigned r; asm volatile("v_cvt_pk_bf16_f32 %0, %1, %2" : "=v"(r) : "v"(lo), "v"(hi)); return r; }
template <class Epi, class Sched, bool ALIGN_EPI = false, bool SP2 = false>
__device__ __forceinline__ void gemm_phase(PG8_LAS unsigned char* lds, const Gemm g, const Sched& S, const Epi& E, int wv) {
    const int tid = opaque_tid(wv), wid = __builtin_amdgcn_readfirstlane(tid >> 6), lane = tid & 63, wr = wid >> 2, wc = wid & 3, fr = lane & 15, fq = lane >> 4;
    const int K = g.K, nt = K / BK;
    unsigned voffA[2], voffB[2];
#pragma unroll
    for (int i = 0; i < 2; ++i) { int R, C; stage_rc(tid * 16 + i * 8192, R, C); const int Rb = Epi::PERM ? ((R & ~31) + perm32(R & 31)) : R;
        voffA[i] = (unsigned)(R * K + C) * 2u; voffB[i] = (unsigned)(Rb * K + C) * 2u; }
    const size_t kstep = (size_t)(BK * 2);
    const size_t hstep = (size_t)HALF * K * 2;
    const size_t tstep = 2 * hstep;
    const unsigned ldsw = (unsigned)wid * 1024u;
    const int aoff = lds_byte(wr * 64 + fr, fq * 8), boff = lds_byte(wc * 32 + fr, fq * 8);
#define PG8_SA(b, h) (((b) * 2 + (h)) * HTB)
#define PG8_SB(b, h) ((4 + (b) * 2 + (h)) * HTB)
#define PG8_STAGE(bufoff, gbase, voff) do { _Pragma("unroll") for (int _i = 0; _i < 2; ++_i) \
        __builtin_amdgcn_global_load_lds((const unsigned*)((const char*)(gbase) + (voff)[_i]), (PG8_LAS unsigned*)(lds + (bufoff) + ldsw + _i * 8192), 16, 0, 0); } while (0)
#define PG8_LDA(dst, b, h) do { _Pragma("unroll") for (int m = 0; m < 4; ++m) _Pragma("unroll") for (int k = 0; k < 2; ++k) dst[m][k] = *(const PG8_LAS bf16x8*)(lds + PG8_SA(b, h) + aoff + m * 2048 + k * 1024); } while (0)
#define PG8_LDB(dst, b, h) do { _Pragma("unroll") for (int n = 0; n < 2; ++n) _Pragma("unroll") for (int k = 0; k < 2; ++k) dst[n][k] = *(const PG8_LAS bf16x8*)(lds + PG8_SB(b, h) + boff + n * 2048 + k * 1024); } while (0)
#define PG8_MMA(ai, bj, At, Bt) do { __builtin_amdgcn_s_setprio(1); _Pragma("unroll") for (int m = 0; m < 4; ++m) _Pragma("unroll") for (int n = 0; n < 2; ++n) _Pragma("unroll") for (int k = 0; k < 2; ++k) \
        acc[ai][bj][m][n] = __builtin_amdgcn_mfma_f32_16x16x32_bf16(Bt[n][k], At[m][k], acc[ai][bj][m][n], 0, 0, 0); __builtin_amdgcn_s_setprio(0); } while (0)
#define PG8_WAIT_V(n) asm volatile("s_waitcnt vmcnt(" #n ")" ::: "memory")
#define PG8_WAIT_L(n) asm volatile("s_waitcnt lgkmcnt(" #n ")" ::: "memory")
#define PG8_BAR __builtin_amdgcn_s_barrier()
#define PG8_SCHED __builtin_amdgcn_sched_barrier(0)
    Unit cur, nxt; int ui = 0;
    if (!S.next(0, cur)) return;
    f32x4 acc[2][2][4][2];
#pragma unroll
    for (int a = 0; a < 2; ++a)
#pragma unroll
        for (int b = 0; b < 2; ++b)
#pragma unroll
            for (int m = 0; m < 4; ++m)
#pragma unroll
                for (int n = 0; n < 2; ++n) acc[a][b][m][n] = (f32x4){0.f, 0.f, 0.f, 0.f};
    bf16x8 At[4][2], B0[2][2], B1[2][2];
    const char* cA = (const char*)g.A + (size_t)cur.pm * tstep; const char* cB = (const char*)g.Bt + (size_t)cur.pn * tstep;
    if constexpr (Epi::KSCALE) E.prep(cur, lds, wid, wr, fr, fq);
    S.a_ready(cur);
    if constexpr (SP2) {
        PG8_STAGE(PG8_SB(0, 0), cB, voffB); PG8_STAGE(PG8_SB(0, 1), cB + hstep, voffB); PG8_STAGE(PG8_SA(0, 0), cA, voffA); PG8_STAGE(PG8_SA(0, 1), cA + hstep, voffA);
        if (wr == 1) PG8_BAR;
        PG8_WAIT_V(2); PG8_BAR;
        PG8_STAGE(PG8_SB(1, 0), cB + kstep, voffB); PG8_STAGE(PG8_SA(1, 0), cA + kstep, voffA); PG8_STAGE(PG8_SB(1, 1), cB + hstep + kstep, voffB);
        PG8_WAIT_V(6); PG8_BAR;
    } else {
        PG8_STAGE(PG8_SB(0, 0), cB, voffB); PG8_STAGE(PG8_SA(0, 0), cA, voffA); PG8_STAGE(PG8_SB(0, 1), cB + hstep, voffB); PG8_STAGE(PG8_SA(0, 1), cA + hstep, voffA);
        if (wr == 1) PG8_BAR;
        PG8_WAIT_V(4); PG8_BAR;
        PG8_STAGE(PG8_SB(1, 0), cB + kstep, voffB); PG8_STAGE(PG8_SA(1, 0), cA + kstep, voffA); PG8_STAGE(PG8_SB(1, 1), cB + hstep + kstep, voffB);
        PG8_WAIT_V(6); PG8_BAR;
    }
    for (;;) {
        const bool has_next = S.next(ui + 1, nxt);
        const char* nA = has_next ? (const char*)g.A + (size_t)nxt.pm * tstep : cA; const char* nB = has_next ? (const char*)g.Bt + (size_t)nxt.pn * tstep : cB;
        for (int t = 0; t < nt; t += 2) {
            const bool last = (t == nt - 2);
            const char* a1 = cA + (size_t)(t + 1) * kstep;
            const char* a2 = last ? nA : cA + (size_t)(t + 2) * kstep; const char* b2 = last ? nB : cB + (size_t)(t + 2) * kstep;
            const char* a3 = a2 + kstep; const char* b3 = b2 + kstep;
            if (last && has_next) S.a_ready(nxt);
            if constexpr (SP2) {
            PG8_LDB(B0, 0, 0); PG8_LDB(B1, 0, 1); PG8_SCHED; PG8_LDA(At, 0, 0); PG8_STAGE(PG8_SA(1, 1), a1 + hstep, voffA);
            PG8_WAIT_V(8); PG8_WAIT_L(0); PG8_BAR; PG8_MMA(0, 0, At, B0); PG8_MMA(0, 1, At, B1); PG8_BAR; PG8_SCHED;
            PG8_LDA(At, 0, 1); PG8_STAGE(PG8_SB(0, 0), b2, voffB); PG8_STAGE(PG8_SB(0, 1), b2 + hstep, voffB); PG8_STAGE(PG8_SA(0, 0), a2, voffA);
            PG8_WAIT_V(8); PG8_WAIT_L(0); PG8_BAR; PG8_MMA(1, 0, At, B0); PG8_MMA(1, 1, At, B1); PG8_BAR; PG8_SCHED;
            PG8_LDB(B0, 1, 0); PG8_LDB(B1, 1, 1); PG8_SCHED; PG8_LDA(At, 1, 0); PG8_STAGE(PG8_SA(0, 1), a2 + hstep, voffA);
            PG8_WAIT_V(8); PG8_WAIT_L(0); PG8_BAR; PG8_MMA(0, 0, At, B0); PG8_MMA(0, 1, At, B1); PG8_BAR; PG8_SCHED;
            PG8_LDA(At, 1, 1); PG8_STAGE(PG8_SB(1, 0), b3, voffB); PG8_STAGE(PG8_SB(1, 1), b3 + hstep, voffB); PG8_STAGE(PG8_SA(1, 0), a3, voffA);
            PG8_WAIT_V(8); PG8_WAIT_L(0); PG8_BAR; PG8_MMA(1, 0, At, B0); PG8_MMA(1, 1, At, B1); PG8_BAR; PG8_SCHED;
            } else {
            PG8_LDB(B0, 0, 0); PG8_SCHED; PG8_LDA(At, 0, 0); PG8_STAGE(PG8_SA(1, 1), a1 + hstep, voffA);
            PG8_WAIT_L(8); PG8_BAR; PG8_WAIT_L(0); PG8_MMA(0, 0, At, B0); PG8_BAR; PG8_SCHED;
            PG8_LDB(B1, 0, 1); PG8_STAGE(PG8_SB(0, 0), b2, voffB);
            PG8_BAR; PG8_WAIT_L(0); PG8_MMA(0, 1, At, B1); PG8_BAR;
            PG8_LDA(At, 0, 1); PG8_STAGE(PG8_SA(0, 0), a2, voffA);
            PG8_BAR; PG8_WAIT_L(0); PG8_MMA(1, 0, At, B0); PG8_BAR; PG8_SCHED;
            PG8_STAGE(PG8_SB(0, 1), b2 + hstep, voffB);
            PG8_WAIT_V(6); PG8_BAR; PG8_MMA(1, 1, At, B1); PG8_BAR;
            PG8_LDB(B0, 1, 0); PG8_SCHED; PG8_LDA(At, 1, 0); PG8_STAGE(PG8_SA(0, 1), a2 + hstep, voffA);
            PG8_WAIT_L(8); PG8_BAR; PG8_WAIT_L(0); PG8_MMA(0, 0, At, B0); PG8_BAR; PG8_SCHED;
            PG8_LDB(B1, 1, 1); PG8_STAGE(PG8_SB(1, 0), b3, voffB);
            PG8_BAR; PG8_WAIT_L(0); PG8_MMA(0, 1, At, B1); PG8_BAR;
            PG8_LDA(At, 1, 1); PG8_STAGE(PG8_SA(1, 0), a3, voffA);
            PG8_BAR; PG8_WAIT_L(0); PG8_MMA(1, 0, At, B0); PG8_BAR; PG8_SCHED;
            PG8_STAGE(PG8_SB(1, 1), b3 + hstep, voffB);
            PG8_WAIT_V(6); PG8_BAR; PG8_MMA(1, 1, At, B1); PG8_BAR;
            }
            if constexpr (Epi::KSCALE) { if (t == Epi::KS_T0 || t == Epi::KS_T1) E.kscale(acc, t == Epi::KS_T0 ? 0 : 1, lds, wid, fr); }
        }
        if constexpr (ALIGN_EPI) { if (wr == 0) PG8_BAR; }
        if constexpr (!Epi::AFTER_DRAIN) { E(acc, cur, wr, wc, fr, fq); S.done(cur); }
        if constexpr (Epi::KSCALE) { if (has_next) E.prep(nxt, lds, wid, wr, fr, fq); }
        if (!has_next) break;
#pragma unroll
        for (int a = 0; a < 2; ++a)
#pragma unroll
            for (int b = 0; b < 2; ++b)
#pragma unroll
                for (int m = 0; m < 4; ++m)
#pragma unroll
                    for (int n = 0; n < 2; ++n) acc[a][b][m][n] = (f32x4){0.f, 0.f, 0.f, 0.f};
        cur = nxt; cA = nA; cB = nB; ++ui;
        if constexpr (ALIGN_EPI) { if (wr == 1) PG8_BAR; }
    }
    PG8_WAIT_V(0);
    if constexpr (!ALIGN_EPI) { if (wr == 0) PG8_BAR; }
    PG8_BAR;
    if constexpr (Epi::AFTER_DRAIN) { E.fused(acc, cur, wr, wc, fr, fq, lds, wid, lane); S.done(cur); }
#undef PG8_SA
#undef PG8_SB
#undef PG8_STAGE
#undef PG8_LDA
#undef PG8_LDB
#undef PG8_MMA
#undef PG8_WAIT_V
#undef PG8_WAIT_L
#undef PG8_BAR
#undef PG8_SCHED
}
}

typedef float f32x4 __attribute__((ext_vector_type(4)));
typedef float f32x2 __attribute__((ext_vector_type(2)));
typedef unsigned u32x4 __attribute__((ext_vector_type(4)));
struct EpiIn {
    static constexpr bool PERM = true, AFTER_DRAIN = false, KSCALE = false; static constexpr int KS_T0 = -1, KS_T1 = -1;
    const float* ssq; bf16* ZY; bf16* P; float* DT; int prenorm;
    const PG8_LAS float* rtab; int pm_a, pm_b;
    __device__ __forceinline__ void operator()(const f32x4 (&acc)[2][2][4][2], const pg8::Unit& u, int wr, int wc, int fr, int fq) const {
        const int row0 = u.pm * 256 + wr * 64 + fr, cin = wc * 32 + 8 * fq;
#pragma unroll
        for (int ai = 0; ai < 2; ++ai)
#pragma unroll
            for (int m = 0; m < 4; ++m) {
                const int row = row0 + ai * 128 + m * 16;
                float rstd = 1.f;
                if (!prenorm && (u.pm == pm_a || u.pm == pm_b)) rstd = rtab[(u.pm == pm_a ? 0 : 256) + wr * 64 + ai * 128 + m * 16 + fr];
                else if (!prenorm) {
                    const f32x4* sp = (const f32x4*)(ssq + (size_t)row * 16);
                    const f32x4 s0 = sp[0], s1 = sp[1], s2 = sp[2], s3 = sp[3];
                    const float s = ((s0[0] + s0[1]) + (s0[2] + s0[3])) + ((s1[0] + s1[1]) + (s1[2] + s1[3])) + ((s2[0] + s2[1]) + (s2[2] + s2[3])) + ((s3[0] + s3[1]) + (s3[2] + s3[3]));
                    rstd = rsqrtf(s * (1.f / DM) + EPS);
                }
                if (u.pn >= 17 && u.pn < 21) {
                    const f32x4 a0 = acc[ai][0][m][0] * rstd, a1 = acc[ai][0][m][1] * rstd, g0 = acc[ai][1][m][0] * rstd, g1 = acc[ai][1][m][1] * rstd;
                    u32x4 w; w.x = cvtpk(a0[0] * sigmf(g0[0]), a0[1] * sigmf(g0[1])); w.y = cvtpk(a0[2] * sigmf(g0[2]), a0[3] * sigmf(g0[3]));
                    w.z = cvtpk(a1[0] * sigmf(g1[0]), a1[1] * sigmf(g1[1])); w.w = cvtpk(a1[2] * sigmf(g1[2]), a1[3] * sigmf(g1[3]));
                    *(u32x4*)(P + (size_t)row * PW + P_CA + (u.pn - 17) * 128 + cin) = w;
                } else if (u.pn < 8) {
                    bf16* rowp = ZY + (size_t)row * ZYW + u.pn * 256 + cin;
#pragma unroll
                    for (int bj = 0; bj < 2; ++bj) {
                        const f32x4 v0 = acc[ai][bj][m][0] * rstd, v1 = acc[ai][bj][m][1] * rstd;
                        u32x4 w; w.x = cvtpk(siluf(v0[0]), siluf(v0[1])); w.y = cvtpk(siluf(v0[2]), siluf(v0[3])); w.z = cvtpk(siluf(v1[0]), siluf(v1[1])); w.w = cvtpk(siluf(v1[2]), siluf(v1[3]));
                        *(u32x4*)(rowp + bj * 128) = w;
                    }
                } else if (u.pn < 21) {
                    bf16* rowp = P + (size_t)row * PW + (u.pn - 8) * 256 + cin;
#pragma unroll
                    for (int bj = 0; bj < 2; ++bj) {
                        const f32x4 v0 = acc[ai][bj][m][0] * rstd, v1 = acc[ai][bj][m][1] * rstd;
                        u32x4 w; w.x = cvtpk(v0[0], v0[1]); w.y = cvtpk(v0[2], v0[3]); w.z = cvtpk(v1[0], v1[1]); w.w = cvtpk(v1[2], v1[3]);
                        *(u32x4*)(rowp + bj * 128) = w;
                    }
                } else if (cin < 16) {
                    *(f32x4*)(DT + (size_t)row * 16 + cin) = acc[ai][0][m][0] * rstd;
                    *(f32x4*)(DT + (size_t)row * 16 + cin + 4) = acc[ai][0][m][1] * rstd;
                }
            }
    }
};
struct EpiNull {
    static constexpr bool PERM = true, AFTER_DRAIN = false, KSCALE = false; static constexpr int KS_T0 = -1, KS_T1 = -1;
    __device__ __forceinline__ void operator()(const f32x4 (&acc)[2][2][4][2], const pg8::Unit& u, int wr, int wc, int fr, int fq) const {
#pragma unroll
        for (int ai = 0; ai < 2; ++ai)
#pragma unroll
            for (int bj = 0; bj < 2; ++bj)
#pragma unroll
                for (int m = 0; m < 4; ++m)
#pragma unroll
                    for (int n = 0; n < 2; ++n) asm volatile("" :: "v"(acc[ai][bj][m][n]));
    }
};
constexpr int KS_LDS = 131072;
__device__ __forceinline__ float sum_fq(float v) {
    const unsigned u = __builtin_bit_cast(unsigned, v);
    auto a = __builtin_amdgcn_permlane16_swap(u, u, false, false);
    const float s1 = __builtin_bit_cast(float, (unsigned)a[0]) + __builtin_bit_cast(float, (unsigned)a[1]);
    const unsigned u2 = __builtin_bit_cast(unsigned, s1);
    auto b = __builtin_amdgcn_permlane32_swap(u2, u2, false, false);
    return __builtin_bit_cast(float, (unsigned)b[0]) + __builtin_bit_cast(float, (unsigned)b[1]);
}
struct EpiOut {
    static constexpr bool PERM = true, AFTER_DRAIN = false, KSCALE = true; static constexpr int KS_T0 = 6, KS_T1 = 14;
    const float* xs; bf16* XB; float* ssq; const float* ssqh; int noepi;
    __device__ __forceinline__ void prep(const pg8::Unit& u, PG8_LAS unsigned char* lds, int wid, int wr, int fr, int fq) const {
        if (fq == 0) {
            PG8_LAS float* dst = (PG8_LAS float*)(lds + KS_LDS) + (wid * 16 + fr) * 16;
#pragma unroll
            for (int ai = 0; ai < 2; ++ai)
#pragma unroll
                for (int m = 0; m < 4; ++m) {
                    const f32x4* sp = (const f32x4*)(ssqh + (size_t)(u.pm * 256 + ai * 128 + wr * 64 + m * 16 + fr) * 16);
                    const f32x4 s0 = sp[0], s1 = sp[1], s2 = sp[2], s3 = sp[3];
                    const float r0 = rsqrtf((((s0[0] + s0[1]) + (s0[2] + s0[3])) + ((s1[0] + s1[1]) + (s1[2] + s1[3]))) * (1.f / 512.f) + EPS);
                    const float r1 = rsqrtf((((s2[0] + s2[1]) + (s2[2] + s2[3])) + ((s3[0] + s3[1]) + (s3[2] + s3[3]))) * (1.f / 512.f) + EPS);
                    dst[ai * 4 + m] = r0 / r1; dst[8 + ai * 4 + m] = r1;
                }
        }
    }
    __device__ __forceinline__ void kscale(f32x4 (&acc)[2][2][4][2], int which, PG8_LAS unsigned char* lds, int wid, int fr) const {
        const PG8_LAS f32x4* src = (const PG8_LAS f32x4*)((PG8_LAS float*)(lds + KS_LDS) + (wid * 16 + fr) * 16 + which * 8);
        const f32x4 fa = src[0], fb = src[1];
#pragma unroll
        for (int m = 0; m < 4; ++m)
#pragma unroll
            for (int bj = 0; bj < 2; ++bj)
#pragma unroll
                for (int n = 0; n < 2; ++n) { acc[0][bj][m][n] *= fa[m]; acc[1][bj][m][n] *= fb[m]; }
    }
    __device__ __forceinline__ void piece(const f32x4 a0, const f32x4 a1, const f32x4 r0, const f32x4 r1, float& s, char* dst) const {
        const f32x4 v0 = a0 + r0, v1 = a1 + r1;
        s += ((v0[0] * v0[0] + v0[1] * v0[1]) + (v0[2] * v0[2] + v0[3] * v0[3])) + ((v1[0] * v1[0] + v1[1] * v1[1]) + (v1[2] * v1[2] + v1[3] * v1[3]));
        u32x4 w; w.x = cvtpk(v0[0], v0[1]); w.y = cvtpk(v0[2], v0[3]); w.z = cvtpk(v1[0], v1[1]); w.w = cvtpk(v1[2], v1[3]);
        *(u32x4*)dst = w;
    }
    __device__ __forceinline__ void operator()(const f32x4 (&acc)[2][2][4][2], const pg8::Unit& u, int wr, int wc, int fr, int fq) const {
        if (noepi) {
#pragma unroll
            for (int ai = 0; ai < 2; ++ai)
#pragma unroll
                for (int bj = 0; bj < 2; ++bj)
#pragma unroll
                    for (int m = 0; m < 4; ++m)
#pragma unroll
                        for (int n = 0; n < 2; ++n) asm volatile("" :: "v"(acc[ai][bj][m][n]));
            return;
        }
        const unsigned off0 = (unsigned)(u.pm * 256 + wr * 64 + fr) * DM + (unsigned)(u.pn * 256 + wc * 32 + 8 * fq);
        char* xb = (char*)XB; char* sq = (char*)ssq;
        const unsigned soff = ((unsigned)(u.pm * 256 + wr * 64 + fr) * 16u + (unsigned)(u.pn * 4 + wc)) * 4u;
        {
            float sc[2][4];
#pragma unroll
            for (int ai = 0; ai < 2; ++ai)
#pragma unroll
                for (int m = 0; m < 4; ++m) sc[ai][m] = 1.f;
            if (xs) {
#pragma unroll
                for (int ai = 0; ai < 2; ++ai)
#pragma unroll
                    for (int m = 0; m < 4; ++m) sc[ai][m] = xs[u.pm * 256 + wr * 64 + fr + 128 * ai + 16 * m];
            }
            u32x4 ra[4][2], rb[4][2];
#define EO_LD(R, AI, M0, M1) do { _Pragma("unroll") for (int m = (M0); m < (M1); ++m) _Pragma("unroll") for (int bj = 0; bj < 2; ++bj) R[m][bj] = *(const u32x4*)(xb + (off0 + (unsigned)((128 * (AI) + 16 * m) * DM + 128 * bj)) * 2u); } while (0)
#define EO_DO(R, AI, M0, M1) do { _Pragma("unroll") for (int m = (M0); m < (M1); ++m) { float s = 0.f; \
                _Pragma("unroll") for (int bj = 0; bj < 2; ++bj) { const u32x4 xo = R[m][bj]; \
                    piece(acc[AI][bj][m][0], acc[AI][bj][m][1], (f32x4){bflo(xo.x), bfhi(xo.x), bflo(xo.y), bfhi(xo.y)} * sc[AI][m], (f32x4){bflo(xo.z), bfhi(xo.z), bflo(xo.w), bfhi(xo.w)} * sc[AI][m], s, \
                          xb + (off0 + (unsigned)((128 * (AI) + 16 * m) * DM + 128 * bj)) * 2u); } \
                s = sum_fq(s); if (fq == 0) *(float*)(sq + (soff + (unsigned)((128 * (AI) + 16 * m) * 64))) = s; } } while (0)
            EO_LD(ra, 0, 0, 4); EO_LD(rb, 1, 0, 2);
            EO_DO(ra, 0, 0, 2); EO_LD(rb, 1, 2, 4);
            EO_DO(ra, 0, 2, 4); EO_DO(rb, 1, 0, 4);
#undef EO_LD
#undef EO_DO
        }
    }
};

constexpr int NTHR = 512, NWAVE = 8;
constexpr int LDS_BYTES = 163840;
constexpr int MISC_OFF = LDS_BYTES - 64;
constexpr int CW_BAR = 1024;
constexpr size_t CTL_ZERO_BYTES = 65536;

struct Params { const float* in[16]; float* out; unsigned char* ws; };

typedef float f32x4n __attribute__((ext_vector_type(4))); typedef unsigned u32x2n __attribute__((ext_vector_type(2)));
constexpr int N_WIN_ITEMS = DEPTH * 88 * 16, N_W_ITEMS = N_WIN_ITEMS + DEPTH * 16 * 32;
__device__ __forceinline__ void wconv_load(const Params& p, int item, int tid, f32x4n (&r)[2]) {
#pragma unroll
    for (int i = 0; i < 2; ++i) {
        const int e = tid + NTHR * i, kk = e >> 4, n4 = (e & 15) * 4;
        f32x4n v = {0.f, 0.f, 0.f, 0.f};
        if (item < N_WIN_ITEMS) {
            const int l = item / (88 * 16), rr = item % (88 * 16), np = (rr % 88) * 64 + n4, k = (rr / 88) * 64 + kk;
            if (np < NIN) { v = *(const f32x4n*)(p.in[2] + (size_t)l * DM * NIN + (size_t)k * NIN + src_col(np)); v = v * p.in[1][l * DM + k]; }
        } else {
            const int it2 = item - N_WIN_ITEMS, l = it2 / (16 * 32), rr = it2 % (16 * 32), n = (rr % 16) * 64 + n4, k = (rr / 16) * 64 + kk;
            v = *(const f32x4n*)(p.in[14] + (size_t)l * 2048 * DM + (size_t)k * DM + n);
            if (k < 1024) v = v * p.in[8][l * 1024 + k];
        }
        r[i] = v;
    }
}
__device__ __forceinline__ void wconv_items(const Params& p, unsigned char* ws, int bid, int G, float* tile  , int wv) {
    const int tid = opaque_tid(wv);
    f32x4n r[2];
    int item = bid;
    if (item < N_W_ITEMS) wconv_load(p, item, tid, r);
    for (; item < N_W_ITEMS; item += G) {
#pragma unroll
        for (int i = 0; i < 2; ++i) { const int e = tid + NTHR * i, kk = e >> 4, n4 = (e & 15) * 4; tile[kk * 65 + n4] = r[i][0]; tile[kk * 65 + n4 + 1] = r[i][1]; tile[kk * 65 + n4 + 2] = r[i][2]; tile[kk * 65 + n4 + 3] = r[i][3]; }
        __syncthreads();
        if (item + G < N_W_ITEMS) wconv_load(p, item + G, tid, r);
        const int nn = tid >> 3, kc = (tid & 7) * 8;
        u32x4 o;
        o.x = cvtpk(tile[(kc + 0) * 65 + nn], tile[(kc + 1) * 65 + nn]); o.y = cvtpk(tile[(kc + 2) * 65 + nn], tile[(kc + 3) * 65 + nn]);
        o.z = cvtpk(tile[(kc + 4) * 65 + nn], tile[(kc + 5) * 65 + nn]); o.w = cvtpk(tile[(kc + 6) * 65 + nn], tile[(kc + 7) * 65 + nn]);
        bf16* dst;
        if (item < N_WIN_ITEMS) { const int l = item / (88 * 16), rr = item % (88 * 16); dst = (bf16*)(ws + WS_WIN) + (size_t)l * NINP * DM + (size_t)((rr % 88) * 64 + nn) * DM + (rr / 88) * 64 + kc; }
        else { const int it2 = item - N_WIN_ITEMS, l = it2 / (16 * 32), rr = it2 % (16 * 32); dst = (bf16*)(ws + WS_WOUT) + (size_t)l * DM * 2048 + (size_t)((rr % 16) * 64 + nn) * 2048 + (rr / 16) * 64 + kc; }
        *(u32x4*)dst = o;
        __syncthreads();
    }
}
__device__ __forceinline__ void normprep_rows(const float* __restrict__ x, bf16* __restrict__ XB, float* __restrict__ XS, int gw, int NGW, int lane) {
    f32x4n va[4][4], vb[4][4];
    const int nb = (M - gw + NGW - 1) / NGW;
#define NP_LOAD(V, B0) do { _Pragma("unroll") for (int r = 0; r < 4; ++r) { const int row = gw + ((B0) + r) * NGW; _Pragma("unroll") for (int j = 0; j < 4; ++j) { V[r][j] = (f32x4n){0.f, 0.f, 0.f, 0.f}; if (row < M) V[r][j] = *(const f32x4n*)(x + (size_t)row * DM + 4 * lane + 256 * j); } } } while (0)
#define NP_STORE(V, B0) do { _Pragma("unroll") for (int r = 0; r < 4; ++r) { const int row = gw + ((B0) + r) * NGW; float s = 0.f; \
        _Pragma("unroll") for (int j = 0; j < 4; ++j) s += (V[r][j][0] * V[r][j][0] + V[r][j][1] * V[r][j][1]) + (V[r][j][2] * V[r][j][2] + V[r][j][3] * V[r][j][3]); \
        const float ms_ = wave_sum(s) * (1.f / DM) + EPS, rstd = rsqrtf(ms_); \
        if (row < M) { if (lane == 0) XS[row] = ms_ * rstd; _Pragma("unroll") for (int j = 0; j < 4; ++j) { u32x2n o; o.x = cvtpk(V[r][j][0] * rstd, V[r][j][1] * rstd); o.y = cvtpk(V[r][j][2] * rstd, V[r][j][3] * rstd); \
            *(u32x2n*)(XB + (size_t)row * DM + 4 * lane + 256 * j) = o; } } } } while (0)
    NP_LOAD(va, 0);
#pragma unroll 1
    for (int b0 = 0; b0 < nb; b0 += 8) {
        NP_LOAD(vb, b0 + 4);
        NP_STORE(va, b0);
        NP_LOAD(va, b0 + 8);
        NP_STORE(vb, b0 + 4);
    }
#undef NP_LOAD
#undef NP_STORE
}

struct SsdArgs { const bf16* P; bf16* ZY; const float* DT; float* SSQH; const float* conv_w; const float* conv_b; const float* dt_bias; const float* a_log; const float* dskip; };
__device__ __forceinline__ void ssd_naive_unit(const SsdArgs& a, int unit, float* sm, int wv) {
    constexpr int TT = 32;
    float* raw = sm;
    float* act = raw + (TT + 3) * 320;
    float* dts = act + TT * 320;
    float* decs = dts + TT;
    float* gq = decs + TT;
    const int b = unit >> 4, h = unit & 15, g = h >> 3, tid = opaque_tid(wv), lane = tid & 63, w = tid >> 6;
    const int p = w * 8 + (lane >> 3), ng = lane & 7;
    const float A = -__expf(a.a_log[h]), Dk = a.dskip[h], dtb = a.dt_bias[h];
    float S[16];
#pragma unroll
    for (int i = 0; i < 16; ++i) S[i] = 0.f;
    for (int t0 = 0; t0 < SEQ; t0 += TT) {
        for (int e = tid; e < (TT + 3) * 320; e += NTHR) {
            const int tt = e / 320, c = e % 320, t = t0 - 3 + tt;
            const int col = c < 64 ? (P_XS + h * 64 + c) : (c < 192 ? (P_B + g * 128 + (c - 64)) : (P_C + g * 128 + (c - 192)));
            raw[tt * 320 + c] = t >= 0 ? bf2f(a.P[((size_t)b * SEQ + t) * PW + col]) : 0.f;
        }
        if (tid < TT) {
            const float v = a.DT[((size_t)b * SEQ + t0 + tid) * 16 + h] + dtb;
            const float dt = v > 20.f ? v : log1pf(__expf(v));
            dts[tid] = dt; decs[tid] = __expf(dt * A);
        }
        __syncthreads();
        for (int e = tid; e < TT * 320; e += NTHR) {
            const int tt = e / 320, c = e % 320;
            const int col = c < 64 ? (P_XS + h * 64 + c) : (c < 192 ? (P_B + g * 128 + (c - 64)) : (P_C + g * 128 + (c - 192)));
            float v = a.conv_b[col];
#pragma unroll
            for (int k = 0; k < 4; ++k) v += a.conv_w[k * 1536 + col] * raw[(tt + k) * 320 + c];
            act[tt * 320 + c] = siluf(v);
        }
        __syncthreads();
        for (int tt = 0; tt < TT; ++tt) {
            const float* at = act + tt * 320;
            const float xv = at[p], xdt = xv * dts[tt], dec = decs[tt];
            float yp = 0.f;
#pragma unroll
            for (int i = 0; i < 16; ++i) {
                S[i] = dec * S[i] + xdt * at[64 + ng * 16 + i];
                yp += at[192 + ng * 16 + i] * S[i];
            }
            yp += __shfl_xor(yp, 1); yp += __shfl_xor(yp, 2); yp += __shfl_xor(yp, 4);
            if (ng == 0) {
                const float y = yp + Dk * xv;
                const size_t zi = ((size_t)b * SEQ + t0 + tt) * ZYW + h * 64 + p;
                const float z = bf2f(a.ZY[zi]);
                const float gg = y * siluf(z);
                a.ZY[zi] = f2bf(gg);
                gq[tt * 64 + p] = gg * gg;
            }
        }
        __syncthreads();
        if (tid < TT) { float s = 0.f; for (int i = 0; i < 64; ++i) s += gq[tid * 64 + i]; a.SSQH[((size_t)b * SEQ + t0 + tid) * 16 + h] = s; }
        __syncthreads();
    }
}
__device__ __forceinline__ void ssd_norm_row(bf16* ZY, const float* __restrict__ SSQH, const float* __restrict__ nw, int row, int lane, bf16* yo, int yp) {
    float v[16], s0 = 0.f, s1 = 0.f;
#pragma unroll
    for (int j = 0; j < 16; ++j) { v[j] = bf2f(ZY[(size_t)row * ZYW + j * 64 + lane]); if (j < 8) s0 += v[j] * v[j]; else s1 += v[j] * v[j]; }
    s0 = wave_sum(s0); s1 = wave_sum(s1);
    const float r0 = rsqrtf(s0 * (1.f / 512.f) + EPS), r1 = rsqrtf(s1 * (1.f / 512.f) + EPS);
#pragma unroll
    for (int j = 0; j < 16; ++j) { const int c = j * 64 + lane; yo[(size_t)row * yp + c] = f2bf(v[j] * (j < 8 ? r0 : r1) * nw[c]); }
}

struct AttnArgs { const bf16* P; bf16* ZY; const float* sinks; };
__device__ __forceinline__ void attn_naive_unit(const AttnArgs& a, int unit, float* sm, bf16* yref, int wv) {
    float* Ks = sm;
    float* Vs = sm + 256 * 64;
    const int nb = unit & 15, g = (unit >> 4) & 1, b = unit >> 5, tid = opaque_tid(wv);
    const int r = tid >> 7, qi = tid & 127;
    for (int e = tid; e < 256 * 64; e += NTHR) {
        const int kr = e >> 6, d = e & 63, t = (nb - 1) * 128 + kr;
        float kv = 0.f, vv = 0.f;
        if (t >= 0) { const size_t base = ((size_t)b * SEQ + t) * PW; kv = bf2f(a.P[base + P_K + g * 64 + d]); vv = bf2f(a.P[base + P_V + g * 64 + d]); }
        Ks[e] = kv; Vs[e] = vv;
    }
    __syncthreads();
    const int t = nb * 128 + qi;
    const size_t prow = ((size_t)b * SEQ + t) * PW;
    float q[64], o[64];
#pragma unroll
    for (int d = 0; d < 64; ++d) { q[d] = bf2f(a.P[prow + P_Q + g * 256 + r * 64 + d]) * 0.125f; o[d] = 0.f; }
    float mx = -1e30f, l = 0.f;
    const int jlo = (t - 127 < 0) ? 0 : t - 127;
    for (int tj = jlo; tj <= t; ++tj) {
        const int kr = tj - (nb - 1) * 128;
        const float* kp = Ks + kr * 64;
        float s = 0.f;
#pragma unroll
        for (int d = 0; d < 64; ++d) s += q[d] * kp[d];
        const float mn = fmaxf(mx, s), f = __expf(mx - mn), pe = __expf(s - mn);
        l = l * f + pe;
        const float* vp = Vs + kr * 64;
#pragma unroll
        for (int d = 0; d < 64; ++d) o[d] = o[d] * f + pe * vp[d];
        mx = mn;
    }
    const float sk = a.sinks[g * 4 + r];
    const float mn = fmaxf(mx, sk), f = __expf(mx - mn);
    l = l * f + __expf(sk - mn);
    const float inv = f / l;
    const size_t zrow = ((size_t)b * SEQ + t) * ZYW + 1024 + g * 256 + r * 64;
#pragma unroll
    for (int d = 0; d < 64; ++d) { const float z = bf2f(a.ZY[zrow + d]); yref[((size_t)b * SEQ + t) * 512 + g * 256 + r * 64 + d] = f2bf(o[d] * inv * siluf(z)); }
    __syncthreads();
}


typedef short bf16x8 __attribute__((ext_vector_type(8)));
typedef short s16x4 __attribute__((ext_vector_type(4)));
typedef float f32x16 __attribute__((ext_vector_type(16)));
#define LAS __attribute__((address_space(3)))
__device__ __forceinline__ int crow(int r, int hi) { return (r & 3) + 8 * (r >> 2) + 4 * hi; }
constexpr int AT_KP = 144;
constexpr int AT_K = 0, AT_V = 256 * AT_KP, AT_O = 2 * 256 * AT_KP, AT_W = AT_O + 8 * 32 * AT_KP;
typedef short v4i16a_t __attribute__((ext_vector_type(4)));
__device__ __forceinline__ void attn_unit(const AttnArgs& a, int unit, LAS unsigned char* lds, bf16* ybase, int ypitch, int wv) {
    const int tid = opaque_tid(wv), lane = tid & 63, wid = __builtin_amdgcn_readfirstlane(tid >> 6), c32 = lane & 31, hi = lane >> 5;
    const int nb = unit & 15, g = (unit >> 4) & 1, b = unit >> 5;
    u32x4 kv[4], vv[4];
#pragma unroll
    for (int q = 0; q < 4; ++q) {
        const int e = tid + NTHR * q, key = e >> 3, ch = e & 7, t = (nb - 1) * 128 + key;
        kv[q] = (u32x4){0u, 0u, 0u, 0u}; vv[q] = (u32x4){0u, 0u, 0u, 0u};
        if (t >= 0) { const bf16* base = a.P + ((size_t)b * SEQ + t) * PW; kv[q] = *(const u32x4*)(base + P_K + g * 64 + ch * 8); vv[q] = *(const u32x4*)(base + P_V + g * 64 + ch * 8); }
    }
    bf16x8 qf[2][4];
#pragma unroll
    for (int gi2 = 0; gi2 < 2; ++gi2) {
        const int gi = wid + 8 * gi2, head = gi >> 2, qo = (gi & 3) * 32;
        const bf16* qp = a.P + ((size_t)b * SEQ + nb * 128 + qo + c32) * PW + P_Q + g * 256 + head * 64 + hi * 8;
#pragma unroll
        for (int ks = 0; ks < 4; ++ks) qf[gi2][ks] = *(const bf16x8*)(qp + ks * 16);
    }
#pragma unroll
    for (int q = 0; q < 4; ++q) {
        const int e = tid + NTHR * q, key = e >> 3, ch = e & 7;
        *(LAS u32x4*)(lds + AT_K + key * AT_KP + ch * 16) = kv[q];
        *(LAS u32x4*)(lds + AT_V + key * AT_KP + ch * 16) = vv[q];
    }
    __syncthreads();
    LAS float* wsf = (LAS float*)(lds + AT_W) + wid * 32;
    LAS unsigned char* ost = lds + AT_O + wid * 32 * AT_KP;
    const float C2 = 0.125f * 1.4426950408889634f, NEG = -1e30f;
    const int i16 = lane & 15, gsel = (lane >> 4) & 1;
#pragma unroll
    for (int gi2 = 0; gi2 < 2; ++gi2) {
        const int gi = wid + 8 * gi2, head = gi >> 2, qo = (gi & 3) * 32;
        const size_t tok0 = (size_t)b * SEQ + nb * 128 + qo;
        u32x4 zv[4];
#pragma unroll
        for (int k = 0; k < 4; ++k) { const int e = lane + 64 * k; zv[k] = *(const u32x4*)(a.ZY + (tok0 + (e >> 3)) * ZYW + 1024 + g * 256 + head * 64 + (e & 7) * 8); }
        f32x16 S[5];
#pragma unroll
        for (int j = 0; j < 5; ++j) {
            f32x16 acc = {0.f, 0.f, 0.f, 0.f, 0.f, 0.f, 0.f, 0.f, 0.f, 0.f, 0.f, 0.f, 0.f, 0.f, 0.f, 0.f};
#pragma unroll
            for (int ks = 0; ks < 4; ++ks) {
                const bf16x8 kf = *(const LAS bf16x8*)(lds + AT_K + (qo + 32 * j + c32) * AT_KP + ks * 32 + hi * 16);
                acc = __builtin_amdgcn_mfma_f32_32x32x16_bf16(kf, qf[gi2][ks], acc, 0, 0, 0);
            }
            S[j] = acc;
        }
        float mx = NEG;
#pragma unroll
        for (int j = 0; j < 5; ++j) {
            const bool dead = (nb == 0) && (qo + 32 * j < 128);
#pragma unroll
            for (int r = 0; r < 16; ++r) {
                float v = S[j][r] * C2;
                const int kr = crow(r, hi);
                if (j == 0 && !(kr > c32)) v = NEG;
                if (j == 4 && !(kr <= c32)) v = NEG;
                if (dead) v = NEG;
                S[j][r] = v; mx = fmaxf(mx, v);
            }
        }
        mx = fmaxf(mx, __shfl_xor(mx, 32));
        const float sink2 = a.sinks[g * 4 + head] * 1.4426950408889634f;
        mx = fmaxf(mx, sink2);
        float l = 0.f;
#pragma unroll
        for (int j = 0; j < 5; ++j)
#pragma unroll
            for (int r = 0; r < 16; ++r) { const float pe = __builtin_amdgcn_exp2f(S[j][r] - mx); l += pe; S[j][r] = pe; }
        l += __shfl_xor(l, 32);
        l += __builtin_amdgcn_exp2f(sink2 - mx);
        if (hi == 0) wsf[c32] = __builtin_amdgcn_rcpf(l);
        f32x16 o[2];
#pragma unroll
        for (int dh = 0; dh < 2; ++dh) o[dh] = (f32x16){0.f, 0.f, 0.f, 0.f, 0.f, 0.f, 0.f, 0.f, 0.f, 0.f, 0.f, 0.f, 0.f, 0.f, 0.f, 0.f};
#pragma unroll
        for (int j = 0; j < 5; ++j)
#pragma unroll
            for (int s2 = 0; s2 < 2; ++s2) {
                u32x4 pw;
                pw.x = cvtpk(S[j][8 * s2 + 0], S[j][8 * s2 + 1]); pw.y = cvtpk(S[j][8 * s2 + 2], S[j][8 * s2 + 3]);
                pw.z = cvtpk(S[j][8 * s2 + 4], S[j][8 * s2 + 5]); pw.w = cvtpk(S[j][8 * s2 + 6], S[j][8 * s2 + 7]);
                const bf16x8 pa = __builtin_bit_cast(bf16x8, pw);
#pragma unroll
                for (int dh = 0; dh < 2; ++dh) {
                    const LAS unsigned char* vp = lds + AT_V + (qo + 32 * j + 16 * s2 + 4 * hi + (i16 >> 2)) * AT_KP + (dh * 32 + 16 * gsel + 4 * (i16 & 3)) * 2;
                    const v4i16a_t v0 = __builtin_amdgcn_ds_read_tr16_b64_v4i16((LAS v4i16a_t*)vp);
                    const v4i16a_t v1 = __builtin_amdgcn_ds_read_tr16_b64_v4i16((LAS v4i16a_t*)(vp + 8 * AT_KP));
                    const bf16x8 vf = {v0[0], v0[1], v0[2], v0[3], v1[0], v1[1], v1[2], v1[3]};
                    o[dh] = __builtin_amdgcn_mfma_f32_32x32x16_bf16(pa, vf, o[dh], 0, 0, 0);
                }
            }
#pragma unroll
        for (int r = 0; r < 16; r += 2) {
            const int q0 = crow(r, hi), q1 = crow(r + 1, hi);
            const float i0v = wsf[q0], i1v = wsf[q1];
#pragma unroll
            for (int dh = 0; dh < 2; ++dh) {
                const unsigned w2 = cvtpk(o[dh][r] * i0v, o[dh][r + 1] * i1v);
                *(LAS unsigned short*)(ost + q0 * AT_KP + (dh * 32 + c32) * 2) = (unsigned short)(w2 & 0xffffu);
                *(LAS unsigned short*)(ost + q1 * AT_KP + (dh * 32 + c32) * 2) = (unsigned short)(w2 >> 16);
            }
        }
#pragma unroll
        for (int k = 0; k < 4; ++k) {
            const int e = lane + 64 * k;
            const u32x4 ov = *(const LAS u32x4*)(ost + (e >> 3) * AT_KP + (e & 7) * 16);
            u32x4 yv;
#pragma unroll
            for (int c = 0; c < 4; ++c) yv[c] = cvtpk(bflo(ov[c]) * bflo(zv[k][c]), bfhi(ov[c]) * bfhi(zv[k][c]));
            *(u32x4*)(ybase + (tok0 + (e >> 3)) * ypitch + g * 256 + head * 64 + (e & 7) * 8) = yv;
        }
    }
    __syncthreads();
}

typedef unsigned u32x2 __attribute__((ext_vector_type(2)));
__device__ __forceinline__ void bc_unit(const SsdArgs& a, int unit, bf16* __restrict__ BC, int wv) {
    const int tid = opaque_tid(wv);
    const int b = unit >> 5, t0 = (unit & 31) * 64, cc = tid & 63, j0 = (tid >> 6) * 8;
    const bf16* src = a.P + ((size_t)b * SEQ) * PW + P_B + cc * 8;
    u32x4 raw[11];
#pragma unroll
    for (int k = 0; k < 11; ++k) {
        const int t = t0 + j0 - 3 + k;
        raw[k] = (u32x4){0u, 0u, 0u, 0u};
        if (t >= 0) raw[k] = *(const u32x4*)(src + (size_t)t * PW);
    }
    u32x4 ob[8];
#pragma unroll
    for (int e2 = 0; e2 < 4; ++e2) {
        const int c0 = 1024 + cc * 8 + 2 * e2;
        float w0[5], w1[5];
#pragma unroll
        for (int k = 0; k < 4; ++k) { const f32x2 wv = *(const f32x2*)(a.conv_w + k * 1536 + c0); w0[k] = wv.x; w1[k] = wv.y; }
        { const f32x2 wv = *(const f32x2*)(a.conv_b + c0); w0[4] = wv.x; w1[4] = wv.y; }
#pragma unroll
        for (int tt = 0; tt < 8; ++tt) {
            float v0 = w0[4], v1 = w1[4];
#pragma unroll
            for (int k = 0; k < 4; ++k) { v0 += w0[k] * bflo(raw[tt + k][e2]); v1 += w1[k] * bfhi(raw[tt + k][e2]); }
            ob[tt][e2] = cvtpk(siluf(v0), siluf(v1));
        }
    }
#pragma unroll
    for (int tt = 0; tt < 8; ++tt) *(u32x4*)(BC + ((size_t)b * SEQ + t0 + j0 + tt) * 512 + cc * 8) = ob[tt];
}

typedef short v4i16_t __attribute__((ext_vector_type(4)));
constexpr int SD_BP = 272, SD_XP = 144;
constexpr int SD_BM = 0, SD_CM = SD_BM + 128 * SD_BP, SD_XT = SD_CM + 128 * SD_BP, SD_SL = SD_XT + 64 * SD_BP, SD_ZT = SD_SL + 64 * SD_BP, SD_F = SD_ZT + 128 * SD_XP;
constexpr int SD_ACS = SD_F, SD_DTE = SD_F + 1024, SD_LACS = SD_F + 2048, SD_EACS = SD_F + 3072, SD_CW = SD_F + 4096, SD_END = SD_CW + 5 * 64 * 4;
static_assert(SD_END <= MISC_OFF, "SSD LDS map");
__device__ __forceinline__ float softplusf(float v) { return v > 15.f ? v : __builtin_amdgcn_logf(1.f + __builtin_amdgcn_exp2f(v * 1.4426950408889634f)) * 0.6931471805599453f; }
__device__ __forceinline__ void ssd_dt_chunk(LAS unsigned char* lds, float r0, float r1, int par, int lane, float A2, float dtb) {
    LAS float* acs2 = (LAS float*)(lds + SD_ACS) + par * 128; LAS float* dte = (LAS float*)(lds + SD_DTE) + par * 128; LAS float* lacs = (LAS float*)(lds + SD_LACS) + par * 128; LAS float* eacs = (LAS float*)(lds + SD_EACS) + par * 128;
    const float d0 = softplusf(r0 + dtb), d1 = softplusf(r1 + dtb);
    const float a0 = d0 * A2, a1 = d1 * A2, sp = a0 + a1;
    float incl = sp;
    incl = dpp_add<0x111, 0xf>(incl); incl = dpp_add<0x112, 0xf>(incl); incl = dpp_add<0x114, 0xf>(incl); incl = dpp_add<0x118, 0xf>(incl);
    incl = dpp_add<0x142, 0xa>(incl); incl = dpp_add<0x143, 0xc>(incl);
    const float c0v = incl - a1, tot = __builtin_bit_cast(float, __builtin_amdgcn_readlane(__builtin_bit_cast(int, incl), 63));
    acs2[2 * lane] = c0v; acs2[2 * lane + 1] = incl;
    lacs[2 * lane] = c0v - __builtin_amdgcn_logf(d0); lacs[2 * lane + 1] = incl - __builtin_amdgcn_logf(d1);
    dte[2 * lane] = d0 * __builtin_amdgcn_exp2f(tot - c0v); dte[2 * lane + 1] = d1 * __builtin_amdgcn_exp2f(tot - incl);
    eacs[2 * lane] = __builtin_amdgcn_exp2f(c0v); eacs[2 * lane + 1] = __builtin_amdgcn_exp2f(incl);
}
__device__ __forceinline__ void ssd_unit(const SsdArgs& a, int unit, LAS unsigned char* lds, bf16* ybase, int ypitch, float* ssqh, const bf16* __restrict__ BC, int wv, int probe = 0) {
    const int tid = opaque_tid(wv), lane = tid & 63, wid = __builtin_amdgcn_readfirstlane(tid >> 6), c32 = lane & 31, hi = lane >> 5;
    const int b = unit >> 4, h = unit & 15, g = h >> 3;
    const float LOG2E = 1.4426950408889634f;
    const float A2 = -__expf(a.a_log[h]) * LOG2E, Dk = a.dskip[h], dtb = a.dt_bias[h];
    LAS float* cwl = (LAS float*)(lds + SD_CW);
    for (int e = tid; e < 5 * 64; e += NTHR) { const int k = e >> 6, c = e & 63; cwl[e] = k < 4 ? a.conv_w[k * 1536 + h * 64 + c] : a.conv_b[h * 64 + c]; }
    for (int e = tid; e < 64 * SD_BP / 4; e += NTHR) ((LAS unsigned*)(lds + SD_SL))[e] = 0u;
    float dr0 = 0.f, dr1 = 0.f;
    if (wid == 0) { dr0 = a.DT[((size_t)b * SEQ + 2 * lane) * 16 + h]; dr1 = a.DT[((size_t)b * SEQ + 2 * lane + 1) * 16 + h]; ssd_dt_chunk(lds, dr0, dr1, 0, lane, A2, dtb); }
    const int it = wid >> 1, ph = wid & 1, pt = wid >> 2, nt = wid & 3;
    f32x16 St = {0.f, 0.f, 0.f, 0.f, 0.f, 0.f, 0.f, 0.f, 0.f, 0.f, 0.f, 0.f, 0.f, 0.f, 0.f, 0.f};
    u32x4 pbc[8] = {}, pxr[5] = {}, pz[2] = {};
    const int xc = tid & 7, tp = tid >> 3;
#define SSD_PF_LOAD(CH) do { if (probe & 1) break; const size_t r0_ = (size_t)b * SEQ + (CH) * 128; \
        _Pragma("unroll") for (int q = 0; q < 8; ++q) { const int e = tid + 512 * q, r = e >> 5, ci = e & 31; \
            pbc[q] = *(const u32x4*)(BC + (r0_ + r) * 512 + (ci < 16 ? g * 128 + ci * 8 : 256 + g * 128 + (ci - 16) * 8)); } \
        _Pragma("unroll") for (int k = 0; k < 5; ++k) { const int t = (CH) * 128 + 2 * tp - 3 + k; pxr[k] = (u32x4){0u, 0u, 0u, 0u}; \
            if (t >= 0) pxr[k] = *(const u32x4*)(a.P + ((size_t)b * SEQ + t) * PW + P_XS + h * 64 + xc * 8); } \
        _Pragma("unroll") for (int q = 0; q < 2; ++q) { const int e = tid + 512 * q; pz[q] = *(const u32x4*)(a.ZY + (r0_ + (e >> 3)) * ZYW + h * 64 + (e & 7) * 8); } } while (0)
#define SSD_PF_COMMIT() do { \
        _Pragma("unroll") for (int q = 0; q < 8; ++q) { const int e = tid + 512 * q, r = e >> 5, ci = e & 31; \
            *(LAS u32x4*)(lds + (ci < 16 ? SD_BM + ci * 16 : SD_CM + (ci - 16) * 16) + r * SD_BP) = pbc[q]; } \
        _Pragma("unroll") for (int q = 0; q < 2; ++q) { const int e = tid + 512 * q; *(LAS u32x4*)(lds + SD_ZT + (e >> 3) * SD_XP + (e & 7) * 16) = pz[q]; } \
        { _Pragma("unroll") for (int e2 = 0; e2 < 4; ++e2) { const int c0 = xc * 8 + 2 * e2; \
              f32x2 va = *(const LAS f32x2*)(cwl + 4 * 64 + c0), vc = va; \
              _Pragma("unroll") for (int k = 0; k < 4; ++k) { const f32x2 w2 = *(const LAS f32x2*)(cwl + k * 64 + c0); \
                  va += w2 * (f32x2){bflo(pxr[k][e2]), bfhi(pxr[k][e2])}; vc += w2 * (f32x2){bflo(pxr[k + 1][e2]), bfhi(pxr[k + 1][e2])}; } \
              va.x = siluf(va.x); va.y = siluf(va.y); vc.x = siluf(vc.x); vc.y = siluf(vc.y); \
              *(LAS unsigned*)(lds + SD_XT + c0 * SD_BP + tp * 4) = cvtpk(va.x, vc.x); \
              *(LAS unsigned*)(lds + SD_XT + (c0 + 1) * SD_BP + tp * 4) = cvtpk(va.y, vc.y); } } } while (0)
    if (wid == 0) { dr0 = a.DT[((size_t)b * SEQ + 128 + 2 * lane) * 16 + h]; dr1 = a.DT[((size_t)b * SEQ + 128 + 2 * lane + 1) * 16 + h]; }
    SSD_PF_LOAD(0);
    __syncthreads();
    SSD_PF_COMMIT();
    __syncthreads();
#pragma unroll 1
    for (int ch = 0; ch < SEQ / 128; ++ch) {
        const int t0 = ch * 128, par = ch & 1;
        const size_t row0 = (size_t)b * SEQ + t0;
        const LAS float* acs2 = (const LAS float*)(lds + SD_ACS) + par * 128; const LAS float* dte = (const LAS float*)(lds + SD_DTE) + par * 128;
        const LAS float* lacs = (const LAS float*)(lds + SD_LACS) + par * 128; const LAS float* eacs = (const LAS float*)(lds + SD_EACS) + par * 128;
        if (ch + 1 < SEQ / 128) SSD_PF_LOAD(ch + 1);
        if (!(probe & 2)) {
            bf16x8 cf[8];
#pragma unroll
            for (int ks = 0; ks < 8; ++ks) cf[ks] = *(const LAS bf16x8*)(lds + SD_CM + (32 * it + c32) * SD_BP + ks * 32 + hi * 16);
            f32x16 Yd = {0.f, 0.f, 0.f, 0.f, 0.f, 0.f, 0.f, 0.f, 0.f, 0.f, 0.f, 0.f, 0.f, 0.f, 0.f, 0.f};
            const float ai = acs2[32 * it + c32];
#pragma unroll
            for (int jt = 0; jt < 4; ++jt) {
                if (jt <= it) {
                    f32x16 X = {0.f, 0.f, 0.f, 0.f, 0.f, 0.f, 0.f, 0.f, 0.f, 0.f, 0.f, 0.f, 0.f, 0.f, 0.f, 0.f};
#pragma unroll
                    for (int ks = 0; ks < 8; ++ks) {
                        const bf16x8 bfr = *(const LAS bf16x8*)(lds + SD_BM + (32 * jt + c32) * SD_BP + ks * 32 + hi * 16);
                        X = __builtin_amdgcn_mfma_f32_32x32x16_bf16(bfr, cf[ks], X, 0, 0, 0);
                    }
#pragma unroll
                    for (int r4 = 0; r4 < 4; ++r4) {
                        const f32x4 aj = *(const LAS f32x4*)(lacs + 32 * jt + 8 * r4 + 4 * hi);
#pragma unroll
                        for (int q = 0; q < 4; ++q) {
                            const int r = 4 * r4 + q, jr = 8 * r4 + 4 * hi + q;
                            float f = __builtin_amdgcn_exp2f(ai - aj[q]);
                            if (jt == it && jr > c32) f = 0.f;
                            X[r] *= f;
                        }
                    }
#pragma unroll
                    for (int s2 = 0; s2 < 2; ++s2) {
                        u32x4 pw;
                        pw.x = cvtpk(X[8 * s2 + 0], X[8 * s2 + 1]); pw.y = cvtpk(X[8 * s2 + 2], X[8 * s2 + 3]);
                        pw.z = cvtpk(X[8 * s2 + 4], X[8 * s2 + 5]); pw.w = cvtpk(X[8 * s2 + 6], X[8 * s2 + 7]);
                        const LAS unsigned char* vp = lds + SD_XT + (32 * ph + c32) * SD_BP + (32 * jt + 16 * s2 + 4 * hi) * 2;
                        const s16x4 v0 = *(const LAS s16x4*)vp, v1 = *(const LAS s16x4*)(vp + 16);
                        const bf16x8 vf = {v0[0], v0[1], v0[2], v0[3], v1[0], v1[1], v1[2], v1[3]};
                        Yd = __builtin_amdgcn_mfma_f32_32x32x16_bf16(__builtin_bit_cast(bf16x8, pw), vf, Yd, 0, 0, 0);
                    }
                }
            }
            f32x16 Yo = {0.f, 0.f, 0.f, 0.f, 0.f, 0.f, 0.f, 0.f, 0.f, 0.f, 0.f, 0.f, 0.f, 0.f, 0.f, 0.f};
#pragma unroll
            for (int ks = 0; ks < 8; ++ks) {
                const bf16x8 sf = *(const LAS bf16x8*)(lds + SD_SL + (32 * ph + c32) * SD_BP + ks * 32 + hi * 16);
                Yo = __builtin_amdgcn_mfma_f32_32x32x16_bf16(cf[ks], sf, Yo, 0, 0, 0);
            }
            const int pcol = 32 * ph + c32;
#pragma unroll
            for (int r4 = 0; r4 < 4; ++r4) {
                const f32x4 ea = *(const LAS f32x4*)(eacs + 32 * it + 8 * r4 + 4 * hi);
                const u32x2 xw = *(const LAS u32x2*)(lds + SD_XT + pcol * SD_BP + (32 * it + 8 * r4 + 4 * hi) * 2);
                const float xs4[4] = {bflo(xw.x), bfhi(xw.x), bflo(xw.y), bfhi(xw.y)};
#pragma unroll
                for (int q = 0; q < 4; ++q) {
                    const int r = 4 * r4 + q, i = 32 * it + 8 * r4 + 4 * hi + q;
                    const float xs = xs4[q];
                    const float y = Yd[r] + ea[q] * Yo[r] + Dk * xs;
                    LAS unsigned short* zp = (LAS unsigned short*)(lds + SD_ZT + i * SD_XP + pcol * 2);
                    *zp = (unsigned short)cvtpk(y * bf2f(*zp), 0.f);
                }
            }
        }
        __syncthreads();
        if (!(probe & 2)) {
            const float dec = eacs[127];
#pragma unroll
            for (int r = 0; r < 16; ++r) St[r] *= dec;
            const int i16 = lane & 15, gsel = (lane >> 4) & 1;
#pragma unroll
            for (int ks = 0; ks < 8; ++ks) {
                const u32x4 xr = *(const LAS u32x4*)(lds + SD_XT + (32 * pt + c32) * SD_BP + ks * 32 + hi * 16);
                const f32x4 f0 = *(const LAS f32x4*)(dte + 16 * ks + 8 * hi), f1 = *(const LAS f32x4*)(dte + 16 * ks + 8 * hi + 4);
                u32x4 aw;
                aw.x = cvtpk(bflo(xr.x) * f0[0], bfhi(xr.x) * f0[1]); aw.y = cvtpk(bflo(xr.y) * f0[2], bfhi(xr.y) * f0[3]);
                aw.z = cvtpk(bflo(xr.z) * f1[0], bfhi(xr.z) * f1[1]); aw.w = cvtpk(bflo(xr.w) * f1[2], bfhi(xr.w) * f1[3]);
                const LAS unsigned char* bp = lds + SD_BM + (16 * ks + 8 * hi + (i16 >> 2)) * SD_BP + (32 * nt + 16 * gsel + 4 * (i16 & 3)) * 2;
                const v4i16_t t0v = __builtin_amdgcn_ds_read_tr16_b64_v4i16((LAS v4i16_t*)bp);
                const v4i16_t t1v = __builtin_amdgcn_ds_read_tr16_b64_v4i16((LAS v4i16_t*)(bp + 4 * SD_BP));
                const bf16x8 bfr = {t0v[0], t0v[1], t0v[2], t0v[3], t1v[0], t1v[1], t1v[2], t1v[3]};
                St = __builtin_amdgcn_mfma_f32_32x32x16_bf16(__builtin_bit_cast(bf16x8, aw), bfr, St, 0, 0, 0);
            }
#pragma unroll
            for (int r = 0; r < 16; r += 2) {
                const unsigned w2 = cvtpk(St[r], St[r + 1]);
                *(LAS unsigned short*)(lds + SD_SL + (32 * pt + crow(r, hi)) * SD_BP + (32 * nt + c32) * 2) = (unsigned short)(w2 & 0xffffu);
                *(LAS unsigned short*)(lds + SD_SL + (32 * pt + crow(r + 1, hi)) * SD_BP + (32 * nt + c32) * 2) = (unsigned short)(w2 >> 16);
            }
        }
        __syncthreads();
#pragma unroll
        for (int q = 0; q < 2; ++q) {
            const int e = tid + 512 * q, r = e >> 3;
            const u32x4 yv = *(const LAS u32x4*)(lds + SD_ZT + r * SD_XP + (e & 7) * 16);
            *(u32x4*)(ybase + (row0 + r) * ypitch + h * 64 + (e & 7) * 8) = yv;
            float sq = 0.f;
#pragma unroll
            for (int k = 0; k < 4; ++k) { const float lo = bflo(yv[k]), hi2 = bfhi(yv[k]); sq += lo * lo + hi2 * hi2; }
            sq = dpp_add<0x111, 0xf>(sq); sq = dpp_add<0x112, 0xf>(sq); sq = dpp_add<0x114, 0xf>(sq);
            if (ssqh != nullptr && (lane & 7) == 7) ssqh[(row0 + r) * 16 + h] = sq;
        }
        if (ch + 1 < SEQ / 128) {
            SSD_PF_COMMIT();
            if (wid == 0) {
                ssd_dt_chunk(lds, dr0, dr1, par ^ 1, lane, A2, dtb);
                if (ch + 2 < SEQ / 128) { dr0 = a.DT[(row0 + 256 + 2 * lane) * 16 + h]; dr1 = a.DT[(row0 + 256 + 2 * lane + 1) * 16 + h]; }
            }
        }
        __syncthreads();
    }
#undef SSD_PF_LOAD
#undef SSD_PF_COMMIT
}

constexpr int S5_Q = 64, S5_NCH = SEQ / S5_Q, S5_BP = 272, S5_XP = 144;
constexpr int S5_BM = 0, S5_CM = 64 * S5_BP, S5_XT = 2 * 64 * S5_BP, S5_WT = S5_XT + 64 * S5_XP, S5_ZT = S5_WT + 64 * S5_XP, S5_SET = S5_ZT + 64 * S5_XP;
constexpr int S5_SL = 2 * S5_SET, S5_F = S5_SL + 64 * S5_BP;
constexpr int S5_ACS = S5_F, S5_LACS = S5_F + 768, S5_DTE = S5_F + 1536, S5_EACS = S5_F + 2304, S5_CW = S5_F + 3072, S5_DTA = S5_CW + 5 * 64 * 4, S5_END = S5_DTA + SEQ * 4;
static_assert(S5_END <= MISC_OFF, "SSD5 LDS map");
__device__ __forceinline__ void ssd5_dt(LAS unsigned char* lds, int ch, int lane, float A2) {
    const int sl = (ch % 3) * 64 + lane;
    const float d = ((const LAS float*)(lds + S5_DTA))[ch * S5_Q + lane];
    float incl = d * A2;
    incl = dpp_add<0x111, 0xf>(incl); incl = dpp_add<0x112, 0xf>(incl); incl = dpp_add<0x114, 0xf>(incl); incl = dpp_add<0x118, 0xf>(incl);
    incl = dpp_add<0x142, 0xa>(incl); incl = dpp_add<0x143, 0xc>(incl);
    const float tot = __builtin_bit_cast(float, __builtin_amdgcn_readlane(__builtin_bit_cast(int, incl), 63));
    ((LAS float*)(lds + S5_ACS))[sl] = incl;
    ((LAS float*)(lds + S5_LACS))[sl] = incl - __builtin_amdgcn_logf(d);
    ((LAS float*)(lds + S5_DTE))[sl] = d * __builtin_amdgcn_exp2f(tot - incl);
    ((LAS float*)(lds + S5_EACS))[sl] = __builtin_amdgcn_exp2f(incl);
}
__device__ __forceinline__ void ssd_unit5(const SsdArgs& a, int unit, LAS unsigned char* lds, bf16* ybase, int ypitch, float* ssqh, const bf16* __restrict__ BC, int wv) {
    const int tid = opaque_tid(wv), lane = tid & 63, wid = __builtin_amdgcn_readfirstlane(tid >> 6), c32 = lane & 31, hi = lane >> 5;
    const int b = unit >> 4, h = unit & 15, g = h >> 3;
    const float A2 = -__expf(a.a_log[h]) * 1.4426950408889634f, Dk = a.dskip[h], dtb = a.dt_bias[h];
    const size_t tok0 = (size_t)b * SEQ;
    LAS float* cwl = (LAS float*)(lds + S5_CW);
    for (int e = tid; e < 5 * 64; e += NTHR) { const int k = e >> 6, c = e & 63; cwl[e] = k < 4 ? a.conv_w[k * 1536 + h * 64 + c] : a.conv_b[h * 64 + c]; }
    for (int e = tid; e < 64 * S5_BP / 4; e += NTHR) ((LAS unsigned*)(lds + S5_SL))[e] = 0u;
    {
        float r4[4];
#pragma unroll
        for (int q = 0; q < 4; ++q) r4[q] = a.DT[(tok0 + tid + NTHR * q) * 16 + h];
#pragma unroll
        for (int q = 0; q < 4; ++q) ((LAS float*)(lds + S5_DTA))[tid + NTHR * q] = softplusf(r4[q] + dtb);
    }
    const int t = tid & 255, xc = t & 7, tp = t >> 3;
    u32x4 pbc[8] = {}, pxr[5] = {}, pz[2] = {};
#define S5_LOAD(CH) do { const size_t r0_ = tok0 + (size_t)(CH) * S5_Q; \
        _Pragma("unroll") for (int q = 0; q < 8; ++q) { const int e = t + 256 * q, r = e >> 5, ci = e & 31; \
            pbc[q] = *(const u32x4*)(BC + (r0_ + r) * 512 + (ci < 16 ? g * 128 + ci * 8 : 256 + g * 128 + (ci - 16) * 8)); } \
        _Pragma("unroll") for (int k = 0; k < 5; ++k) { const int tk = (CH) * S5_Q + 2 * tp - 3 + k; pxr[k] = (u32x4){0u, 0u, 0u, 0u}; \
            if (tk >= 0) pxr[k] = *(const u32x4*)(a.P + (tok0 + tk) * PW + P_XS + h * 64 + xc * 8); } \
        _Pragma("unroll") for (int q = 0; q < 2; ++q) { const int e = t + 256 * q; pz[q] = *(const u32x4*)(a.ZY + (r0_ + (e >> 3)) * ZYW + h * 64 + (e & 7) * 8); } } while (0)
#define S5_COMMIT(CH) do { LAS unsigned char* sb_ = lds + ((CH) & 1) * S5_SET; \
        _Pragma("unroll") for (int q = 0; q < 8; ++q) { const int e = t + 256 * q, r = e >> 5, ci = e & 31; \
            *(LAS u32x4*)(sb_ + (ci < 16 ? S5_BM + ci * 16 : S5_CM + (ci - 16) * 16) + r * S5_BP) = pbc[q]; } \
        _Pragma("unroll") for (int q = 0; q < 2; ++q) { const int e = t + 256 * q; *(LAS u32x4*)(sb_ + S5_ZT + (e >> 3) * S5_XP + (e & 7) * 16) = pz[q]; } \
        const f32x2 de_ = *(const LAS f32x2*)((const LAS float*)(lds + S5_DTE) + ((CH) % 3) * 64 + 2 * tp); \
        _Pragma("unroll") for (int e2 = 0; e2 < 4; ++e2) { const int c0 = xc * 8 + 2 * e2; \
            f32x2 va = *(const LAS f32x2*)(cwl + 4 * 64 + c0), vc = va; \
            _Pragma("unroll") for (int k = 0; k < 4; ++k) { const f32x2 w2 = *(const LAS f32x2*)(cwl + k * 64 + c0); \
                va += w2 * (f32x2){bflo(pxr[k][e2]), bfhi(pxr[k][e2])}; vc += w2 * (f32x2){bflo(pxr[k + 1][e2]), bfhi(pxr[k + 1][e2])}; } \
            va.x = siluf(va.x); va.y = siluf(va.y); vc.x = siluf(vc.x); vc.y = siluf(vc.y); \
            *(LAS unsigned*)(sb_ + S5_XT + c0 * S5_XP + tp * 4) = cvtpk(va.x, vc.x); \
            *(LAS unsigned*)(sb_ + S5_XT + (c0 + 1) * S5_XP + tp * 4) = cvtpk(va.y, vc.y); \
            *(LAS unsigned*)(sb_ + S5_WT + c0 * S5_XP + tp * 4) = cvtpk(va.x * de_.x, vc.x * de_.y); \
            *(LAS unsigned*)(sb_ + S5_WT + (c0 + 1) * S5_XP + tp * 4) = cvtpk(va.y * de_.x, vc.y * de_.y); } } while (0)
#define S5_YSTORE(CH) do { const size_t r0_ = tok0 + (size_t)(CH) * S5_Q; \
        _Pragma("unroll") for (int q = 0; q < 2; ++q) { const int e = t + 256 * q, r = e >> 3; \
            const u32x4 yv = *(const LAS u32x4*)(lds + ((CH) & 1) * S5_SET + S5_ZT + r * S5_XP + (e & 7) * 16); \
            *(u32x4*)(ybase + (r0_ + r) * ypitch + h * 64 + (e & 7) * 8) = yv; \
            float sq = 0.f; _Pragma("unroll") for (int k = 0; k < 4; ++k) { const float lo = bflo(yv[k]), hi2 = bfhi(yv[k]); sq += lo * lo + hi2 * hi2; } \
            sq = dpp_add<0x111, 0xf>(sq); sq = dpp_add<0x112, 0xf>(sq); sq = dpp_add<0x114, 0xf>(sq); \
            if (ssqh != nullptr && (lane & 7) == 7) ssqh[(r0_ + r) * 16 + h] = sq; } } while (0)
    __syncthreads();
    if (wid >= 4) S5_LOAD(0);
    if (wid == 4) { ssd5_dt(lds, 0, lane, A2); ssd5_dt(lds, 1, lane, A2); }
    __syncthreads();
    if (wid >= 4) { S5_COMMIT(0); S5_LOAD(1); }
    __syncthreads();
    if (wid < 4) {
        const int it = (wid >> 1) & 1, ph = wid & 1;
        const int nst = wid < 2 ? 3 : 1, st0 = wid < 2 ? 3 * wid : 4 + wid;
        f32x16 St[3];
#pragma unroll
        for (int k = 0; k < 3; ++k) St[k] = (f32x16){0.f, 0.f, 0.f, 0.f, 0.f, 0.f, 0.f, 0.f, 0.f, 0.f, 0.f, 0.f, 0.f, 0.f, 0.f, 0.f};
#pragma unroll 1
        for (int ch = 0; ch < S5_NCH; ++ch) {
            LAS unsigned char* sb = lds + (ch & 1) * S5_SET;
            const int sl = (ch % 3) * 64;
            const LAS float* acs2 = (const LAS float*)(lds + S5_ACS) + sl; const LAS float* lacs = (const LAS float*)(lds + S5_LACS) + sl; const LAS float* eacs = (const LAS float*)(lds + S5_EACS) + sl;
            {
                bf16x8 cf[8];
#pragma unroll
                for (int ks = 0; ks < 8; ++ks) cf[ks] = *(const LAS bf16x8*)(sb + S5_CM + (32 * it + c32) * S5_BP + ks * 32 + hi * 16);
                f32x16 Yd = {0.f, 0.f, 0.f, 0.f, 0.f, 0.f, 0.f, 0.f, 0.f, 0.f, 0.f, 0.f, 0.f, 0.f, 0.f, 0.f};
                const float ai = acs2[32 * it + c32];
#pragma unroll
                for (int jt = 0; jt < 2; ++jt) {
                    if (jt <= it) {
                        f32x16 X = {0.f, 0.f, 0.f, 0.f, 0.f, 0.f, 0.f, 0.f, 0.f, 0.f, 0.f, 0.f, 0.f, 0.f, 0.f, 0.f};
#pragma unroll
                        for (int ks = 0; ks < 8; ++ks) {
                            const bf16x8 bfr = *(const LAS bf16x8*)(sb + S5_BM + (32 * jt + c32) * S5_BP + ks * 32 + hi * 16);
                            X = __builtin_amdgcn_mfma_f32_32x32x16_bf16(bfr, cf[ks], X, 0, 0, 0);
                        }
#pragma unroll
                        for (int r4 = 0; r4 < 4; ++r4) {
                            const f32x4 aj = *(const LAS f32x4*)(lacs + 32 * jt + 8 * r4 + 4 * hi);
#pragma unroll
                            for (int q = 0; q < 4; ++q) {
                                const int r = 4 * r4 + q, jr = 8 * r4 + 4 * hi + q;
                                float f = __builtin_amdgcn_exp2f(ai - aj[q]);
                                if (jt == it && jr > c32) f = 0.f;
                                X[r] *= f;
                            }
                        }
#pragma unroll
                        for (int s2 = 0; s2 < 2; ++s2) {
                            u32x4 pw;
                            pw.x = cvtpk(X[8 * s2 + 0], X[8 * s2 + 1]); pw.y = cvtpk(X[8 * s2 + 2], X[8 * s2 + 3]);
                            pw.z = cvtpk(X[8 * s2 + 4], X[8 * s2 + 5]); pw.w = cvtpk(X[8 * s2 + 6], X[8 * s2 + 7]);
                            const LAS unsigned char* vp = sb + S5_XT + (32 * ph + c32) * S5_XP + (32 * jt + 16 * s2 + 4 * hi) * 2;
                            const s16x4 v0 = *(const LAS s16x4*)vp, v1 = *(const LAS s16x4*)(vp + 16);
                            const bf16x8 vf = {v0[0], v0[1], v0[2], v0[3], v1[0], v1[1], v1[2], v1[3]};
                            Yd = __builtin_amdgcn_mfma_f32_32x32x16_bf16(__builtin_bit_cast(bf16x8, pw), vf, Yd, 0, 0, 0);
                        }
                    }
                }
                f32x16 Yo = {0.f, 0.f, 0.f, 0.f, 0.f, 0.f, 0.f, 0.f, 0.f, 0.f, 0.f, 0.f, 0.f, 0.f, 0.f, 0.f};
#pragma unroll
                for (int ks = 0; ks < 8; ++ks) {
                    const bf16x8 sf = *(const LAS bf16x8*)(lds + S5_SL + (32 * ph + c32) * S5_BP + ks * 32 + hi * 16);
                    Yo = __builtin_amdgcn_mfma_f32_32x32x16_bf16(cf[ks], sf, Yo, 0, 0, 0);
                }
                const int pcol = 32 * ph + c32;
#pragma unroll
                for (int r4 = 0; r4 < 4; ++r4) {
                    const f32x4 ea = *(const LAS f32x4*)(eacs + 32 * it + 8 * r4 + 4 * hi);
                    const u32x2 xw = *(const LAS u32x2*)(sb + S5_XT + pcol * S5_XP + (32 * it + 8 * r4 + 4 * hi) * 2);
                    const float xs4[4] = {bflo(xw.x), bfhi(xw.x), bflo(xw.y), bfhi(xw.y)};
#pragma unroll
                    for (int q = 0; q < 4; ++q) {
                        const int r = 4 * r4 + q, i = 32 * it + 8 * r4 + 4 * hi + q;
                        const float y = Yd[r] + ea[q] * Yo[r] + Dk * xs4[q];
                        LAS unsigned short* zp = (LAS unsigned short*)(sb + S5_ZT + i * S5_XP + pcol * 2);
                        *zp = (unsigned short)cvtpk(y * bf2f(*zp), 0.f);
                    }
                }
            }
            asm volatile("s_waitcnt lgkmcnt(0)" ::: "memory"); __builtin_amdgcn_s_barrier();
            {
                const float dec = eacs[63];
                const int i16 = lane & 15, gsel = (lane >> 4) & 1;
#pragma unroll
                for (int k = 0; k < 3; ++k) {
                    if (k < nst) {
                        const int tl = st0 + k, pt = tl >> 2, nt = tl & 3;
                        f32x16 acc = St[k];
#pragma unroll
                        for (int r = 0; r < 16; ++r) acc[r] *= dec;
#pragma unroll
                        for (int ks = 0; ks < 4; ++ks) {
                            const bf16x8 aw = *(const LAS bf16x8*)(sb + S5_WT + (32 * pt + c32) * S5_XP + ks * 32 + hi * 16);
                            const LAS unsigned char* bp = sb + S5_BM + (16 * ks + 8 * hi + (i16 >> 2)) * S5_BP + (32 * nt + 16 * gsel + 4 * (i16 & 3)) * 2;
                            const v4i16_t t0v = __builtin_amdgcn_ds_read_tr16_b64_v4i16((LAS v4i16_t*)bp);
                            const v4i16_t t1v = __builtin_amdgcn_ds_read_tr16_b64_v4i16((LAS v4i16_t*)(bp + 4 * S5_BP));
                            const bf16x8 bfr = {t0v[0], t0v[1], t0v[2], t0v[3], t1v[0], t1v[1], t1v[2], t1v[3]};
                            acc = __builtin_amdgcn_mfma_f32_32x32x16_bf16(aw, bfr, acc, 0, 0, 0);
                        }
                        St[k] = acc;
#pragma unroll
                        for (int r = 0; r < 16; r += 2) {
                            const unsigned w2 = cvtpk(acc[r], acc[r + 1]);
                            *(LAS unsigned short*)(lds + S5_SL + (32 * pt + crow(r, hi)) * S5_BP + (32 * nt + c32) * 2) = (unsigned short)(w2 & 0xffffu);
                            *(LAS unsigned short*)(lds + S5_SL + (32 * pt + crow(r + 1, hi)) * S5_BP + (32 * nt + c32) * 2) = (unsigned short)(w2 >> 16);
                        }
                    }
                }
            }
            asm volatile("s_waitcnt lgkmcnt(0)" ::: "memory"); __builtin_amdgcn_s_barrier();
        }
    } else {
#pragma unroll 1
        for (int ch = 0; ch < S5_NCH; ++ch) {
            if (ch >= 1) S5_YSTORE(ch - 1);
            if (ch + 1 < S5_NCH) {
                S5_COMMIT(ch + 1);
                if (ch + 2 < S5_NCH) { S5_LOAD(ch + 2); if (wid == 4) ssd5_dt(lds, ch + 2, lane, A2); }
            }
            __builtin_amdgcn_s_barrier();
            asm volatile("s_waitcnt lgkmcnt(0)" ::: "memory"); __builtin_amdgcn_s_barrier();
        }
        S5_YSTORE(S5_NCH - 1);
    }
    __syncthreads();
#undef S5_LOAD
#undef S5_COMMIT
#undef S5_YSTORE
}

constexpr int S6_SL = 2 * S5_SET, S6_F = S6_SL + 2 * 16384;
constexpr int S6_ACS = S6_F, S6_LACS = S6_F + 768, S6_DTE = S6_F + 1536, S6_EACS = S6_F + 2304, S6_CW = S6_F + 3072, S6_END = S6_CW + 5 * 64 * 4;
static_assert(S6_END <= MISC_OFF, "SSD6 LDS map");
__device__ __forceinline__ float dot2sq(unsigned v, float acc) { const bf16x2_t_ b = __builtin_bit_cast(bf16x2_t_, v); return __builtin_amdgcn_fdot2_f32_bf16(b, b, acc, false); }
__device__ __forceinline__ void ssd6_dt(LAS unsigned char* lds, int ch, int lane, float A2, float d) {
    const int sl = (ch % 3) * 64 + lane;
    float incl = d * A2;
    incl = dpp_add<0x111, 0xf>(incl); incl = dpp_add<0x112, 0xf>(incl); incl = dpp_add<0x114, 0xf>(incl); incl = dpp_add<0x118, 0xf>(incl);
    incl = dpp_add<0x142, 0xa>(incl); incl = dpp_add<0x143, 0xc>(incl);
    const float tot = __builtin_bit_cast(float, __builtin_amdgcn_readlane(__builtin_bit_cast(int, incl), 63));
    ((LAS float*)(lds + S6_ACS))[sl] = incl;
    ((LAS float*)(lds + S6_LACS))[sl] = incl - __builtin_amdgcn_logf(d);
    ((LAS float*)(lds + S6_DTE))[sl] = d * __builtin_amdgcn_exp2f(tot - incl);
    ((LAS float*)(lds + S6_EACS))[sl] = __builtin_amdgcn_exp2f(incl);
}
__device__ __forceinline__ void ssd6_state_tile(f32x16& St, const LAS unsigned char* sb, LAS unsigned char* sw, int pt, int nt, float dec, int lane) {
    const int c32 = lane & 31, hi = lane >> 5, i16 = lane & 15, gsel = (lane >> 4) & 1;
    bf16x8 aw[4]; v4i16_t t0v[4], t1v[4];
#pragma unroll
    for (int ks = 0; ks < 4; ++ks) {
        aw[ks] = *(const LAS bf16x8*)(sb + S5_WT + (32 * pt + c32) * S5_XP + ks * 32 + hi * 16);
        const LAS unsigned char* bp = sb + S5_BM + (16 * ks + 8 * hi + (i16 >> 2)) * S5_BP + (32 * nt + 16 * gsel + 4 * (i16 & 3)) * 2;
        t0v[ks] = __builtin_amdgcn_ds_read_tr16_b64_v4i16((LAS v4i16_t*)bp);
        t1v[ks] = __builtin_amdgcn_ds_read_tr16_b64_v4i16((LAS v4i16_t*)(bp + 4 * S5_BP));
    }
    f32x16 acc = St;
#pragma unroll
    for (int r = 0; r < 16; ++r) acc[r] *= dec;
#pragma unroll
    for (int ks = 0; ks < 4; ++ks) {
        const bf16x8 bfr = {t0v[ks][0], t0v[ks][1], t0v[ks][2], t0v[ks][3], t1v[ks][0], t1v[ks][1], t1v[ks][2], t1v[ks][3]};
        acc = __builtin_amdgcn_mfma_f32_32x32x16_bf16(aw[ks], bfr, acc, 0, 0, 0);
    }
    St = acc;
    const int bx = (64 * nt + 2 * c32) ^ (hi << 6);
    LAS unsigned char* wb = sw + (32 * pt + 4 * hi) * 256;
#pragma unroll
    for (int r = 0; r < 16; r += 2) {
        const unsigned w2 = cvtpk(acc[r], acc[r + 1]);
        const int a0 = (r & 3) + 8 * ((r >> 2) & 1), a1 = ((r + 1) & 3) + 8 * (((r + 1) >> 2) & 1);
        *(LAS unsigned short*)(wb + ((r & 3) + 8 * (r >> 2)) * 256 + (bx ^ (a0 << 4))) = (unsigned short)(w2 & 0xffffu);
        *(LAS unsigned short*)(wb + (((r + 1) & 3) + 8 * ((r + 1) >> 2)) * 256 + (bx ^ (a1 << 4))) = (unsigned short)(w2 >> 16);
    }
}
struct StFrag { bf16x8 aw[4]; v4i16_t t0v[4], t1v[4]; };
__device__ __forceinline__ void ssd6_state_load(StFrag& f, const LAS unsigned char* sb, int pt, int nt, int lane) {
    const int c32 = lane & 31, hi = lane >> 5, i16 = lane & 15, gsel = (lane >> 4) & 1;
#pragma unroll
    for (int ks = 0; ks < 4; ++ks) {
        f.aw[ks] = *(const LAS bf16x8*)(sb + S5_WT + (32 * pt + c32) * S5_XP + ks * 32 + hi * 16);
        const LAS unsigned char* bp = sb + S5_BM + (16 * ks + 8 * hi + (i16 >> 2)) * S5_BP + (32 * nt + 16 * gsel + 4 * (i16 & 3)) * 2;
        f.t0v[ks] = __builtin_amdgcn_ds_read_tr16_b64_v4i16((LAS v4i16_t*)bp);
        f.t1v[ks] = __builtin_amdgcn_ds_read_tr16_b64_v4i16((LAS v4i16_t*)(bp + 4 * S5_BP));
    }
}
__device__ __forceinline__ void ssd6_state_mma(f32x16& St, const StFrag& f, float dec) {
    f32x16 acc = St;
#pragma unroll
    for (int r = 0; r < 16; ++r) acc[r] *= dec;
#pragma unroll
    for (int ks = 0; ks < 4; ++ks) {
        const bf16x8 bfr = {f.t0v[ks][0], f.t0v[ks][1], f.t0v[ks][2], f.t0v[ks][3], f.t1v[ks][0], f.t1v[ks][1], f.t1v[ks][2], f.t1v[ks][3]};
        acc = __builtin_amdgcn_mfma_f32_32x32x16_bf16(f.aw[ks], bfr, acc, 0, 0, 0);
    }
    St = acc;
}
__device__ __forceinline__ void ssd6_state_store(const f32x16& acc, LAS unsigned char* sw, int pt, int nt, int lane) {
    const int c32 = lane & 31, hi = lane >> 5;
    const int bx = (64 * nt + 2 * c32) ^ (hi << 6);
    LAS unsigned char* wb = sw + (32 * pt + 4 * hi) * 256;
#pragma unroll
    for (int r = 0; r < 16; r += 2) {
        const unsigned w2 = cvtpk(acc[r], acc[r + 1]);
        const int a0 = (r & 3) + 8 * ((r >> 2) & 1), a1 = ((r + 1) & 3) + 8 * (((r + 1) >> 2) & 1);
        *(LAS unsigned short*)(wb + ((r & 3) + 8 * (r >> 2)) * 256 + (bx ^ (a0 << 4))) = (unsigned short)(w2 & 0xffffu);
        *(LAS unsigned short*)(wb + (((r + 1) & 3) + 8 * ((r + 1) >> 2)) * 256 + (bx ^ (a1 << 4))) = (unsigned short)(w2 >> 16);
    }
}
template <bool DIAG>
__device__ __forceinline__ void ssd6_maskf(float (&f)[16], float ai, const f32x4 (&aj)[4], int c32, int hi) {
#pragma unroll
    for (int r4 = 0; r4 < 4; ++r4)
#pragma unroll
        for (int q = 0; q < 4; ++q) {
            const int r = 4 * r4 + q, jr = 8 * r4 + 4 * hi + q;
            float v = __builtin_amdgcn_exp2f(ai - aj[r4][q]);
            if (DIAG && jr > c32) v = 0.f;
            f[r] = v;
        }
}
__device__ __forceinline__ void ssd6_yd(f32x16& Yd, const f32x16& X, const s16x4 (&xv)[4]) {
#pragma unroll
    for (int s2 = 0; s2 < 2; ++s2) {
        u32x4 pw;
        pw.x = cvtpk(X[8 * s2 + 0], X[8 * s2 + 1]); pw.y = cvtpk(X[8 * s2 + 2], X[8 * s2 + 3]);
        pw.z = cvtpk(X[8 * s2 + 4], X[8 * s2 + 5]); pw.w = cvtpk(X[8 * s2 + 6], X[8 * s2 + 7]);
        const bf16x8 vf = {xv[2 * s2][0], xv[2 * s2][1], xv[2 * s2][2], xv[2 * s2][3], xv[2 * s2 + 1][0], xv[2 * s2 + 1][1], xv[2 * s2 + 1][2], xv[2 * s2 + 1][3]};
        Yd = __builtin_amdgcn_mfma_f32_32x32x16_bf16(__builtin_bit_cast(bf16x8, pw), vf, Yd, 0, 0, 0);
    }
}
template <int PROBE>
__device__ __forceinline__ void ssd_unit6(const SsdArgs& a, int unit, LAS unsigned char* lds, bf16* ybase, int ypitch, float* ssqh, const bf16* __restrict__ BC, int wv) {
    const int tid = opaque_tid(wv), lane = tid & 63, wid = __builtin_amdgcn_readfirstlane(tid >> 6), c32 = lane & 31, hi = lane >> 5;
    const int b = unit >> 4, h = unit & 15, g = h >> 3;
    const float A2 = -__expf(a.a_log[h]) * 1.4426950408889634f, Dk = a.dskip[h], dtb = a.dt_bias[h];
    const size_t tok0 = (size_t)b * SEQ;
    LAS float* cwl = (LAS float*)(lds + S6_CW);
    for (int e = tid; e < 5 * 64; e += NTHR) { const int k = e >> 6, c = e & 63; cwl[e] = k < 4 ? a.conv_w[k * 1536 + h * 64 + c] : a.conv_b[h * 64 + c]; }
    for (int e = tid; e < 2 * 16384 / 4; e += NTHR) ((LAS unsigned*)(lds + S6_SL))[e] = 0u;
    const int t = tid & 255, xc = t & 7, tp = t >> 3;
    u32x4 pbc0[8] = {}, pxr0[5] = {}, pz0[2] = {}, pbc1[8] = {}, pxr1[5] = {}, pz1[2] = {};
    const unsigned cBC = (unsigned)(tok0 * 1024 + g * 256) + (unsigned)((t >> 5) * 1024 + ((t & 31) < 16 ? (t & 31) * 16 : 512 + ((t & 31) - 16) * 16));
    const unsigned cP = (unsigned)(tok0 * (PW * 2) + (P_XS + h * 64) * 2) + (unsigned)(2 * tp * (PW * 2) + xc * 16);
    const unsigned cZ = (unsigned)(tok0 * (ZYW * 2) + h * 128) + (unsigned)((t >> 3) * (ZYW * 2) + (t & 7) * 16);
    const unsigned cY = (unsigned)(tok0 * (ypitch * 2) + h * 128) + (unsigned)((t >> 3) * (ypitch * 2) + (t & 7) * 16);
    const unsigned cQ = (unsigned)((tok0 * 16 + h) * 4) + (unsigned)((t >> 3) * 64);
    const char* BCb = (const char*)BC; const char* Pb = (const char*)a.P; const char* Zb = (const char*)a.ZY; char* Yb = (char*)ybase; char* Qb = (char*)ssqh;
#define S6_LOAD(CH, S) do { \
        _Pragma("unroll") for (int q = 0; q < 8; ++q) pbc##S[q] = *(const u32x4*)(BCb + (cBC + (unsigned)((CH) * (S5_Q * 1024) + q * 8192))); \
        _Pragma("unroll") for (int k = 0; k < 5; ++k) pxr##S[k] = *(const u32x4*)(Pb + (cP + (unsigned)(((CH) * S5_Q - 3 + k) * (PW * 2)))); \
        _Pragma("unroll") for (int q = 0; q < 2; ++q) pz##S[q] = *(const u32x4*)(Zb + (cZ + (unsigned)(((CH) * S5_Q + 32 * q) * (ZYW * 2)))); } while (0)
#define S6_LOAD0(S) do { \
        _Pragma("unroll") for (int q = 0; q < 8; ++q) pbc##S[q] = *(const u32x4*)(BCb + (cBC + (unsigned)(q * 8192))); \
        _Pragma("unroll") for (int k = 0; k < 5; ++k) { pxr##S[k] = (u32x4){0u, 0u, 0u, 0u}; if (2 * tp - 3 + k >= 0) pxr##S[k] = *(const u32x4*)(Pb + (cP + (unsigned)((k - 3) * (PW * 2)))); } \
        _Pragma("unroll") for (int q = 0; q < 2; ++q) pz##S[q] = *(const u32x4*)(Zb + (cZ + (unsigned)(32 * q * (ZYW * 2)))); } while (0)
#define S6_COMMIT(CH, S) do { LAS unsigned char* sb_ = lds + ((CH) & 1) * S5_SET; \
        _Pragma("unroll") for (int q = 0; q < 8; ++q) { const int e = t + 256 * q, r = e >> 5, ci = e & 31; \
            *(LAS u32x4*)(sb_ + (ci < 16 ? S5_BM + ci * 16 : S5_CM + (ci - 16) * 16) + r * S5_BP) = pbc##S[q]; } \
        _Pragma("unroll") for (int q = 0; q < 2; ++q) { const int e = t + 256 * q; *(LAS u32x4*)(sb_ + S5_ZT + (e >> 3) * S5_XP + (e & 7) * 16) = pz##S[q]; } \
        const f32x2 de_ = *(const LAS f32x2*)((const LAS float*)(lds + S6_DTE) + ((CH) % 3) * 64 + 2 * tp); \
        f32x2 wt_[5][4];        \
        _Pragma("unroll") for (int e2 = 0; e2 < 4; ++e2) _Pragma("unroll") for (int k = 0; k < 5; ++k) wt_[k][e2] = *(const LAS f32x2*)(cwl + k * 64 + xc * 8 + 2 * e2); \
        __builtin_amdgcn_sched_barrier(0); \
        _Pragma("unroll") for (int e2 = 0; e2 < 4; ++e2) { const int c0 = xc * 8 + 2 * e2; \
            f32x2 va = wt_[4][e2], vc = va; \
            _Pragma("unroll") for (int k = 0; k < 4; ++k) { const f32x2 w2 = wt_[k][e2]; \
                va += w2 * (f32x2){bflo(pxr##S[k][e2]), bfhi(pxr##S[k][e2])}; vc += w2 * (f32x2){bflo(pxr##S[k + 1][e2]), bfhi(pxr##S[k + 1][e2])}; } \
            va.x = siluf(va.x); va.y = siluf(va.y); vc.x = siluf(vc.x); vc.y = siluf(vc.y); \
            *(LAS unsigned*)(sb_ + S5_XT + c0 * S5_XP + tp * 4) = cvtpk(va.x, vc.x); \
            *(LAS unsigned*)(sb_ + S5_XT + (c0 + 1) * S5_XP + tp * 4) = cvtpk(va.y, vc.y); \
            *(LAS unsigned*)(sb_ + S5_WT + c0 * S5_XP + tp * 4) = cvtpk(va.x * de_.x, vc.x * de_.y); \
            *(LAS unsigned*)(sb_ + S5_WT + (c0 + 1) * S5_XP + tp * 4) = cvtpk(va.y * de_.x, vc.y * de_.y); } } while (0)
#define S6_YSTORE(CH) do { \
        _Pragma("unroll") for (int q = 0; q < 2; ++q) { const int e = t + 256 * q, r = e >> 3; \
            const u32x4 yv = *(const LAS u32x4*)(lds + ((CH) & 1) * S5_SET + S5_ZT + r * S5_XP + (e & 7) * 16); \
            *(u32x4*)(Yb + (cY + (unsigned)(((CH) * S5_Q + 32 * q) * (ypitch * 2)))) = yv; \
            float sq = dot2sq(yv.x, 0.f); sq = dot2sq(yv.y, sq); sq = dot2sq(yv.z, sq); sq = dot2sq(yv.w, sq); \
            sq = dpp_add<0x111, 0xf>(sq); sq = dpp_add<0x112, 0xf>(sq); sq = dpp_add<0x114, 0xf>(sq); \
            if (ssqh != nullptr && (lane & 7) == 7) *(float*)(Qb + (cQ + (unsigned)(((CH) * S5_Q + 32 * q) * 64))) = sq; } } while (0)
#define S6_BAR() do { asm volatile("s_waitcnt lgkmcnt(0)" ::: "memory"); __builtin_amdgcn_s_barrier(); } while (0)
    if (wid >= 4) S6_LOAD0(0);
    if (wid == 0) {
        const float da = a.DT[(tok0 + lane) * 16 + h], db = a.DT[(tok0 + 64 + lane) * 16 + h];
        ssd6_dt(lds, 0, lane, A2, softplusf(da + dtb)); ssd6_dt(lds, 1, lane, A2, softplusf(db + dtb));
    }
    __syncthreads();
    if (wid >= 4) { S6_COMMIT(0, 0); S6_LOAD(1, 1); S6_LOAD(2, 0); }
    __syncthreads();
    if (wid < 4) {
        const int it = (wid >> 1) & 1, ph = wid & 1;
        __builtin_amdgcn_s_waitcnt(0x0F70);
        f32x16 St0 = {0.f, 0.f, 0.f, 0.f, 0.f, 0.f, 0.f, 0.f, 0.f, 0.f, 0.f, 0.f, 0.f, 0.f, 0.f, 0.f}, St1 = St0;
        const int srd = (32 * ph + c32) * 256, sxr = (hi << 4) ^ ((c32 & 15) << 4);
#pragma unroll 1
        for (int ch = 0; ch < S5_NCH; ++ch) {
            LAS unsigned char* sb = lds + (ch & 1) * S5_SET;
            const LAS unsigned char* sr = lds + S6_SL + ((ch + 1) & 1) * 16384 + srd;
            const int sl = (ch % 3) * 64;
            const LAS float* acs2 = (const LAS float*)(lds + S6_ACS) + sl; const LAS float* lacs = (const LAS float*)(lds + S6_LACS) + sl; const LAS float* eacs = (const LAS float*)(lds + S6_EACS) + sl;
            float drw = 0.f;
            if (wid == 0 && ch + 2 < S5_NCH) { const float* dp = a.DT + (tok0 + (ch + 2) * S5_Q + lane) * 16 + h; asm volatile("global_load_dword %0, %1, off" : "=&v"(drw) : "v"(dp) : "memory"); }
            if (!(PROBE & 1)) {
                bf16x8 cf[8], bj[8], sf[8];
#pragma unroll
                for (int ks = 0; ks < 8; ++ks) cf[ks] = *(const LAS bf16x8*)(sb + S5_CM + (32 * it + c32) * S5_BP + ks * 32 + hi * 16);
#pragma unroll
                for (int ks = 0; ks < 8; ++ks) bj[ks] = *(const LAS bf16x8*)(sb + S5_BM + c32 * S5_BP + ks * 32 + hi * 16);
#pragma unroll
                for (int ks = 0; ks < 8; ++ks) sf[ks] = *(const LAS bf16x8*)(sr + (sxr ^ (ks << 5)));
                const float ai = acs2[32 * it + c32];
                f32x4 aj0[4]; s16x4 xv0[4];
#pragma unroll
                for (int r4 = 0; r4 < 4; ++r4) aj0[r4] = *(const LAS f32x4*)(lacs + 8 * r4 + 4 * hi);
#pragma unroll
                for (int s2 = 0; s2 < 2; ++s2) { const LAS unsigned char* vp = sb + S5_XT + (32 * ph + c32) * S5_XP + (16 * s2 + 4 * hi) * 2; xv0[2 * s2] = *(const LAS s16x4*)vp; xv0[2 * s2 + 1] = *(const LAS s16x4*)(vp + 16); }
                f32x16 X = {0.f, 0.f, 0.f, 0.f, 0.f, 0.f, 0.f, 0.f, 0.f, 0.f, 0.f, 0.f, 0.f, 0.f, 0.f, 0.f}, Yo = X, Yd = X;
#pragma unroll
                for (int ks = 0; ks < 8; ++ks) X = __builtin_amdgcn_mfma_f32_32x32x16_bf16(bj[ks], cf[ks], X, 0, 0, 0);
#pragma unroll
                for (int ks = 0; ks < 8; ++ks) Yo = __builtin_amdgcn_mfma_f32_32x32x16_bf16(cf[ks], sf[ks], Yo, 0, 0, 0);
                float f0[16];
                if (it == 0) ssd6_maskf<true>(f0, ai, aj0, c32, hi); else ssd6_maskf<false>(f0, ai, aj0, c32, hi);
#pragma unroll
                for (int i = 0; i < 16; ++i) { __builtin_amdgcn_sched_group_barrier(0x008, 1, 0); __builtin_amdgcn_sched_group_barrier(0x002, 2, 0); __builtin_amdgcn_sched_group_barrier(0x400, 1, 0); }
                if (it == 1) {
                    f32x4 aj1[4]; s16x4 xv1[4];
#pragma unroll
                    for (int ks = 0; ks < 8; ++ks) bj[ks] = *(const LAS bf16x8*)(sb + S5_BM + (32 + c32) * S5_BP + ks * 32 + hi * 16);
#pragma unroll
                    for (int r4 = 0; r4 < 4; ++r4) aj1[r4] = *(const LAS f32x4*)(lacs + 32 + 8 * r4 + 4 * hi);
#pragma unroll
                    for (int s2 = 0; s2 < 2; ++s2) { const LAS unsigned char* vp = sb + S5_XT + (32 * ph + c32) * S5_XP + (32 + 16 * s2 + 4 * hi) * 2; xv1[2 * s2] = *(const LAS s16x4*)vp; xv1[2 * s2 + 1] = *(const LAS s16x4*)(vp + 16); }
#pragma unroll
                    for (int r = 0; r < 16; ++r) X[r] *= f0[r];
                    ssd6_yd(Yd, X, xv0);
                    f32x16 X1 = {0.f, 0.f, 0.f, 0.f, 0.f, 0.f, 0.f, 0.f, 0.f, 0.f, 0.f, 0.f, 0.f, 0.f, 0.f, 0.f};
#pragma unroll
                    for (int ks = 0; ks < 8; ++ks) X1 = __builtin_amdgcn_mfma_f32_32x32x16_bf16(bj[ks], cf[ks], X1, 0, 0, 0);
                    float f1[16];
                    ssd6_maskf<true>(f1, ai, aj1, c32, hi);
#pragma unroll
                    for (int i = 0; i < 8; ++i) { __builtin_amdgcn_sched_group_barrier(0x008, 1, 1); __builtin_amdgcn_sched_group_barrier(0x002, 4, 1); __builtin_amdgcn_sched_group_barrier(0x400, 2, 1); }
#pragma unroll
                    for (int r = 0; r < 16; ++r) X1[r] *= f1[r];
                    ssd6_yd(Yd, X1, xv1);
                } else {
#pragma unroll
                    for (int r = 0; r < 16; ++r) X[r] *= f0[r];
                    ssd6_yd(Yd, X, xv0);
                }
                StFrag sf0, sf1;
                if (!(PROBE & 2)) { ssd6_state_load(sf0, sb, 0, wid, lane); ssd6_state_load(sf1, sb, 1, wid, lane); }
                const float dec = eacs[63];
                const int pcol = 32 * ph + c32, i16 = lane & 15, gsel = (lane >> 4) & 1;
                f32x4 ea[4]; u32x2 xw[4]; v4i16_t gz[4];
#pragma unroll
                for (int r4 = 0; r4 < 4; ++r4) {
                    ea[r4] = *(const LAS f32x4*)(eacs + 32 * it + 8 * r4 + 4 * hi);
                    xw[r4] = *(const LAS u32x2*)(sb + S5_XT + pcol * S5_XP + (32 * it + 8 * r4 + 4 * hi) * 2);
                    gz[r4] = __builtin_amdgcn_ds_read_tr16_b64_v4i16((LAS v4i16_t*)(sb + S5_ZT + (32 * it + 8 * r4 + 4 * hi + (i16 >> 2)) * S5_XP + (32 * ph + 16 * gsel + 4 * (i16 & 3)) * 2));
                }
                if (!(PROBE & 2)) { ssd6_state_mma(St0, sf0, dec); ssd6_state_mma(St1, sf1, dec); }
#pragma unroll
                for (int r4 = 0; r4 < 4; ++r4) {
                    const float xs4[4] = {bflo(xw[r4].x), bfhi(xw[r4].x), bflo(xw[r4].y), bfhi(xw[r4].y)};
                    float g4[4];
#pragma unroll
                    for (int q = 0; q < 4; ++q) { const int r = 4 * r4 + q; g4[q] = (Yd[r] + ea[r4][q] * Yo[r] + Dk * xs4[q]) * bf2f((unsigned short)gz[r4][q]); }
                    const unsigned w01 = cvtpk(g4[0], g4[1]), w23 = cvtpk(g4[2], g4[3]);
                    LAS unsigned char* zp = sb + S5_ZT + (32 * it + 8 * r4 + 4 * hi) * S5_XP + pcol * 2;
                    *(LAS unsigned short*)zp = (unsigned short)(w01 & 0xffffu); *(LAS unsigned short*)(zp + S5_XP) = (unsigned short)(w01 >> 16);
                    *(LAS unsigned short*)(zp + 2 * S5_XP) = (unsigned short)(w23 & 0xffffu); *(LAS unsigned short*)(zp + 3 * S5_XP) = (unsigned short)(w23 >> 16);
                }
                if (!(PROBE & 2)) { LAS unsigned char* sw = lds + S6_SL + (ch & 1) * 16384; ssd6_state_store(St0, sw, 0, wid, lane); ssd6_state_store(St1, sw, 1, wid, lane); }
#pragma unroll
                for (int i = 0; i < 8; ++i) { __builtin_amdgcn_sched_group_barrier(0x008, 1, 2); __builtin_amdgcn_sched_group_barrier(0x002, SGB_VALU, 2); }
            }
            if (wid == 0 && ch + 2 < S5_NCH) {
                asm volatile("s_waitcnt vmcnt(0)" : "+v"(drw) :: "memory");
                ssd6_dt(lds, ch + 2, lane, A2, softplusf(drw + dtb));
            }
            S6_BAR();
        }
    } else {
#define S6_PERIOD(CH, S, LCH) do { \
            if ((CH) >= 1 && !(PROBE & 8)) S6_YSTORE((CH) - 1); \
            if ((CH) + 1 < S5_NCH) { if (!(PROBE & 16)) S6_COMMIT((CH) + 1, S); if ((CH) + 3 < S5_NCH && !(PROBE & 32)) S6_LOAD(LCH, S); } \
            S6_BAR(); } while (0)
#define S6_PERIOD_U(CH, S, LCH) do { \
            if (!(PROBE & 8)) S6_YSTORE((CH) - 1); \
            if (!(PROBE & 16)) S6_COMMIT((CH) + 1, S); if (!(PROBE & 32)) S6_LOAD(LCH, S); \
            S6_BAR(); } while (0)
        S6_PERIOD(0, 1, 3);
#pragma unroll 1
        for (int ch = 1; ch < S5_NCH - 1; ch += 2) {
            const int l3 = ch + 3 < S5_NCH ? ch + 3 : S5_NCH - 1, l4 = ch + 4 < S5_NCH ? ch + 4 : S5_NCH - 1;
            S6_PERIOD_U(ch, 0, l3);
            S6_PERIOD_U(ch + 1, 1, l4);
        }
        S6_PERIOD(S5_NCH - 1, 0, S5_NCH - 1);
        S6_YSTORE(S5_NCH - 1);
#undef S6_PERIOD
#undef S6_PERIOD_U
    }
    __syncthreads();
#undef S6_LOAD
#undef S6_LOAD0
#undef S6_COMMIT
#undef S6_YSTORE
#undef S6_BAR
}

struct ConfArgs { const bf16* P; bf16* ZY; const float* dw_w; const float* dw_b; const float* ln_w; const float* ln_b; };
__device__ __forceinline__ void conf_naive_unit(const ConfArgs& a, int unit, float* sm, int wv) {
    constexpr int TT = 16;
    float* glu = sm;
    float* outb = sm + (TT + 30) * 512;
    const int b = unit >> 7, t0 = (unit & 127) * TT, c = opaque_tid(wv), lane = c & 63, w = c >> 6;
    for (int tt = 0; tt < TT + 30; ++tt) {
        const int t = t0 - 30 + tt;
        float v = 0.f;
        if (t >= 0) { const size_t base = ((size_t)b * SEQ + t) * PW; v = bf2f(a.P[base + P_CA + c]); }
        glu[tt * 512 + c] = v;
    }
    float wk[31];
#pragma unroll
    for (int k = 0; k < 31; ++k) wk[k] = a.dw_w[k * 512 + c];
    const float bias = a.dw_b[c];
    for (int tt = 0; tt < TT; ++tt) {
        float v = bias;
#pragma unroll
        for (int k = 0; k < 31; ++k) v += wk[k] * glu[(tt + k) * 512 + c];
        outb[tt * 512 + c] = v;
    }
    __syncthreads();
    for (int tt = w * 2; tt < w * 2 + 2; ++tt) {
        float v[8], s = 0.f;
#pragma unroll
        for (int j = 0; j < 8; ++j) { v[j] = outb[tt * 512 + j * 64 + lane]; s += v[j]; }
        const float mean = wave_sum(s) * (1.f / 512.f);
        float s2 = 0.f;
#pragma unroll
        for (int j = 0; j < 8; ++j) { v[j] -= mean; s2 += v[j] * v[j]; }
        const float rstd = rsqrtf(wave_sum(s2) * (1.f / 512.f) + EPS);
        const size_t zrow = ((size_t)b * SEQ + t0 + tt) * ZYW + 1536;
#pragma unroll
        for (int j = 0; j < 8; ++j) {
            const int ch = j * 64 + lane;
            const float y = siluf(v[j] * rstd * a.ln_w[ch] + a.ln_b[ch]);
            const float z = bf2f(a.ZY[zrow + ch]);
            a.ZY[zrow + ch] = f2bf(y * siluf(z));
        }
    }
    __syncthreads();
}


constexpr int CF_TT = 64, CF_ROWS = CF_TT + 30, CF_GLU = 0, CF_OUT = CF_ROWS * 1024, CF_END = CF_OUT + CF_TT * 1024;
static_assert(CF_END <= MISC_OFF, "conformer LDS map");
__device__ __forceinline__ void conf_unit(const ConfArgs& a, int unit, LAS unsigned char* lds, bf16* ybase, int ypitch, int wv) {
    const int tid = opaque_tid(wv), lane = tid & 63, wid = __builtin_amdgcn_readfirstlane(tid >> 6);
    const int b = unit >> 5, t0 = (unit & 31) * CF_TT;
    {
        const int c8 = tid & 63, rb = tid >> 6;
        u32x4 va[12];
#pragma unroll
        for (int k = 0; k < 12; ++k) {
            const int row = rb + 8 * k, t = t0 - 30 + row;
            va[k] = (u32x4){0u, 0u, 0u, 0u};
            if (row < CF_ROWS && t >= 0) va[k] = *(const u32x4*)(a.P + ((size_t)b * SEQ + t) * PW + P_CA + c8 * 8);
        }
#pragma unroll
        for (int k = 0; k < 12; ++k) { const int row = rb + 8 * k; if (row < CF_ROWS) *(LAS u32x4*)(lds + CF_GLU + row * 1024 + c8 * 16) = va[k]; }
    }
    __syncthreads();
    {
        const int cp = tid & 255, th = tid >> 8;
        f32x2 w2[31];
#pragma unroll
        for (int k = 0; k < 31; ++k) w2[k] = *(const f32x2*)(a.dw_w + k * 512 + 2 * cp);
        const f32x2 bias2 = *(const f32x2*)(a.dw_b + 2 * cp);
#pragma unroll 1
        for (int bb = 0; bb < 2; ++bb) {
            const int r0 = th * 32 + bb * 16;
            f32x2 acc[16];
#pragma unroll
            for (int o = 0; o < 16; ++o) acc[o] = bias2;
#pragma unroll
            for (int r = 0; r < 46; ++r) {
                const unsigned xw = *(const LAS unsigned*)(lds + CF_GLU + (r0 + r) * 1024 + cp * 4);
                const f32x2 x2 = {bflo(xw), bfhi(xw)};
#pragma unroll
                for (int o = 0; o < 16; ++o) { if (r - o >= 0 && r - o <= 30) acc[o] += w2[r - o] * x2; }
            }
#pragma unroll
            for (int o = 0; o < 16; ++o) *(LAS unsigned*)(lds + CF_OUT + (r0 + o) * 1024 + cp * 4) = cvtpk(acc[o].x, acc[o].y);
        }
    }
    __syncthreads();
    {
        const f32x4 lw0 = *(const f32x4*)(a.ln_w + lane * 8), lw1 = *(const f32x4*)(a.ln_w + lane * 8 + 4), lb0 = *(const f32x4*)(a.ln_b + lane * 8), lb1 = *(const f32x4*)(a.ln_b + lane * 8 + 4);
        const float lw[8] = {lw0[0], lw0[1], lw0[2], lw0[3], lw1[0], lw1[1], lw1[2], lw1[3]}, lb[8] = {lb0[0], lb0[1], lb0[2], lb0[3], lb1[0], lb1[1], lb1[2], lb1[3]};
        u32x4 zv[8];
#pragma unroll
        for (int q = 0; q < 8; ++q) zv[q] = *(const u32x4*)(a.ZY + ((size_t)b * SEQ + t0 + wid * 8 + q) * ZYW + 1536 + lane * 8);
#pragma unroll
        for (int q = 0; q < 8; ++q) {
            const int tt = wid * 8 + q;
            const u32x4 xv = *(const LAS u32x4*)(lds + CF_OUT + tt * 1024 + lane * 16);
            bf16* yp = ybase + ((size_t)b * SEQ + t0 + tt) * ypitch + lane * 8;
            float v[8], s = 0.f, s2 = 0.f;
#pragma unroll
            for (int e = 0; e < 4; ++e) { v[2 * e] = bflo(xv[e]); v[2 * e + 1] = bfhi(xv[e]); }
#pragma unroll
            for (int e = 0; e < 8; ++e) { s += v[e]; s2 += v[e] * v[e]; }
            s = wave_sum(s); s2 = wave_sum(s2);
            const float mean = s * (1.f / 512.f), var = fmaxf(s2 * (1.f / 512.f) - mean * mean, 0.f), rstd = rsqrtf(var + EPS);
            u32x4 ov;
#pragma unroll
            for (int e = 0; e < 4; ++e) {
                const float y0 = siluf((v[2 * e] - mean) * rstd * lw[2 * e] + lb[2 * e]) * bflo(zv[q][e]);
                const float y1 = siluf((v[2 * e + 1] - mean) * rstd * lw[2 * e + 1] + lb[2 * e + 1]) * bfhi(zv[q][e]);
                ov[e] = cvtpk(y0, y1);
            }
            *(u32x4*)yp = ov;
        }
    }
    __syncthreads();
}

typedef unsigned u32x2f __attribute__((ext_vector_type(2)));
__device__ __forceinline__ void final_norm_rows(const bf16* __restrict__ XB, float* __restrict__ out, const float* __restrict__ w, const float* __restrict__ SSQ, int gw, int NGW, int lane) {
    f32x4 wv[4];
#pragma unroll
    for (int j = 0; j < 4; ++j) wv[j] = *(const f32x4*)(w + 4 * lane + 256 * j);
#pragma unroll 1
    for (int r0 = gw; r0 < M; r0 += 16 * NGW) {
        u32x2f xv[16][4]; float sq[16];
#pragma unroll
        for (int r = 0; r < 16; ++r) {
            const int row = r0 + r * NGW;
            sq[r] = (row < M && lane < 16) ? SSQ[row * 16 + lane] : 0.f;
#pragma unroll
            for (int j = 0; j < 4; ++j) { xv[r][j] = (u32x2f){0u, 0u}; if (row < M) xv[r][j] = *(const u32x2f*)(XB + (size_t)row * DM + 4 * lane + 256 * j); }
        }
        asm volatile("" ::: "memory");
#pragma unroll
        for (int r = 0; r < 16; ++r) {
            const int row = r0 + r * NGW;
            const float rstd = rsqrtf(wave_sum(sq[r]) * (1.f / DM) + EPS);
            if (row < M) {
#pragma unroll
                for (int j = 0; j < 4; ++j) {
                    const f32x4 o = {bflo(xv[r][j].x) * rstd * wv[j][0], bfhi(xv[r][j].x) * rstd * wv[j][1], bflo(xv[r][j].y) * rstd * wv[j][2], bfhi(xv[r][j].y) * rstd * wv[j][3]};
                    *(f32x4*)(out + (size_t)row * DM + 4 * lane + 256 * j) = o;
                }
            }
        }
    }
}

#define GAS __attribute__((address_space(1)))
typedef GAS unsigned gu32;
#define RLX_AGENT __ATOMIC_RELAXED, __HIP_MEMORY_SCOPE_AGENT
#define XB_TMO      128
#define XB_XCNT(j)  (256  + 64 * (j))
#define XB_XSUB(j)  (1280 + 64 * (j))
#define XB_XGEN(j)  (2304 + 64 * (j))
#define XB_TOP      3328
#define XB_TOPGEN   3392
#define XCD_BAR_WORDS 3456
#define XB_SPIN_CAP (1u << 18)

__device__ __forceinline__ unsigned xb_ld(unsigned* p)              { return __hip_atomic_load(p, __ATOMIC_RELAXED, __HIP_MEMORY_SCOPE_AGENT); }
__device__ __forceinline__ unsigned xb_add(unsigned* p, unsigned v) { return __hip_atomic_fetch_add(p, v, __ATOMIC_RELAXED, __HIP_MEMORY_SCOPE_AGENT); }
__device__ __forceinline__ unsigned xb_xcc_id() { return (unsigned)__builtin_amdgcn_s_getreg((3 << 11) | 20) & 0xFu; }
#define XB_SPIN(cond, bar) do { unsigned _sp = 0; while (cond) { __builtin_amdgcn_s_sleep(1); \
    if ((++_sp & 255u) == 0u) { if (xb_ld(&(bar)[XB_TMO])) break; if (_sp > XB_SPIN_CAP) { atomicAdd(&(bar)[XB_TMO], 1u); break; } } } } while (0)

struct XcdBarrier {
    unsigned* bar; unsigned x;
    volatile LAS unsigned* st;
};

__device__ __forceinline__ XcdBarrier xcd_barrier_post(unsigned* bar, volatile LAS unsigned* st, bool leader) {
    XcdBarrier b; b.bar = bar; b.x = xb_xcc_id(); b.st = st;
    if (leader) (void)xb_add(&bar[XB_XCNT(b.x)], 1u);
    return b;
}
__device__ __forceinline__ void xcd_barrier_complete(unsigned* bar, unsigned x, unsigned& nloc, unsigned& nx) {
    const unsigned G = gridDim.x * gridDim.y * gridDim.z;
    unsigned sum, cnt, mine, sp = 0u;
    for (;;) {
        sum = 0u; cnt = 0u; mine = 0u;
#pragma unroll
        for (unsigned j = 0; j < 16; ++j) { const unsigned c = xb_ld(&bar[XB_XCNT(j)]); sum += c; cnt += (c > 0u) ? 1u : 0u; mine = (j == x) ? c : mine; }
        if (sum == G) break;
        __builtin_amdgcn_s_sleep(1);
        if ((++sp & 255u) == 0u) { if (xb_ld(&bar[XB_TMO])) break; if (sp > XB_SPIN_CAP) { atomicAdd(&bar[XB_TMO], 1u); break; } }
    }
    nloc = mine > 0u ? mine : 1u; nx = cnt > 0u ? cnt : 1u;
}

__device__ __forceinline__ void xcd_barrier(const XcdBarrier& b, bool leader) {
    asm volatile("s_waitcnt vmcnt(0)" ::: "memory");
    __syncthreads();
    if (leader) {
        unsigned* bar = b.bar;
        __builtin_amdgcn_s_waitcnt(0);
        unsigned nloc = b.st[0], nx = b.st[1];
        if (nloc == 0u) { xcd_barrier_complete(bar, b.x, nloc, nx); b.st[0] = nloc; b.st[1] = nx; }
        const unsigned old = xb_add(&bar[XB_XSUB(b.x)], 1u);
        const unsigned gen = old / nloc;
        if (old + 1u == (gen + 1u) * nloc) {
            __builtin_amdgcn_fence(__ATOMIC_RELEASE, "agent");
            asm volatile("s_waitcnt vmcnt(0)" ::: "memory");
            const unsigned og = xb_add(&bar[XB_TOP], 1u);
            const unsigned tg = og / nx;
            if (og + 1u == (tg + 1u) * nx) xb_add(&bar[XB_TOPGEN], 1u);
            else XB_SPIN(xb_ld(&bar[XB_TOPGEN]) == tg, bar);
            __builtin_amdgcn_fence(__ATOMIC_ACQUIRE, "agent");
            xb_add(&bar[XB_XGEN(b.x)], 1u);
            asm volatile("s_waitcnt vmcnt(0)" ::: "memory");
        } else {
            XB_SPIN(xb_ld(&bar[XB_XGEN(b.x)]) == gen, bar);
            __builtin_amdgcn_fence(__ATOMIC_ACQUIRE, "agent");
            asm volatile("s_waitcnt vmcnt(0)" ::: "memory");
        }
    }
    __syncthreads();
}

__global__ __launch_bounds__(NTHR, 2) void mega_fwd(Params p) {
    extern __shared__ __attribute__((aligned(16))) unsigned char lds[];
    float* sm = (float*)lds;
    volatile LAS unsigned* MISC = (volatile LAS unsigned*)((LAS unsigned char*)lds + MISC_OFF);
    const int wv = __builtin_amdgcn_readfirstlane((int)(threadIdx.x >> 6));
#define LEADER() (wv == 0 && lane_id() == 0)
    if (wv == 0 && lane_id() < 16) MISC[lane_id()] = 0u;
    __syncthreads();
    { const XcdBarrier b0 = xcd_barrier_post((unsigned*)(p.ws + WS_CTL) + CW_BAR, MISC + 8, LEADER()); if (LEADER()) MISC[10] = b0.x; }
    __syncthreads();
#define GRID_SYNC() do { XcdBarrier b_; b_.bar = (unsigned*)(p.ws + WS_CTL) + CW_BAR; b_.st = MISC + 8; b_.x = MISC[10]; xcd_barrier(b_, LEADER()); } while (0)
    const int bid = blockIdx.x, G = gridDim.x, NGW = G * NWAVE;
#define ROWLOOP(body) do { const int tid_ = opaque_tid(wv), lane = tid_ & 63, gw_ = bid * NWAVE + __builtin_amdgcn_readfirstlane(tid_ >> 6); for (int row = gw_; row < M; row += NGW) { body; } } while (0)
    const float* x = p.in[0];
    unsigned char* ws = p.ws;
    bf16* Win_t = (bf16*)(ws + WS_WIN); bf16* Wout_t = (bf16*)(ws + WS_WOUT);
    float* SSQ = (float*)(ws + WS_SSQ); float* SSQH = (float*)(ws + WS_SSQH); float* DT = (float*)(ws + WS_DT);
    bf16* XB = (bf16*)(ws + WS_XB); bf16* ZY = (bf16*)(ws + WS_ZY); bf16* P = (bf16*)(ws + WS_P);
    float* out = p.out;

    wconv_items(p, ws, bid, G, sm, wv);
    { const int tid_ = opaque_tid(wv); normprep_rows(x, XB, (float*)(ws + WS_XS), bid * NWAVE + __builtin_amdgcn_readfirstlane(tid_ >> 6), NGW, tid_ & 63); }
    GRID_SYNC();

    for (int l = 0; l < DEPTH; ++l) {
        {
            pg8::Gemm g{XB, Win_t + (size_t)l * NINP * DM, M, NINP, DM}; pg8::StaticOrder S; S.init(M, NINP, G, bid);
            int pm_a = -1, pm_b = -1;
            if (l != 0) {
                pg8::Unit ua, ub; int nu = 0; while (S.next(nu, ub)) ++nu;
                if (nu > 0) { S.next(0, ua); S.next(nu - 1, ub); pm_a = ua.pm; pm_b = ub.pm; }
                const int tid_ = opaque_tid(wv), pmx = tid_ < 256 ? pm_a : pm_b;
                if (pmx >= 0) {
                    const f32x4* sp = (const f32x4*)(SSQ + ((size_t)pmx * 256 + (tid_ & 255)) * 16);
                    const f32x4 s0 = sp[0], s1 = sp[1], s2 = sp[2], s3 = sp[3];
                    const float sm_ = ((s0[0] + s0[1]) + (s0[2] + s0[3])) + ((s1[0] + s1[1]) + (s1[2] + s1[3])) + ((s2[0] + s2[1]) + (s2[2] + s2[3])) + ((s3[0] + s3[1]) + (s3[2] + s3[3]));
                    ((LAS float*)((LAS unsigned char*)lds + 131072))[tid_] = rsqrtf(sm_ * (1.f / DM) + EPS);
                }
                __syncthreads();
            }
            EpiIn E{SSQ, ZY, P, DT, l == 0 ? 1 : 0, (const PG8_LAS float*)((PG8_LAS unsigned char*)lds + 131072), pm_a, pm_b};
#if STAGGER_IN > 0
            if ((bid >> 3) & 1) { const unsigned long long t0_ = __builtin_amdgcn_s_memrealtime(); while (__builtin_amdgcn_s_memrealtime() - t0_ < STAGGER_IN) __builtin_amdgcn_s_sleep(8); }
#endif
#if REP_PHASE == 4
            pg8::gemm_phase<EpiIn, pg8::StaticOrder, true, true>((PG8_LAS unsigned char*)lds, g, S, E, wv);
#endif
            pg8::gemm_phase<EpiIn, pg8::StaticOrder, true, true>((PG8_LAS unsigned char*)lds, g, S, E, wv);
        }
        GRID_SYNC();
        {
            SsdArgs sa{P, ZY, DT, SSQH, p.in[3] + l * 4 * 1536, p.in[4] + l * 1536, p.in[5] + l * 16, p.in[6] + l * 16, p.in[7] + l * 16};
            bf16* BC = (bf16*)(ws + WS_BC);
            for (int u = bid; u < BATCH * 32; u += G) bc_unit(sa, u, BC, wv);
            GRID_SYNC();
            AttnArgs aa{P, ZY, p.in[9] + l * 8};
            ConfArgs ca{P, ZY, p.in[10] + l * 31 * 512, p.in[11] + l * 512, p.in[12] + l * 512, p.in[13] + l * 512};
            const bool ssd_first = (bid & 7) < 4;
#pragma nounroll
            for (int slot = 0; slot < 2; ++slot) {
                if ((slot == 0) == ssd_first) {
#if REP_PHASE == 1
                    for (int u = bid; u < BATCH * 16; u += G) { const int pair = (u & 7) + 8 * (u >> 6), hh = (u >> 3) & 7; ssd_unit6<SSD_PROBE>(sa, (pair >> 1) * 16 + (pair & 1) * 8 + hh, (LAS unsigned char*)lds, (bf16*)out, 1024, nullptr, BC, wv); }
#endif
                    for (int u = bid; u < BATCH * 16; u += G) {
                        const int pair = (u & 7) + 8 * (u >> 6), hh = (u >> 3) & 7;
                        ssd_unit6<0>(sa, (pair >> 1) * 16 + (pair & 1) * 8 + hh, (LAS unsigned char*)lds, ZY, ZYW, SSQH, BC, wv);
                    }
                } else {
#if REP_PHASE == 2
                    for (int u = bid; u < BATCH * 2 * 16; u += G) attn_unit(aa, u, (LAS unsigned char*)lds, (bf16*)(ws + 476 * MiB), 512, wv);
#endif
                    for (int u = bid; u < BATCH * 2 * 16; u += G) attn_unit(aa, u, (LAS unsigned char*)lds, ZY + 1024, ZYW, wv);
#if REP_PHASE == 3
                    for (int u = bid; u < BATCH * 32; u += G) conf_unit(ca, u, (LAS unsigned char*)lds, (bf16*)(ws + 476 * MiB), 512, wv);
#endif
                    for (int u = bid; u < BATCH * 32; u += G) conf_unit(ca, u, (LAS unsigned char*)lds, ZY + 1536, ZYW, wv);
                }
            }
        }
        GRID_SYNC();
        {
            pg8::Gemm g{ZY, Wout_t + (size_t)l * DM * 2048, M, DM, 2048}; pg8::StaticOrder S; S.init(M, DM, G, bid);
            EpiOut E{l == 0 ? (const float*)(ws + WS_XS) : nullptr, XB, SSQ, SSQH, 0};
#if REP_PHASE == 6
            if (l == 0) { EpiOut E2{(const float*)(ws + WS_XS), XB, SSQ, SSQH, 1}; pg8::gemm_phase<EpiOut, pg8::StaticOrder, true, true>((PG8_LAS unsigned char*)lds, g, S, E2, wv); }
#endif
            pg8::gemm_phase<EpiOut, pg8::StaticOrder, true, true>((PG8_LAS unsigned char*)lds, g, S, E, wv);
        }
        GRID_SYNC();
    }
    { const int tid_ = opaque_tid(wv); final_norm_rows(XB, out, p.in[15], SSQ, bid * NWAVE + __builtin_amdgcn_readfirstlane(tid_ >> 6), NGW, tid_ & 63); }
}

extern "C" void kernel_launch(void* const* d_in, const int* in_sizes, int n_in, void* d_out, int out_size, void* d_ws, size_t ws_size, hipStream_t stream) {
    static int grid_blocks = 0;
    if (grid_blocks == 0) {
        if (n_in != 16 || out_size != M * DM || ws_size < WS_END) { fprintf(stderr, "kernel_launch: unexpected shapes (n_in %d out %d ws %zu)\n", n_in, out_size, ws_size); grid_blocks = -1; return; }
        int dev = 0, cus = 0, per_cu = 0;
        (void)hipGetDevice(&dev);
        (void)hipDeviceGetAttribute(&cus, hipDeviceAttributeMultiprocessorCount, dev);
        (void)hipFuncSetAttribute((const void*)mega_fwd, hipFuncAttributeMaxDynamicSharedMemorySize, LDS_BYTES);
        (void)hipOccupancyMaxActiveBlocksPerMultiprocessor(&per_cu, (const void*)mega_fwd, NTHR, LDS_BYTES);
        if (per_cu < 1) { fprintf(stderr, "kernel_launch: occupancy query says %d blocks per CU\n", per_cu); per_cu = 1; }
        grid_blocks = cus * 1;
        fprintf(stderr, "kernel_launch: %d CUs, occupancy %d/CU, grid %d\n", cus, per_cu, grid_blocks);
    }
    if (grid_blocks < 0) return;
    Params p{};
    for (int i = 0; i < 16; ++i) p.in[i] = (const float*)d_in[i];
    p.out = (float*)d_out; p.ws = (unsigned char*)d_ws;
    if (hipMemsetAsync((char*)d_ws + WS_CTL, 0, CTL_ZERO_BYTES, stream) != hipSuccess) { fprintf(stderr, "kernel_launch: memset of the control words failed\n"); return; }
    hipLaunchKernelGGL(mega_fwd, dim3(grid_blocks), dim3(NTHR), LDS_BYTES, stream, p);
    const hipError_t e = hipPeekAtLastError();
    if (e != hipSuccess) fprintf(stderr, "launch failed: %s (grid %d)\n", hipGetErrorString(e), grid_blocks);
}
```

```cpp
#define STAGGER_IN 0
#define SSD_PROBE 0
#define CONV_STEP1 0
#define REP_PHASE 0
#include <hip/hip_runtime.h>
#include <cstdint>
#include <cstdio>

typedef unsigned short bf16;

constexpr int BATCH = 16, SEQ = 2048, DM = 1024, DEPTH = 2;
constexpr int M = BATCH * SEQ;
constexpr int NIN = 5392, NINP = 5632;
constexpr int ZYW = 2048;
constexpr int PW = 3328;
constexpr int P_XS = 0, P_B = 1024, P_C = 1280, P_Q = 1536, P_K = 2048, P_V = 2176, P_CA = 2304, P_CG = 2816;
constexpr float EPS = 1e-5f;

constexpr size_t MiB = 1u << 20;
constexpr size_t WS_CTL = 0;
constexpr size_t WS_WIN = 1 * MiB;
constexpr size_t WS_WOUT = 23 * MiB;
constexpr size_t WS_SSQ = 438 * MiB;
constexpr size_t WS_XS = 512 * 1024;
constexpr size_t WS_SSQH = 32 * MiB;
constexpr size_t WS_DT = 34 * MiB;
constexpr size_t WS_XB = 36 * MiB;
constexpr size_t WS_ZY = 100 * MiB;
constexpr size_t WS_P = 228 * MiB;
constexpr size_t WS_BC = 440 * MiB;
constexpr size_t WS_RAWB = 472 * MiB;
constexpr size_t WS_END = 476 * MiB;

__device__ __forceinline__ float bf2f(bf16 v) { return __uint_as_float(((unsigned)v) << 16); }
typedef float f32x2_t_ __attribute__((ext_vector_type(2))); typedef __bf16 bf16x2_t_ __attribute__((ext_vector_type(2)));
__device__ __forceinline__ unsigned cvtpk(float lo, float hi) { const f32x2_t_ v = {lo, hi}; return __builtin_bit_cast(unsigned, __builtin_convertvector(v, bf16x2_t_)); }
__device__ __forceinline__ float bflo(unsigned w) { return __uint_as_float(w << 16); }
__device__ __forceinline__ float bfhi(unsigned w) { return __uint_as_float(w & 0xffff0000u); }
__device__ __forceinline__ bf16 f2bf(float f) { unsigned u = __float_as_uint(f); return (bf16)((u + 0x7fffu + ((u >> 16) & 1u)) >> 16); }
__device__ __forceinline__ float sigmf(float v) { return __builtin_amdgcn_rcpf(1.f + __builtin_amdgcn_exp2f(v * -1.4426950408889634f)); }
__device__ __forceinline__ float siluf(float v) { return v * sigmf(v); }
template <int CTRL, int ROWMASK> __device__ __forceinline__ float dpp_add(float v) {
    return v + __builtin_bit_cast(float, __builtin_amdgcn_update_dpp(0, __builtin_bit_cast(int, v), CTRL, ROWMASK, 0xf, false));
}
__device__ __forceinline__ float half_sum_dpp(float v) {
    v = dpp_add<0x111, 0xf>(v); v = dpp_add<0x112, 0xf>(v); v = dpp_add<0x114, 0xf>(v); v = dpp_add<0x118, 0xf>(v);
    return dpp_add<0x142, 0xa>(v);
}
__device__ __forceinline__ float wave_sum(float v) {
    v = half_sum_dpp(v);
    v = dpp_add<0x143, 0xc>(v);
    return __builtin_bit_cast(float, __builtin_amdgcn_readlane(__builtin_bit_cast(int, v), 63));
}
__device__ __forceinline__ int lane_id() { int l; asm volatile("v_mbcnt_lo_u32_b32 %0, -1, 0\n\tv_mbcnt_hi_u32_b32 %0, -1, %0" : "=v"(l)); return l; }
__device__ __forceinline__ int opaque_tid(int wv) { int t = wv * 64 + lane_id(); asm volatile("" : "+v"(t)); return t; }
__host__ __device__ __forceinline__ int src_col(int np) {
    if (np < 3584) return np;
    if (np < 4352) return np + 16;
    if (np < 5376) { const int q = (np - 4352) >> 8, w = (np - 4352) & 255; return 4368 + (w < 128 ? 128 * q + w : 512 + 128 * q + (w - 128)); }
    return np - 1792;
}

namespace pg8 {
#define PG8_LAS __attribute__((address_space(3)))
typedef unsigned short bf16_t;
typedef short bf16x8 __attribute__((ext_vector_type(8)));
typedef float f32x4 __attribute__((ext_vector_type(4)));
typedef unsigned u32x4 __attribute__((ext_vector_type(4)));
constexpr int BM = 256, BK = 64, HALF = 128, HTB = HALF * BK * 2  , STAGE_BYTES = 8 * HTB, NXCD = 8, WGM = 4;

__host__ __device__ __forceinline__ int lds_byte(int r, int c) { const int st = (r >> 4) * 2 + (c >> 5), rr = r & 15, cc = c & 31, ob = rr * 64 + cc * 2; return st * 1024 + (ob ^ (((ob >> 9) & 1) << 5)); }
__host__ __device__ __forceinline__ void stage_rc(int b, int& R, int& C) { const int st = b / 1024, sb = b % 1024, swz = sb ^ (((sb >> 9) & 1) << 5); R = (st >> 1) * 16 + swz / 64; C = (st & 1) * 32 + (swz % 64) / 2; }
__host__ __device__ __forceinline__ int perm32(int rho) { const int n = rho >> 4, i = rho & 15; return 8 * (i >> 2) + 4 * n + (i & 3); }

struct Unit { int pm, pn; };
struct Gemm { const bf16_t* A; const bf16_t* Bt; int M, N, K; };

struct StaticOrder {
    int nM, nN, nwg, G, c;
    __host__ __device__ void init(int M, int N, int G_, int c_) { nM = M / BM; nN = N / BM; nwg = nM * nN; G = G_; c = c_; }
    __host__ __device__ __forceinline__ bool next(int i, Unit& u) const {
        const long L = (long)i * G + c; if (L >= nwg) return false;
        int wgid = (int)L; { const int q = nwg / NXCD, r = nwg % NXCD, xcd = wgid % NXCD, off = wgid / NXCD; wgid = (xcd < r ? xcd * (q + 1) : r * (q + 1) + (xcd - r) * q) + off; }
        const int nig = WGM * nN, gid = wgid / nig, fm = gid * WGM, gsz = (nM - fm) < WGM ? (nM - fm) : WGM;
        u.pm = fm + ((wgid % nig) % gsz); u.pn = (wgid % nig) / gsz; return true;
    }
    __device__ __forceinline__ void a_ready(const Unit&) const {}
    __device__ __forceinline__ void done(const Unit&) const {}
};

__device__ __forceinline__ unsigned cvt_pk_bf16(float lo, float hi) { unsigned r; asm volatile("v_cvt_pk_bf16_f32 %0, %1, %2" : "=v"(r) : "v"(lo), "v"(hi)); return r; }
template <class Epi, class Sched, bool ALIGN_EPI = false, bool SP2 = false>
__device__ __forceinline__ void gemm_phase(PG8_LAS unsigned char* lds, const Gemm g, const Sched& S, const Epi& E, int wv) {
    const int tid = opaque_tid(wv), wid = __builtin_amdgcn_readfirstlane(tid >> 6), lane = tid & 63, wr = wid >> 2, wc = wid & 3, fr = lane & 15, fq = lane >> 4;
    const int K = g.K, nt = K / BK;
    unsigned voffA[2], voffB[2];
#pragma unroll
    for (int i = 0; i < 2; ++i) { int R, C; stage_rc(tid * 16 + i * 8192, R, C); const int Rb = Epi::PERM ? ((R & ~31) + perm32(R & 31)) : R;
        voffA[i] = (unsigned)(R * K + C) * 2u; voffB[i] = (unsigned)(Rb * K + C) * 2u; }
    const size_t kstep = (size_t)(BK * 2);
    const size_t hstep = (size_t)HALF * K * 2;
    const size_t tstep = 2 * hstep;
    const unsigned ldsw = (unsigned)wid * 1024u;
    const int aoff = lds_byte(wr * 64 + fr, fq * 8), boff = lds_byte(wc * 32 + fr, fq * 8);
#define PG8_SA(b, h) (((b) * 2 + (h)) * HTB)
#define PG8_SB(b, h) ((4 + (b) * 2 + (h)) * HTB)
#define PG8_STAGE(bufoff, gbase, voff) do { _Pragma("unroll") for (int _i = 0; _i < 2; ++_i) \
        __builtin_amdgcn_global_load_lds((const unsigned*)((const char*)(gbase) + (voff)[_i]), (PG8_LAS unsigned*)(lds + (bufoff) + ldsw + _i * 8192), 16, 0, 0); } while (0)
#define PG8_LDA(dst, b, h) do { _Pragma("unroll") for (int m = 0; m < 4; ++m) _Pragma("unroll") for (int k = 0; k < 2; ++k) dst[m][k] = *(const PG8_LAS bf16x8*)(lds + PG8_SA(b, h) + aoff + m * 2048 + k * 1024); } while (0)
#define PG8_LDB(dst, b, h) do { _Pragma("unroll") for (int n = 0; n < 2; ++n) _Pragma("unroll") for (int k = 0; k < 2; ++k) dst[n][k] = *(const PG8_LAS bf16x8*)(lds + PG8_SB(b, h) + boff + n * 2048 + k * 1024); } while (0)
#define PG8_MMA(ai, bj, At, Bt) do { __builtin_amdgcn_s_setprio(1); _Pragma("unroll") for (int m = 0; m < 4; ++m) _Pragma("unroll") for (int n = 0; n < 2; ++n) _Pragma("unroll") for (int k = 0; k < 2; ++k) \
        acc[ai][bj][m][n] = __builtin_amdgcn_mfma_f32_16x16x32_bf16(Bt[n][k], At[m][k], acc[ai][bj][m][n], 0, 0, 0); __builtin_amdgcn_s_setprio(0); } while (0)
#define PG8_WAIT_V(n) asm volatile("s_waitcnt vmcnt(" #n ")" ::: "memory")
#define PG8_WAIT_L(n) asm volatile("s_waitcnt lgkmcnt(" #n ")" ::: "memory")
#define PG8_BAR __builtin_amdgcn_s_barrier()
#define PG8_SCHED __builtin_amdgcn_sched_barrier(0)
    Unit cur, nxt; int ui = 0;
    if (!S.next(0, cur)) return;
    f32x4 acc[2][2][4][2];
#pragma unroll
    for (int a = 0; a < 2; ++a)
#pragma unroll
        for (int b = 0; b < 2; ++b)
#pragma unroll
            for (int m = 0; m < 4; ++m)
#pragma unroll
                for (int n = 0; n < 2; ++n) acc[a][b][m][n] = (f32x4){0.f, 0.f, 0.f, 0.f};
    bf16x8 At[4][2], B0[2][2], B1[2][2];
    const char* cA = (const char*)g.A + (size_t)cur.pm * tstep; const char* cB = (const char*)g.Bt + (size_t)cur.pn * tstep;
    if constexpr (Epi::KSCALE) E.prep(cur, lds, wid, wr, fr, fq);
    S.a_ready(cur);
    if constexpr (SP2) {
        PG8_STAGE(PG8_SB(0, 0), cB, voffB); PG8_STAGE(PG8_SB(0, 1), cB + hstep, voffB); PG8_STAGE(PG8_SA(0, 0), cA, voffA); PG8_STAGE(PG8_SA(0, 1), cA + hstep, voffA);
        if (wr == 1) PG8_BAR;
        PG8_WAIT_V(2); PG8_BAR;
        PG8_STAGE(PG8_SB(1, 0), cB + kstep, voffB); PG8_STAGE(PG8_SA(1, 0), cA + kstep, voffA); PG8_STAGE(PG8_SB(1, 1), cB + hstep + kstep, voffB);
        PG8_WAIT_V(6); PG8_BAR;
    } else {
        PG8_STAGE(PG8_SB(0, 0), cB, voffB); PG8_STAGE(PG8_SA(0, 0), cA, voffA); PG8_STAGE(PG8_SB(0, 1), cB + hstep, voffB); PG8_STAGE(PG8_SA(0, 1), cA + hstep, voffA);
        if (wr == 1) PG8_BAR;
        PG8_WAIT_V(4); PG8_BAR;
        PG8_STAGE(PG8_SB(1, 0), cB + kstep, voffB); PG8_STAGE(PG8_SA(1, 0), cA + kstep, voffA); PG8_STAGE(PG8_SB(1, 1), cB + hstep + kstep, voffB);
        PG8_WAIT_V(6); PG8_BAR;
    }
    for (;;) {
        const bool has_next = S.next(ui + 1, nxt);
        const char* nA = has_next ? (const char*)g.A + (size_t)nxt.pm * tstep : cA; const char* nB = has_next ? (const char*)g.Bt + (size_t)nxt.pn * tstep : cB;
        for (int t = 0; t < nt; t += 2) {
            const bool last = (t == nt - 2);
            const char* a1 = cA + (size_t)(t + 1) * kstep;
            const char* a2 = last ? nA : cA + (size_t)(t + 2) * kstep; const char* b2 = last ? nB : cB + (size_t)(t + 2) * kstep;
            const char* a3 = a2 + kstep; const char* b3 = b2 + kstep;
            if (last && has_next) S.a_ready(nxt);
            if constexpr (SP2) {
            PG8_LDB(B0, 0, 0); PG8_LDB(B1, 0, 1); PG8_SCHED; PG8_LDA(At, 0, 0); PG8_STAGE(PG8_SA(1, 1), a1 + hstep, voffA);
            PG8_WAIT_V(8); PG8_WAIT_L(0); PG8_BAR; PG8_MMA(0, 0, At, B0); PG8_MMA(0, 1, At, B1); PG8_BAR; PG8_SCHED;
            PG8_LDA(At, 0, 1); PG8_STAGE(PG8_SB(0, 0), b2, voffB); PG8_STAGE(PG8_SB(0, 1), b2 + hstep, voffB); PG8_STAGE(PG8_SA(0, 0), a2, voffA);
            PG8_WAIT_V(8); PG8_WAIT_L(0); PG8_BAR; PG8_MMA(1, 0, At, B0); PG8_MMA(1, 1, At, B1); PG8_BAR; PG8_SCHED;
            PG8_LDB(B0, 1, 0); PG8_LDB(B1, 1, 1); PG8_SCHED; PG8_LDA(At, 1, 0); PG8_STAGE(PG8_SA(0, 1), a2 + hstep, voffA);
            PG8_WAIT_V(8); PG8_WAIT_L(0); PG8_BAR; PG8_MMA(0, 0, At, B0); PG8_MMA(0, 1, At, B1); PG8_BAR; PG8_SCHED;
            PG8_LDA(At, 1, 1); PG8_STAGE(PG8_SB(1, 0), b3, voffB); PG8_STAGE(PG8_SB(1, 1), b3 + hstep, voffB); PG8_STAGE(PG8_SA(1, 0), a3, voffA);
            PG8_WAIT_V(8); PG8_WAIT_L(0); PG8_BAR; PG8_MMA(1, 0, At, B0); PG8_MMA(1, 1, At, B1); PG8_BAR; PG8_SCHED;
            } else {
            PG8_LDB(B0, 0, 0); PG8_SCHED; PG8_LDA(At, 0, 0); PG8_STAGE(PG8_SA(1, 1), a1 + hstep, voffA);
            PG8_WAIT_L(8); PG8_BAR; PG8_WAIT_L(0); PG8_MMA(0, 0, At, B0); PG8_BAR; PG8_SCHED;
            PG8_LDB(B1, 0, 1); PG8_STAGE(PG8_SB(0, 0), b2, voffB);
            PG8_BAR; PG8_WAIT_L(0); PG8_MMA(0, 1, At, B1); PG8_BAR;
            PG8_LDA(At, 0, 1); PG8_STAGE(PG8_SA(0, 0), a2, voffA);
            PG8_BAR; PG8_WAIT_L(0); PG8_MMA(1, 0, At, B0); PG8_BAR; PG8_SCHED;
            PG8_STAGE(PG8_SB(0, 1), b2 + hstep, voffB);
            PG8_WAIT_V(6); PG8_BAR; PG8_MMA(1, 1, At, B1); PG8_BAR;
            PG8_LDB(B0, 1, 0); PG8_SCHED; PG8_LDA(At, 1, 0); PG8_STAGE(PG8_SA(0, 1), a2 + hstep, voffA);
            PG8_WAIT_L(8); PG8_BAR; PG8_WAIT_L(0); PG8_MMA(0, 0, At, B0); PG8_BAR; PG8_SCHED;
            PG8_LDB(B1, 1, 1); PG8_STAGE(PG8_SB(1, 0), b3, voffB);
            PG8_BAR; PG8_WAIT_L(0); PG8_MMA(0, 1, At, B1); PG8_BAR;
            PG8_LDA(At, 1, 1); PG8_STAGE(PG8_SA(1, 0), a3, voffA);
            PG8_BAR; PG8_WAIT_L(0); PG8_MMA(1, 0, At, B0); PG8_BAR; PG8_SCHED;
            PG8_STAGE(PG8_SB(1, 1), b3 + hstep, voffB);
            PG8_WAIT_V(6); PG8_BAR; PG8_MMA(1, 1, At, B1); PG8_BAR;
            }
            if constexpr (Epi::KSCALE) { if (t == Epi::KS_T0 || t == Epi::KS_T1) E.kscale(acc, t == Epi::KS_T0 ? 0 : 1, lds, wid, fr); }
        }
        if constexpr (ALIGN_EPI) { if (wr == 0) PG8_BAR; }
        if constexpr (!Epi::AFTER_DRAIN) { E(acc, cur, wr, wc, fr, fq); S.done(cur); }
        if constexpr (Epi::KSCALE) { if (has_next) E.prep(nxt, lds, wid, wr, fr, fq); }
        if (!has_next) break;
#pragma unroll
        for (int a = 0; a < 2; ++a)
#pragma unroll
            for (int b = 0; b < 2; ++b)
#pragma unroll
                for (int m = 0; m < 4; ++m)
#pragma unroll
                    for (int n = 0; n < 2; ++n) acc[a][b][m][n] = (f32x4){0.f, 0.f, 0.f, 0.f};
        cur = nxt; cA = nA; cB = nB; ++ui;
        if constexpr (ALIGN_EPI) { if (wr == 1) PG8_BAR; }
    }
    PG8_WAIT_V(0);
    if constexpr (!ALIGN_EPI) { if (wr == 0) PG8_BAR; }
    PG8_BAR;
    if constexpr (Epi::AFTER_DRAIN) { E.fused(acc, cur, wr, wc, fr, fq, lds, wid, lane); S.done(cur); }
#undef PG8_SA
#undef PG8_SB
#undef PG8_STAGE
#undef PG8_LDA
#undef PG8_LDB
#undef PG8_MMA
#undef PG8_WAIT_V
#undef PG8_WAIT_L
#undef PG8_BAR
#undef PG8_SCHED
}
}

typedef float f32x4 __attribute__((ext_vector_type(4)));
typedef float f32x2 __attribute__((ext_vector_type(2)));
typedef unsigned u32x4 __attribute__((ext_vector_type(4)));
struct EpiIn {
    static constexpr bool PERM = true, AFTER_DRAIN = false, KSCALE = false; static constexpr int KS_T0 = -1, KS_T1 = -1;
    const float* ssq; bf16* ZY; bf16* P; float* DT; int prenorm;
    bf16* BC; bf16* RAWB; const float* cw; const float* cb;
    const PG8_LAS float* rtab;
    template <int CTRL> static __device__ __forceinline__ float dppz(float v) { return __builtin_bit_cast(float, __builtin_amdgcn_update_dpp(0, __builtin_bit_cast(int, v), CTRL, 0xf, 0xf, true)); }
    __device__ __forceinline__ float rstd_of(const pg8::Unit& u, int wr, int fr, int ai, int m, int row) const {
        if (prenorm) return 1.f;
        { const int sl = ((const PG8_LAS int*)(rtab + 1024))[u.pm]; if (sl >= 0) return rtab[sl * 256 + wr * 64 + ai * 128 + m * 16 + fr]; }
        const f32x4* sp = (const f32x4*)(ssq + (size_t)row * 16);
        const f32x4 s0 = sp[0], s1 = sp[1], s2 = sp[2], s3 = sp[3];
        const float s = ((s0[0] + s0[1]) + (s0[2] + s0[3])) + ((s1[0] + s1[1]) + (s1[2] + s1[3])) + ((s2[0] + s2[1]) + (s2[2] + s2[3])) + ((s3[0] + s3[1]) + (s3[2] + s3[3]));
        return rsqrtf(s * (1.f / DM) + EPS);
    }
    __device__ __forceinline__ void conv_bc(const f32x4 (&acc)[2][2][4][2], const pg8::Unit& u, int wr, int wc, int fr, int fq) const {
        const int row0 = u.pm * 256 + wr * 64 + fr, cin = wc * 32 + 8 * fq, col0 = (u.pn - 12) * 256 + cin;
#pragma unroll
        for (int bj = 0; bj < 2; ++bj) {
            f32x4 w[2][5];
#pragma unroll
            for (int n = 0; n < 2; ++n) {
#pragma unroll
                for (int k = 0; k < 4; ++k) w[n][k] = *(const f32x4*)(cw + k * 1536 + 1024 + col0 + bj * 128 + 4 * n);
                w[n][4] = *(const f32x4*)(cb + 1024 + col0 + bj * 128 + 4 * n);
            }
#pragma unroll
            for (int ai = 0; ai < 2; ++ai) {
                const int blk = u.pm * 4 + wr + 2 * ai;
                f32x4 vp[2] = {(f32x4){0.f, 0.f, 0.f, 0.f}, (f32x4){0.f, 0.f, 0.f, 0.f}};
#pragma unroll
                for (int m = 0; m < 4; ++m) {
                    const int row = row0 + ai * 128 + m * 16;
                    const float rsv = rstd_of(u, wr, fr, ai, m, row);
                    u32x4 ow, rw;
#pragma unroll
                    for (int n = 0; n < 2; ++n) {
                        const f32x4 v = acc[ai][bj][m][n] * rsv;
                        f32x4 o;
#pragma unroll
                        for (int j = 0; j < 4; ++j) {
                            float t = w[n][4][j] + w[n][3][j] * v[j];
                            t += w[n][2][j] * (dppz<0x111>(v[j]) + (m > 0 ? dppz<0x10f>(vp[n][j]) : 0.f));
                            t += w[n][1][j] * (dppz<0x112>(v[j]) + (m > 0 ? dppz<0x10e>(vp[n][j]) : 0.f));
                            t += w[n][0][j] * (dppz<0x113>(v[j]) + (m > 0 ? dppz<0x10d>(vp[n][j]) : 0.f));
                            o[j] = siluf(t);
                        }
                        vp[n] = v;
                        ow[2 * n] = cvtpk(o[0], o[1]); ow[2 * n + 1] = cvtpk(o[2], o[3]);
                        rw[2 * n] = cvtpk(v[0], v[1]); rw[2 * n + 1] = cvtpk(v[2], v[3]);
                    }
                    *(u32x4*)(BC + (size_t)row * 512 + col0 + bj * 128) = ow;
                    if (CONV_STEP1) *(u32x4*)(P + (size_t)row * PW + (u.pn - 8) * 256 + bj * 128 + cin) = rw;
                    if (m == 0 && fr < 3) *(u32x4*)(RAWB + ((size_t)blk * 6 + fr) * 512 + col0 + bj * 128) = rw;
                    if (m == 3 && fr >= 13) *(u32x4*)(RAWB + ((size_t)blk * 6 + 3 + (fr - 13)) * 512 + col0 + bj * 128) = rw;
                }
            }
        }
    }
    __device__ __forceinline__ void operator()(const f32x4 (&acc)[2][2][4][2], const pg8::Unit& u, int wr, int wc, int fr, int fq) const {
        const int row0 = u.pm * 256 + wr * 64 + fr, cin = wc * 32 + 8 * fq;
        if (u.pn == 12 || u.pn == 13) { conv_bc(acc, u, wr, wc, fr, fq); return; }
#pragma unroll
        for (int ai = 0; ai < 2; ++ai)
#pragma unroll
            for (int m = 0; m < 4; ++m) {
                const int row = row0 + ai * 128 + m * 16;
                float rstd = 1.f;
                const int sl = prenorm ? -1 : ((const PG8_LAS int*)(rtab + 1024))[u.pm];
                if (!prenorm && sl >= 0) rstd = rtab[sl * 256 + wr * 64 + ai * 128 + m * 16 + fr];
                else if (!prenorm) {
                    const f32x4* sp = (const f32x4*)(ssq + (size_t)row * 16);
                    const f32x4 s0 = sp[0], s1 = sp[1], s2 = sp[2], s3 = sp[3];
                    const float s = ((s0[0] + s0[1]) + (s0[2] + s0[3])) + ((s1[0] + s1[1]) + (s1[2] + s1[3])) + ((s2[0] + s2[1]) + (s2[2] + s2[3])) + ((s3[0] + s3[1]) + (s3[2] + s3[3]));
                    rstd = rsqrtf(s * (1.f / DM) + EPS);
                }
                if (u.pn >= 17 && u.pn < 21) {
                    const f32x4 a0 = acc[ai][0][m][0] * rstd, a1 = acc[ai][0][m][1] * rstd, g0 = acc[ai][1][m][0] * rstd, g1 = acc[ai][1][m][1] * rstd;
                    u32x4 w; w.x = cvtpk(a0[0] * sigmf(g0[0]), a0[1] * sigmf(g0[1])); w.y = cvtpk(a0[2] * sigmf(g0[2]), a0[3] * sigmf(g0[3]));
                    w.z = cvtpk(a1[0] * sigmf(g1[0]), a1[1] * sigmf(g1[1])); w.w = cvtpk(a1[2] * sigmf(g1[2]), a1[3] * sigmf(g1[3]));
                    __builtin_nontemporal_store(w, (u32x4*)(P + (size_t)row * PW + P_CA + (u.pn - 17) * 128 + cin));
                } else if (u.pn < 8) {
                    bf16* rowp = ZY + (size_t)row * ZYW + u.pn * 256 + cin;
#pragma unroll
                    for (int bj = 0; bj < 2; ++bj) {
                        const f32x4 v0 = acc[ai][bj][m][0] * rstd, v1 = acc[ai][bj][m][1] * rstd;
                        u32x4 w; w.x = cvtpk(siluf(v0[0]), siluf(v0[1])); w.y = cvtpk(siluf(v0[2]), siluf(v0[3])); w.z = cvtpk(siluf(v1[0]), siluf(v1[1])); w.w = cvtpk(siluf(v1[2]), siluf(v1[3]));
                        __builtin_nontemporal_store(w, (u32x4*)(rowp + bj * 128));
                    }
                } else if (u.pn < 21) {
                    bf16* rowp = P + (size_t)row * PW + (u.pn - 8) * 256 + cin;
#pragma unroll
                    for (int bj = 0; bj < 2; ++bj) {
                        const f32x4 v0 = acc[ai][bj][m][0] * rstd, v1 = acc[ai][bj][m][1] * rstd;
                        u32x4 w; w.x = cvtpk(v0[0], v0[1]); w.y = cvtpk(v0[2], v0[3]); w.z = cvtpk(v1[0], v1[1]); w.w = cvtpk(v1[2], v1[3]);
                        __builtin_nontemporal_store(w, (u32x4*)(rowp + bj * 128));
                    }
                } else if (cin < 16) {
                    *(f32x4*)(DT + (size_t)row * 16 + cin) = acc[ai][0][m][0] * rstd;
                    *(f32x4*)(DT + (size_t)row * 16 + cin + 4) = acc[ai][0][m][1] * rstd;
                }
            }
    }
};
struct EpiNull {
    static constexpr bool PERM = true, AFTER_DRAIN = false, KSCALE = false; static constexpr int KS_T0 = -1, KS_T1 = -1;
    __device__ __forceinline__ void operator()(const f32x4 (&acc)[2][2][4][2], const pg8::Unit& u, int wr, int wc, int fr, int fq) const {
#pragma unroll
        for (int ai = 0; ai < 2; ++ai)
#pragma unroll
            for (int bj = 0; bj < 2; ++bj)
#pragma unroll
                for (int m = 0; m < 4; ++m)
#pragma unroll
                    for (int n = 0; n < 2; ++n) asm volatile("" :: "v"(acc[ai][bj][m][n]));
    }
};
constexpr int KS_LDS = 131072;
__device__ __forceinline__ float sum_fq(float v) {
    const unsigned u = __builtin_bit_cast(unsigned, v);
    auto a = __builtin_amdgcn_permlane16_swap(u, u, false, false);
    const float s1 = __builtin_bit_cast(float, (unsigned)a[0]) + __builtin_bit_cast(float, (unsigned)a[1]);
    const unsigned u2 = __builtin_bit_cast(unsigned, s1);
    auto b = __builtin_amdgcn_permlane32_swap(u2, u2, false, false);
    return __builtin_bit_cast(float, (unsigned)b[0]) + __builtin_bit_cast(float, (unsigned)b[1]);
}
struct EpiOut {
    static constexpr bool PERM = true, AFTER_DRAIN = false, KSCALE = true; static constexpr int KS_T0 = 6, KS_T1 = 14;
    const float* xs; bf16* XB; float* ssq; const float* ssqh; int noepi;
    __device__ __forceinline__ void prep(const pg8::Unit& u, PG8_LAS unsigned char* lds, int wid, int wr, int fr, int fq) const {
        if (fq == 0) {
            PG8_LAS float* dst = (PG8_LAS float*)(lds + KS_LDS) + (wid * 16 + fr) * 16;
#pragma unroll
            for (int ai = 0; ai < 2; ++ai)
#pragma unroll
                for (int m = 0; m < 4; ++m) {
                    const f32x4* sp = (const f32x4*)(ssqh + (size_t)(u.pm * 256 + ai * 128 + wr * 64 + m * 16 + fr) * 16);
                    const f32x4 s0 = sp[0], s1 = sp[1], s2 = sp[2], s3 = sp[3];
                    const float r0 = rsqrtf((((s0[0] + s0[1]) + (s0[2] + s0[3])) + ((s1[0] + s1[1]) + (s1[2] + s1[3]))) * (1.f / 512.f) + EPS);
                    const float r1 = rsqrtf((((s2[0] + s2[1]) + (s2[2] + s2[3])) + ((s3[0] + s3[1]) + (s3[2] + s3[3]))) * (1.f / 512.f) + EPS);
                    dst[ai * 4 + m] = r0 / r1; dst[8 + ai * 4 + m] = r1;
                }
        }
    }
    __device__ __forceinline__ void kscale(f32x4 (&acc)[2][2][4][2], int which, PG8_LAS unsigned char* lds, int wid, int fr) const {
        const PG8_LAS f32x4* src = (const PG8_LAS f32x4*)((PG8_LAS float*)(lds + KS_LDS) + (wid * 16 + fr) * 16 + which * 8);
        const f32x4 fa = src[0], fb = src[1];
#pragma unroll
        for (int m = 0; m < 4; ++m)
#pragma unroll
            for (int bj = 0; bj < 2; ++bj)
#pragma unroll
                for (int n = 0; n < 2; ++n) { acc[0][bj][m][n] *= fa[m]; acc[1][bj][m][n] *= fb[m]; }
    }
    __device__ __forceinline__ void piece(const f32x4 a0, const f32x4 a1, const f32x4 r0, const f32x4 r1, float& s, char* dst) const {
        const f32x4 v0 = a0 + r0, v1 = a1 + r1;
        s += ((v0[0] * v0[0] + v0[1] * v0[1]) + (v0[2] * v0[2] + v0[3] * v0[3])) + ((v1[0] * v1[0] + v1[1] * v1[1]) + (v1[2] * v1[2] + v1[3] * v1[3]));
        u32x4 w; w.x = cvtpk(v0[0], v0[1]); w.y = cvtpk(v0[2], v0[3]); w.z = cvtpk(v1[0], v1[1]); w.w = cvtpk(v1[2], v1[3]);
        *(u32x4*)dst = w;
    }
    __device__ __forceinline__ void operator()(const f32x4 (&acc)[2][2][4][2], const pg8::Unit& u, int wr, int wc, int fr, int fq) const {
        if (noepi) {
#pragma unroll
            for (int ai = 0; ai < 2; ++ai)
#pragma unroll
                for (int bj = 0; bj < 2; ++bj)
#pragma unroll
                    for (int m = 0; m < 4; ++m)
#pragma unroll
                        for (int n = 0; n < 2; ++n) asm volatile("" :: "v"(acc[ai][bj][m][n]));
            return;
        }
        const unsigned off0 = (unsigned)(u.pm * 256 + wr * 64 + fr) * DM + (unsigned)(u.pn * 256 + wc * 32 + 8 * fq);
        char* xb = (char*)XB; char* sq = (char*)ssq;
        const unsigned soff = ((unsigned)(u.pm * 256 + wr * 64 + fr) * 16u + (unsigned)(u.pn * 4 + wc)) * 4u;
        {
            float sc[2][4];
#pragma unroll
            for (int ai = 0; ai < 2; ++ai)
#pragma unroll
                for (int m = 0; m < 4; ++m) sc[ai][m] = 1.f;
            if (xs) {
#pragma unroll
                for (int ai = 0; ai < 2; ++ai)
#pragma unroll
                    for (int m = 0; m < 4; ++m) sc[ai][m] = xs[u.pm * 256 + wr * 64 + fr + 128 * ai + 16 * m];
            }
            u32x4 ra[4][2], rb[4][2];
#define EO_LD(R, AI, M0, M1) do { _Pragma("unroll") for (int m = (M0); m < (M1); ++m) _Pragma("unroll") for (int bj = 0; bj < 2; ++bj) R[m][bj] = *(const u32x4*)(xb + (off0 + (unsigned)((128 * (AI) + 16 * m) * DM + 128 * bj)) * 2u); } while (0)
#define EO_DO(R, AI, M0, M1) do { _Pragma("unroll") for (int m = (M0); m < (M1); ++m) { float s = 0.f; \
                _Pragma("unroll") for (int bj = 0; bj < 2; ++bj) { const u32x4 xo = R[m][bj]; \
                    piece(acc[AI][bj][m][0], acc[AI][bj][m][1], (f32x4){bflo(xo.x), bfhi(xo.x), bflo(xo.y), bfhi(xo.y)} * sc[AI][m], (f32x4){bflo(xo.z), bfhi(xo.z), bflo(xo.w), bfhi(xo.w)} * sc[AI][m], s, \
                          xb + (off0 + (unsigned)((128 * (AI) + 16 * m) * DM + 128 * bj)) * 2u); } \
                s = sum_fq(s); if (fq == 0) *(float*)(sq + (soff + (unsigned)((128 * (AI) + 16 * m) * 64))) = s; } } while (0)
            EO_LD(ra, 0, 0, 4); EO_LD(rb, 1, 0, 2);
            EO_DO(ra, 0, 0, 2); EO_LD(rb, 1, 2, 4);
            EO_DO(ra, 0, 2, 4); EO_DO(rb, 1, 0, 4);
#undef EO_LD
#undef EO_DO
        }
    }
};

constexpr int NTHR = 512, NWAVE = 8;
constexpr int LDS_BYTES = 163840;
constexpr int MISC_OFF = LDS_BYTES - 64;
constexpr int CW_BAR = 1024;
constexpr int CW_GBAR = 4608, CW_GSTRIDE = 3584;
constexpr size_t CTL_ZERO_BYTES = 163840;

struct Params { const float* in[16]; float* out; unsigned char* ws; };

typedef float f32x4n __attribute__((ext_vector_type(4))); typedef unsigned u32x2n __attribute__((ext_vector_type(2)));
constexpr int N_WIN_ITEMS = DEPTH * 88 * 16, N_W_ITEMS = N_WIN_ITEMS + DEPTH * 16 * 32;
__device__ __forceinline__ void wconv_load(const Params& p, int item, int tid, f32x4n (&r)[2], float (&sc)[2]) {
#pragma unroll
    for (int i = 0; i < 2; ++i) {
        const int e = tid + NTHR * i, kk = e >> 4, n4 = (e & 15) * 4;
        const float* src; const float* scp;
        if (item < N_WIN_ITEMS) {
            const int l = item / (88 * 16), rr = item % (88 * 16), np = (rr % 88) * 64 + n4, k = (rr / 88) * 64 + kk;
            src = p.in[2] + (size_t)l * DM * NIN + (size_t)k * NIN + (np < NIN ? src_col(np) : 0); scp = p.in[1] + l * DM + k;
        } else {
            const int it2 = item - N_WIN_ITEMS, l = it2 / (16 * 32), rr = it2 % (16 * 32), n = (rr % 16) * 64 + n4, k = (rr / 16) * 64 + kk;
            src = p.in[14] + (size_t)l * 2048 * DM + (size_t)k * DM + n; scp = p.in[8] + l * 1024 + (k & 1023);
        }
        r[i] = *(const f32x4n*)src; sc[i] = *scp;
    }
}
__device__ __forceinline__ f32x4n wconv_fix(int item, int tid, int i, f32x4n v, float sc) {
    const int e = tid + NTHR * i, kk = e >> 4, n4 = (e & 15) * 4;
    if (item < N_WIN_ITEMS) { const int rr = item % (88 * 16), np = (rr % 88) * 64 + n4; return np < NIN ? v * sc : (f32x4n){0.f, 0.f, 0.f, 0.f}; }
    const int rr = (item - N_WIN_ITEMS) % (16 * 32), k = (rr / 16) * 64 + kk;
    return k < 1024 ? v * sc : v;
}
__device__ __forceinline__ void wconv_store(unsigned char* ws, int item, int tid, const float* tile) {
    const int nn = tid >> 3, kc = (tid & 7) * 8;
    u32x4 o;
    o.x = cvtpk(tile[(kc + 0) * 65 + nn], tile[(kc + 1) * 65 + nn]); o.y = cvtpk(tile[(kc + 2) * 65 + nn], tile[(kc + 3) * 65 + nn]);
    o.z = cvtpk(tile[(kc + 4) * 65 + nn], tile[(kc + 5) * 65 + nn]); o.w = cvtpk(tile[(kc + 6) * 65 + nn], tile[(kc + 7) * 65 + nn]);
    bf16* dst;
    if (item < N_WIN_ITEMS) { const int l = item / (88 * 16), rr = item % (88 * 16); dst = (bf16*)(ws + WS_WIN) + (size_t)l * NINP * DM + (size_t)((rr % 88) * 64 + nn) * DM + (rr / 88) * 64 + kc; }
    else { const int it2 = item - N_WIN_ITEMS, l = it2 / (16 * 32), rr = it2 % (16 * 32); dst = (bf16*)(ws + WS_WOUT) + (size_t)l * DM * 2048 + (size_t)((rr % 16) * 64 + nn) * 2048 + (rr / 16) * 64 + kc; }
    *(u32x4*)dst = o;
}
__device__ __forceinline__ void wconv_items(const Params& p, unsigned char* ws, int bid, int G, float* tile  , int wv) {
    const int tid = opaque_tid(wv);
    f32x4n r0[2], r1[2], r2[2], r3[2]; float s0[2], s1[2], s2[2], s3[2];
#define WC_CL(it) ((it) < N_W_ITEMS ? (it) : N_W_ITEMS - 1)
#define WC_STEP(R, SC, IT) do { \
        _Pragma("unroll") for (int i = 0; i < 2; ++i) { const int e = tid + NTHR * i, kk = e >> 4, n4 = (e & 15) * 4; const f32x4n v_ = wconv_fix((IT), tid, i, R[i], SC[i]); tile[kk * 65 + n4] = v_[0]; tile[kk * 65 + n4 + 1] = v_[1]; tile[kk * 65 + n4 + 2] = v_[2]; tile[kk * 65 + n4 + 3] = v_[3]; } \
        __syncthreads(); \
        wconv_load(p, WC_CL((IT) + 4 * G), tid, R, SC); \
        wconv_store(ws, (IT), tid, tile); \
        __syncthreads(); } while (0)
    int item = bid;
    if (item >= N_W_ITEMS) return;
    wconv_load(p, WC_CL(item), tid, r0, s0); wconv_load(p, WC_CL(item + G), tid, r1, s1); wconv_load(p, WC_CL(item + 2 * G), tid, r2, s2); wconv_load(p, WC_CL(item + 3 * G), tid, r3, s3);
#pragma unroll 1
    for (; item < N_W_ITEMS; item += 4 * G) {
        WC_STEP(r0, s0, item);
        if (item + G >= N_W_ITEMS) break;
        WC_STEP(r1, s1, item + G);
        if (item + 2 * G >= N_W_ITEMS) break;
        WC_STEP(r2, s2, item + 2 * G);
        if (item + 3 * G >= N_W_ITEMS) break;
        WC_STEP(r3, s3, item + 3 * G);
    }
#undef WC_STEP
#undef WC_CL
}
__device__ __forceinline__ void normprep_rows(const float* __restrict__ x, bf16* __restrict__ XB, float* __restrict__ XS, int gw, int NGW, int lane) {
    f32x4n va[4][4], vb[4][4];
    const int nb = (M - gw + NGW - 1) / NGW;
#define NP_LOAD(V, B0) do { _Pragma("unroll") for (int r = 0; r < 4; ++r) { const int row = gw + ((B0) + r) * NGW; _Pragma("unroll") for (int j = 0; j < 4; ++j) { V[r][j] = (f32x4n){0.f, 0.f, 0.f, 0.f}; if (row < M) V[r][j] = *(const f32x4n*)(x + (size_t)row * DM + 4 * lane + 256 * j); } } } while (0)
#define NP_STORE(V, B0) do { _Pragma("unroll") for (int r = 0; r < 4; ++r) { const int row = gw + ((B0) + r) * NGW; float s = 0.f; \
        _Pragma("unroll") for (int j = 0; j < 4; ++j) s += (V[r][j][0] * V[r][j][0] + V[r][j][1] * V[r][j][1]) + (V[r][j][2] * V[r][j][2] + V[r][j][3] * V[r][j][3]); \
        const float ms_ = wave_sum(s) * (1.f / DM) + EPS, rstd = rsqrtf(ms_); \
        if (row < M) { if (lane == 0) XS[row] = ms_ * rstd; _Pragma("unroll") for (int j = 0; j < 4; ++j) { u32x2n o; o.x = cvtpk(V[r][j][0] * rstd, V[r][j][1] * rstd); o.y = cvtpk(V[r][j][2] * rstd, V[r][j][3] * rstd); \
            *(u32x2n*)(XB + (size_t)row * DM + 4 * lane + 256 * j) = o; } } } } while (0)
    NP_LOAD(va, 0);
#pragma unroll 1
    for (int b0 = 0; b0 < nb; b0 += 8) {
        NP_LOAD(vb, b0 + 4);
        NP_STORE(va, b0);
        NP_LOAD(va, b0 + 8);
        NP_STORE(vb, b0 + 4);
    }
#undef NP_LOAD
#undef NP_STORE
}

struct SsdArgs { const bf16* P; bf16* ZY; const float* DT; float* SSQH; const float* conv_w; const float* conv_b; const float* dt_bias; const float* a_log; const float* dskip; const bf16* RAWB; };
__device__ __forceinline__ void ssd_naive_unit(const SsdArgs& a, int unit, float* sm, int wv) {
    constexpr int TT = 32;
    float* raw = sm;
    float* act = raw + (TT + 3) * 320;
    float* dts = act + TT * 320;
    float* decs = dts + TT;
    float* gq = decs + TT;
    const int b = unit >> 4, h = unit & 15, g = h >> 3, tid = opaque_tid(wv), lane = tid & 63, w = tid >> 6;
    const int p = w * 8 + (lane >> 3), ng = lane & 7;
    const float A = -__expf(a.a_log[h]), Dk = a.dskip[h], dtb = a.dt_bias[h];
    float S[16];
#pragma unroll
    for (int i = 0; i < 16; ++i) S[i] = 0.f;
    for (int t0 = 0; t0 < SEQ; t0 += TT) {
        for (int e = tid; e < (TT + 3) * 320; e += NTHR) {
            const int tt = e / 320, c = e % 320, t = t0 - 3 + tt;
            const int col = c < 64 ? (P_XS + h * 64 + c) : (c < 192 ? (P_B + g * 128 + (c - 64)) : (P_C + g * 128 + (c - 192)));
            raw[tt * 320 + c] = t >= 0 ? bf2f(a.P[((size_t)b * SEQ + t) * PW + col]) : 0.f;
        }
        if (tid < TT) {
            const float v = a.DT[((size_t)b * SEQ + t0 + tid) * 16 + h] + dtb;
            const float dt = v > 20.f ? v : log1pf(__expf(v));
            dts[tid] = dt; decs[tid] = __expf(dt * A);
        }
        __syncthreads();
        for (int e = tid; e < TT * 320; e += NTHR) {
            const int tt = e / 320, c = e % 320;
            const int col = c < 64 ? (P_XS + h * 64 + c) : (c < 192 ? (P_B + g * 128 + (c - 64)) : (P_C + g * 128 + (c - 192)));
            float v = a.conv_b[col];
#pragma unroll
            for (int k = 0; k < 4; ++k) v += a.conv_w[k * 1536 + col] * raw[(tt + k) * 320 + c];
            act[tt * 320 + c] = siluf(v);
        }
        __syncthreads();
        for (int tt = 0; tt < TT; ++tt) {
            const float* at = act + tt * 320;
            const float xv = at[p], xdt = xv * dts[tt], dec = decs[tt];
            float yp = 0.f;
#pragma unroll
            for (int i = 0; i < 16; ++i) {
                S[i] = dec * S[i] + xdt * at[64 + ng * 16 + i];
                yp += at[192 + ng * 16 + i] * S[i];
            }
            yp += __shfl_xor(yp, 1); yp += __shfl_xor(yp, 2); yp += __shfl_xor(yp, 4);
            if (ng == 0) {
                const float y = yp + Dk * xv;
                const size_t zi = ((size_t)b * SEQ + t0 + tt) * ZYW + h * 64 + p;
                const float z = bf2f(a.ZY[zi]);
                const float gg = y * siluf(z);
                a.ZY[zi] = f2bf(gg);
                gq[tt * 64 + p] = gg * gg;
            }
        }
        __syncthreads();
        if (tid < TT) { float s = 0.f; for (int i = 0; i < 64; ++i) s += gq[tid * 64 + i]; a.SSQH[((size_t)b * SEQ + t0 + tid) * 16 + h] = s; }
        __syncthreads();
    }
}
__device__ __forceinline__ void ssd_norm_row(bf16* ZY, const float* __restrict__ SSQH, const float* __restrict__ nw, int row, int lane, bf16* yo, int yp) {
    float v[16], s0 = 0.f, s1 = 0.f;
#pragma unroll
    for (int j = 0; j < 16; ++j) { v[j] = bf2f(ZY[(size_t)row * ZYW + j * 64 + lane]); if (j < 8) s0 += v[j] * v[j]; else s1 += v[j] * v[j]; }
    s0 = wave_sum(s0); s1 = wave_sum(s1);
    const float r0 = rsqrtf(s0 * (1.f / 512.f) + EPS), r1 = rsqrtf(s1 * (1.f / 512.f) + EPS);
#pragma unroll
    for (int j = 0; j < 16; ++j) { const int c = j * 64 + lane; yo[(size_t)row * yp + c] = f2bf(v[j] * (j < 8 ? r0 : r1) * nw[c]); }
}

struct AttnArgs { const bf16* P; bf16* ZY; const float* sinks; };
__device__ __forceinline__ void attn_naive_unit(const AttnArgs& a, int unit, float* sm, bf16* yref, int wv) {
    float* Ks = sm;
    float* Vs = sm + 256 * 64;
    const int nb = unit & 15, g = (unit >> 4) & 1, b = unit >> 5, tid = opaque_tid(wv);
    const int r = tid >> 7, qi = tid & 127;
    for (int e = tid; e < 256 * 64; e += NTHR) {
        const int kr = e >> 6, d = e & 63, t = (nb - 1) * 128 + kr;
        float kv = 0.f, vv = 0.f;
        if (t >= 0) { const size_t base = ((size_t)b * SEQ + t) * PW; kv = bf2f(a.P[base + P_K + g * 64 + d]); vv = bf2f(a.P[base + P_V + g * 64 + d]); }
        Ks[e] = kv; Vs[e] = vv;
    }
    __syncthreads();
    const int t = nb * 128 + qi;
    const size_t prow = ((size_t)b * SEQ + t) * PW;
    float q[64], o[64];
#pragma unroll
    for (int d = 0; d < 64; ++d) { q[d] = bf2f(a.P[prow + P_Q + g * 256 + r * 64 + d]) * 0.125f; o[d] = 0.f; }
    float mx = -1e30f, l = 0.f;
    const int jlo = (t - 127 < 0) ? 0 : t - 127;
    for (int tj = jlo; tj <= t; ++tj) {
        const int kr = tj - (nb - 1) * 128;
        const float* kp = Ks + kr * 64;
        float s = 0.f;
#pragma unroll
        for (int d = 0; d < 64; ++d) s += q[d] * kp[d];
        const float mn = fmaxf(mx, s), f = __expf(mx - mn), pe = __expf(s - mn);
        l = l * f + pe;
        const float* vp = Vs + kr * 64;
#pragma unroll
        for (int d = 0; d < 64; ++d) o[d] = o[d] * f + pe * vp[d];
        mx = mn;
    }
    const float sk = a.sinks[g * 4 + r];
    const float mn = fmaxf(mx, sk), f = __expf(mx - mn);
    l = l * f + __expf(sk - mn);
    const float inv = f / l;
    const size_t zrow = ((size_t)b * SEQ + t) * ZYW + 1024 + g * 256 + r * 64;
#pragma unroll
    for (int d = 0; d < 64; ++d) { const float z = bf2f(a.ZY[zrow + d]); yref[((size_t)b * SEQ + t) * 512 + g * 256 + r * 64 + d] = f2bf(o[d] * inv * siluf(z)); }
    __syncthreads();
}


typedef short bf16x8 __attribute__((ext_vector_type(8)));
typedef short s16x4 __attribute__((ext_vector_type(4)));
typedef float f32x16 __attribute__((ext_vector_type(16)));
#define LAS __attribute__((address_space(3)))
__device__ __forceinline__ int crow(int r, int hi) { return (r & 3) + 8 * (r >> 2) + 4 * hi; }
constexpr int AT_KP = 144;
constexpr int AT_K = 0, AT_V = 256 * AT_KP, AT_O = 2 * 256 * AT_KP, AT_W = AT_O + 8 * 32 * AT_KP;
typedef short v4i16a_t __attribute__((ext_vector_type(4)));
__device__ __forceinline__ void attn_unit(const AttnArgs& a, int unit, LAS unsigned char* lds, bf16* ybase, int ypitch, int wv) {
    const int tid = opaque_tid(wv), lane = tid & 63, wid = __builtin_amdgcn_readfirstlane(tid >> 6), c32 = lane & 31, hi = lane >> 5;
    const int nb = unit & 15, g = (unit >> 4) & 1, b = unit >> 5;
    u32x4 kv[4], vv[4];
#pragma unroll
    for (int q = 0; q < 4; ++q) {
        const int e = tid + NTHR * q, key = e >> 3, ch = e & 7, t = (nb - 1) * 128 + key;
        kv[q] = (u32x4){0u, 0u, 0u, 0u}; vv[q] = (u32x4){0u, 0u, 0u, 0u};
        if (t >= 0) { const bf16* base = a.P + ((size_t)b * SEQ + t) * PW; kv[q] = *(const u32x4*)(base + P_K + g * 64 + ch * 8); vv[q] = *(const u32x4*)(base + P_V + g * 64 + ch * 8); }
    }
    bf16x8 qf[2][4];
#pragma unroll
    for (int gi2 = 0; gi2 < 2; ++gi2) {
        const int gi = wid + 8 * gi2, head = gi >> 2, qo = (gi & 3) * 32;
        const bf16* qp = a.P + ((size_t)b * SEQ + nb * 128 + qo + c32) * PW + P_Q + g * 256 + head * 64 + hi * 8;
#pragma unroll
        for (int ks = 0; ks < 4; ++ks) qf[gi2][ks] = *(const bf16x8*)(qp + ks * 16);
    }
#pragma unroll
    for (int q = 0; q < 4; ++q) {
        const int e = tid + NTHR * q, key = e >> 3, ch = e & 7;
        *(LAS u32x4*)(lds + AT_K + key * AT_KP + ch * 16) = kv[q];
        *(LAS u32x4*)(lds + AT_V + key * AT_KP + ch * 16) = vv[q];
    }
    __syncthreads();
    LAS float* wsf = (LAS float*)(lds + AT_W) + wid * 32;
    LAS unsigned char* ost = lds + AT_O + wid * 32 * AT_KP;
    const float C2 = 0.125f * 1.4426950408889634f, NEG = -1e30f;
    const int i16 = lane & 15, gsel = (lane >> 4) & 1;
#pragma unroll
    for (int gi2 = 0; gi2 < 2; ++gi2) {
        const int gi = wid + 8 * gi2, head = gi >> 2, qo = (gi & 3) * 32;
        const size_t tok0 = (size_t)b * SEQ + nb * 128 + qo;
        u32x4 zv[4];
#pragma unroll
        for (int k = 0; k < 4; ++k) { const int e = lane + 64 * k; zv[k] = *(const u32x4*)(a.ZY + (tok0 + (e >> 3)) * ZYW + 1024 + g * 256 + head * 64 + (e & 7) * 8); }
        f32x16 S[5];
#pragma unroll
        for (int j = 0; j < 5; ++j) {
            f32x16 acc = {0.f, 0.f, 0.f, 0.f, 0.f, 0.f, 0.f, 0.f, 0.f, 0.f, 0.f, 0.f, 0.f, 0.f, 0.f, 0.f};
#pragma unroll
            for (int ks = 0; ks < 4; ++ks) {
                const bf16x8 kf = *(const LAS bf16x8*)(lds + AT_K + (qo + 32 * j + c32) * AT_KP + ks * 32 + hi * 16);
                acc = __builtin_amdgcn_mfma_f32_32x32x16_bf16(kf, qf[gi2][ks], acc, 0, 0, 0);
            }
            S[j] = acc;
        }
        float mx = NEG;
#pragma unroll
        for (int j = 0; j < 5; ++j) {
            const bool dead = (nb == 0) && (qo + 32 * j < 128);
#pragma unroll
            for (int r = 0; r < 16; ++r) {
                float v = S[j][r] * C2;
                const int kr = crow(r, hi);
                if (j == 0 && !(kr > c32)) v = NEG;
                if (j == 4 && !(kr <= c32)) v = NEG;
                if (dead) v = NEG;
                S[j][r] = v; mx = fmaxf(mx, v);
            }
        }
        mx = fmaxf(mx, __shfl_xor(mx, 32));
        const float sink2 = a.sinks[g * 4 + head] * 1.4426950408889634f;
        mx = fmaxf(mx, sink2);
        float l = 0.f;
#pragma unroll
        for (int j = 0; j < 5; ++j)
#pragma unroll
            for (int r = 0; r < 16; ++r) { const float pe = __builtin_amdgcn_exp2f(S[j][r] - mx); l += pe; S[j][r] = pe; }
        l += __shfl_xor(l, 32);
        l += __builtin_amdgcn_exp2f(sink2 - mx);
        if (hi == 0) wsf[c32] = __builtin_amdgcn_rcpf(l);
        f32x16 o[2];
#pragma unroll
        for (int dh = 0; dh < 2; ++dh) o[dh] = (f32x16){0.f, 0.f, 0.f, 0.f, 0.f, 0.f, 0.f, 0.f, 0.f, 0.f, 0.f, 0.f, 0.f, 0.f, 0.f, 0.f};
#pragma unroll
        for (int j = 0; j < 5; ++j)
#pragma unroll
            for (int s2 = 0; s2 < 2; ++s2) {
                u32x4 pw;
                pw.x = cvtpk(S[j][8 * s2 + 0], S[j][8 * s2 + 1]); pw.y = cvtpk(S[j][8 * s2 + 2], S[j][8 * s2 + 3]);
                pw.z = cvtpk(S[j][8 * s2 + 4], S[j][8 * s2 + 5]); pw.w = cvtpk(S[j][8 * s2 + 6], S[j][8 * s2 + 7]);
                const bf16x8 pa = __builtin_bit_cast(bf16x8, pw);
#pragma unroll
                for (int dh = 0; dh < 2; ++dh) {
                    const LAS unsigned char* vp = lds + AT_V + (qo + 32 * j + 16 * s2 + 4 * hi + (i16 >> 2)) * AT_KP + (dh * 32 + 16 * gsel + 4 * (i16 & 3)) * 2;
                    const v4i16a_t v0 = __builtin_amdgcn_ds_read_tr16_b64_v4i16((LAS v4i16a_t*)vp);
                    const v4i16a_t v1 = __builtin_amdgcn_ds_read_tr16_b64_v4i16((LAS v4i16a_t*)(vp + 8 * AT_KP));
                    const bf16x8 vf = {v0[0], v0[1], v0[2], v0[3], v1[0], v1[1], v1[2], v1[3]};
                    o[dh] = __builtin_amdgcn_mfma_f32_32x32x16_bf16(pa, vf, o[dh], 0, 0, 0);
                }
            }
#pragma unroll
        for (int r = 0; r < 16; r += 2) {
            const int q0 = crow(r, hi), q1 = crow(r + 1, hi);
            const float i0v = wsf[q0], i1v = wsf[q1];
#pragma unroll
            for (int dh = 0; dh < 2; ++dh) {
                const unsigned w2 = cvtpk(o[dh][r] * i0v, o[dh][r + 1] * i1v);
                *(LAS unsigned short*)(ost + q0 * AT_KP + (dh * 32 + c32) * 2) = (unsigned short)(w2 & 0xffffu);
                *(LAS unsigned short*)(ost + q1 * AT_KP + (dh * 32 + c32) * 2) = (unsigned short)(w2 >> 16);
            }
        }
#pragma unroll
        for (int k = 0; k < 4; ++k) {
            const int e = lane + 64 * k;
            const u32x4 ov = *(const LAS u32x4*)(ost + (e >> 3) * AT_KP + (e & 7) * 16);
            u32x4 yv;
#pragma unroll
            for (int c = 0; c < 4; ++c) yv[c] = cvtpk(bflo(ov[c]) * bflo(zv[k][c]), bfhi(ov[c]) * bfhi(zv[k][c]));
            __builtin_nontemporal_store(yv, (u32x4*)(ybase + (tok0 + (e >> 3)) * ypitch + g * 256 + head * 64 + (e & 7) * 8));
        }
    }
    __syncthreads();
}

typedef unsigned u32x2 __attribute__((ext_vector_type(2)));
__device__ __forceinline__ void bc_unit(const SsdArgs& a, int unit, bf16* __restrict__ BC, int wv) {
    const int tid = opaque_tid(wv);
    const int b = unit >> 5, t0 = (unit & 31) * 64, cc = tid & 63, j0 = (tid >> 6) * 8;
    const bf16* src = a.P + ((size_t)b * SEQ) * PW + P_B + cc * 8;
    u32x4 raw[11];
#pragma unroll
    for (int k = 0; k < 11; ++k) {
        const int t = t0 + j0 - 3 + k;
        raw[k] = (u32x4){0u, 0u, 0u, 0u};
        if (t >= 0) raw[k] = *(const u32x4*)(src + (size_t)t * PW);
    }
    u32x4 ob[8];
#pragma unroll
    for (int e2 = 0; e2 < 4; ++e2) {
        const int c0 = 1024 + cc * 8 + 2 * e2;
        float w0[5], w1[5];
#pragma unroll
        for (int k = 0; k < 4; ++k) { const f32x2 wv = *(const f32x2*)(a.conv_w + k * 1536 + c0); w0[k] = wv.x; w1[k] = wv.y; }
        { const f32x2 wv = *(const f32x2*)(a.conv_b + c0); w0[4] = wv.x; w1[4] = wv.y; }
#pragma unroll
        for (int tt = 0; tt < 8; ++tt) {
            float v0 = w0[4], v1 = w1[4];
#pragma unroll
            for (int k = 0; k < 4; ++k) { v0 += w0[k] * bflo(raw[tt + k][e2]); v1 += w1[k] * bfhi(raw[tt + k][e2]); }
            ob[tt][e2] = cvtpk(siluf(v0), siluf(v1));
        }
    }
#pragma unroll
    for (int tt = 0; tt < 8; ++tt) if (!CONV_STEP1 || ((j0 + tt) & 63) < 3) *(u32x4*)(BC + ((size_t)b * SEQ + t0 + j0 + tt) * 512 + cc * 8) = ob[tt];
}

typedef short v4i16_t __attribute__((ext_vector_type(4)));
constexpr int SD_BP = 272, SD_XP = 144;
constexpr int SD_BM = 0, SD_CM = SD_BM + 128 * SD_BP, SD_XT = SD_CM + 128 * SD_BP, SD_SL = SD_XT + 64 * SD_BP, SD_ZT = SD_SL + 64 * SD_BP, SD_F = SD_ZT + 128 * SD_XP;
constexpr int SD_ACS = SD_F, SD_DTE = SD_F + 1024, SD_LACS = SD_F + 2048, SD_EACS = SD_F + 3072, SD_CW = SD_F + 4096, SD_END = SD_CW + 5 * 64 * 4;
static_assert(SD_END <= MISC_OFF, "SSD LDS map");
__device__ __forceinline__ float softplusf(float v) { return v > 15.f ? v : __builtin_amdgcn_logf(1.f + __builtin_amdgcn_exp2f(v * 1.4426950408889634f)) * 0.6931471805599453f; }
__device__ __forceinline__ void ssd_dt_chunk(LAS unsigned char* lds, float r0, float r1, int par, int lane, float A2, float dtb) {
    LAS float* acs2 = (LAS float*)(lds + SD_ACS) + par * 128; LAS float* dte = (LAS float*)(lds + SD_DTE) + par * 128; LAS float* lacs = (LAS float*)(lds + SD_LACS) + par * 128; LAS float* eacs = (LAS float*)(lds + SD_EACS) + par * 128;
    const float d0 = softplusf(r0 + dtb), d1 = softplusf(r1 + dtb);
    const float a0 = d0 * A2, a1 = d1 * A2, sp = a0 + a1;
    float incl = sp;
    incl = dpp_add<0x111, 0xf>(incl); incl = dpp_add<0x112, 0xf>(incl); incl = dpp_add<0x114, 0xf>(incl); incl = dpp_add<0x118, 0xf>(incl);
    incl = dpp_add<0x142, 0xa>(incl); incl = dpp_add<0x143, 0xc>(incl);
    const float c0v = incl - a1, tot = __builtin_bit_cast(float, __builtin_amdgcn_readlane(__builtin_bit_cast(int, incl), 63));
    acs2[2 * lane] = c0v; acs2[2 * lane + 1] = incl;
    lacs[2 * lane] = c0v - __builtin_amdgcn_logf(d0); lacs[2 * lane + 1] = incl - __builtin_amdgcn_logf(d1);
    dte[2 * lane] = d0 * __builtin_amdgcn_exp2f(tot - c0v); dte[2 * lane + 1] = d1 * __builtin_amdgcn_exp2f(tot - incl);
    eacs[2 * lane] = __builtin_amdgcn_exp2f(c0v); eacs[2 * lane + 1] = __builtin_amdgcn_exp2f(incl);
}
__device__ __forceinline__ void ssd_unit(const SsdArgs& a, int unit, LAS unsigned char* lds, bf16* ybase, int ypitch, float* ssqh, const bf16* __restrict__ BC, int wv, int probe = 0) {
    const int tid = opaque_tid(wv), lane = tid & 63, wid = __builtin_amdgcn_readfirstlane(tid >> 6), c32 = lane & 31, hi = lane >> 5;
    const int b = unit >> 4, h = unit & 15, g = h >> 3;
    const float LOG2E = 1.4426950408889634f;
    const float A2 = -__expf(a.a_log[h]) * LOG2E, Dk = a.dskip[h], dtb = a.dt_bias[h];
    LAS float* cwl = (LAS float*)(lds + SD_CW);
    for (int e = tid; e < 5 * 64; e += NTHR) { const int k = e >> 6, c = e & 63; cwl[e] = k < 4 ? a.conv_w[k * 1536 + h * 64 + c] : a.conv_b[h * 64 + c]; }
    for (int e = tid; e < 64 * SD_BP / 4; e += NTHR) ((LAS unsigned*)(lds + SD_SL))[e] = 0u;
    float dr0 = 0.f, dr1 = 0.f;
    if (wid == 0) { dr0 = a.DT[((size_t)b * SEQ + 2 * lane) * 16 + h]; dr1 = a.DT[((size_t)b * SEQ + 2 * lane + 1) * 16 + h]; ssd_dt_chunk(lds, dr0, dr1, 0, lane, A2, dtb); }
    const int it = wid >> 1, ph = wid & 1, pt = wid >> 2, nt = wid & 3;
    f32x16 St = {0.f, 0.f, 0.f, 0.f, 0.f, 0.f, 0.f, 0.f, 0.f, 0.f, 0.f, 0.f, 0.f, 0.f, 0.f, 0.f};
    u32x4 pbc[8] = {}, pxr[5] = {}, pz[2] = {};
    const int xc = tid & 7, tp = tid >> 3;
#define SSD_PF_LOAD(CH) do { if (probe & 1) break; const size_t r0_ = (size_t)b * SEQ + (CH) * 128; \
        _Pragma("unroll") for (int q = 0; q < 8; ++q) { const int e = tid + 512 * q, r = e >> 5, ci = e & 31; \
            pbc[q] = *(const u32x4*)(BC + (r0_ + r) * 512 + (ci < 16 ? g * 128 + ci * 8 : 256 + g * 128 + (ci - 16) * 8)); } \
        _Pragma("unroll") for (int k = 0; k < 5; ++k) { const int t = (CH) * 128 + 2 * tp - 3 + k; pxr[k] = (u32x4){0u, 0u, 0u, 0u}; \
            if (t >= 0) pxr[k] = *(const u32x4*)(a.P + ((size_t)b * SEQ + t) * PW + P_XS + h * 64 + xc * 8); } \
        _Pragma("unroll") for (int q = 0; q < 2; ++q) { const int e = tid + 512 * q; pz[q] = *(const u32x4*)(a.ZY + (r0_ + (e >> 3)) * ZYW + h * 64 + (e & 7) * 8); } } while (0)
#define SSD_PF_COMMIT() do { \
        _Pragma("unroll") for (int q = 0; q < 8; ++q) { const int e = tid + 512 * q, r = e >> 5, ci = e & 31; \
            *(LAS u32x4*)(lds + (ci < 16 ? SD_BM + ci * 16 : SD_CM + (ci - 16) * 16) + r * SD_BP) = pbc[q]; } \
        _Pragma("unroll") for (int q = 0; q < 2; ++q) { const int e = tid + 512 * q; *(LAS u32x4*)(lds + SD_ZT + (e >> 3) * SD_XP + (e & 7) * 16) = pz[q]; } \
        { _Pragma("unroll") for (int e2 = 0; e2 < 4; ++e2) { const int c0 = xc * 8 + 2 * e2; \
              f32x2 va = *(const LAS f32x2*)(cwl + 4 * 64 + c0), vc = va; \
              _Pragma("unroll") for (int k = 0; k < 4; ++k) { const f32x2 w2 = *(const LAS f32x2*)(cwl + k * 64 + c0); \
                  va += w2 * (f32x2){bflo(pxr[k][e2]), bfhi(pxr[k][e2])}; vc += w2 * (f32x2){bflo(pxr[k + 1][e2]), bfhi(pxr[k + 1][e2])}; } \
              va.x = siluf(va.x); va.y = siluf(va.y); vc.x = siluf(vc.x); vc.y = siluf(vc.y); \
              *(LAS unsigned*)(lds + SD_XT + c0 * SD_BP + tp * 4) = cvtpk(va.x, vc.x); \
              *(LAS unsigned*)(lds + SD_XT + (c0 + 1) * SD_BP + tp * 4) = cvtpk(va.y, vc.y); } } } while (0)
    if (wid == 0) { dr0 = a.DT[((size_t)b * SEQ + 128 + 2 * lane) * 16 + h]; dr1 = a.DT[((size_t)b * SEQ + 128 + 2 * lane + 1) * 16 + h]; }
    SSD_PF_LOAD(0);
    __syncthreads();
    SSD_PF_COMMIT();
    __syncthreads();
#pragma unroll 1
    for (int ch = 0; ch < SEQ / 128; ++ch) {
        const int t0 = ch * 128, par = ch & 1;
        const size_t row0 = (size_t)b * SEQ + t0;
        const LAS float* acs2 = (const LAS float*)(lds + SD_ACS) + par * 128; const LAS float* dte = (const LAS float*)(lds + SD_DTE) + par * 128;
        const LAS float* lacs = (const LAS float*)(lds + SD_LACS) + par * 128; const LAS float* eacs = (const LAS float*)(lds + SD_EACS) + par * 128;
        if (ch + 1 < SEQ / 128) SSD_PF_LOAD(ch + 1);
        if (!(probe & 2)) {
            bf16x8 cf[8];
#pragma unroll
            for (int ks = 0; ks < 8; ++ks) cf[ks] = *(const LAS bf16x8*)(lds + SD_CM + (32 * it + c32) * SD_BP + ks * 32 + hi * 16);
            f32x16 Yd = {0.f, 0.f, 0.f, 0.f, 0.f, 0.f, 0.f, 0.f, 0.f, 0.f, 0.f, 0.f, 0.f, 0.f, 0.f, 0.f};
            const float ai = acs2[32 * it + c32];
#pragma unroll
            for (int jt = 0; jt < 4; ++jt) {
                if (jt <= it) {
                    f32x16 X = {0.f, 0.f, 0.f, 0.f, 0.f, 0.f, 0.f, 0.f, 0.f, 0.f, 0.f, 0.f, 0.f, 0.f, 0.f, 0.f};
#pragma unroll
                    for (int ks = 0; ks < 8; ++ks) {
                        const bf16x8 bfr = *(const LAS bf16x8*)(lds + SD_BM + (32 * jt + c32) * SD_BP + ks * 32 + hi * 16);
                        X = __builtin_amdgcn_mfma_f32_32x32x16_bf16(bfr, cf[ks], X, 0, 0, 0);
                    }
#pragma unroll
                    for (int r4 = 0; r4 < 4; ++r4) {
                        const f32x4 aj = *(const LAS f32x4*)(lacs + 32 * jt + 8 * r4 + 4 * hi);
#pragma unroll
                        for (int q = 0; q < 4; ++q) {
                            const int r = 4 * r4 + q, jr = 8 * r4 + 4 * hi + q;
                            float f = __builtin_amdgcn_exp2f(ai - aj[q]);
                            if (jt == it && jr > c32) f = 0.f;
                            X[r] *= f;
                        }
                    }
#pragma unroll
                    for (int s2 = 0; s2 < 2; ++s2) {
                        u32x4 pw;
                        pw.x = cvtpk(X[8 * s2 + 0], X[8 * s2 + 1]); pw.y = cvtpk(X[8 * s2 + 2], X[8 * s2 + 3]);
                        pw.z = cvtpk(X[8 * s2 + 4], X[8 * s2 + 5]); pw.w = cvtpk(X[8 * s2 + 6], X[8 * s2 + 7]);
                        const LAS unsigned char* vp = lds + SD_XT + (32 * ph + c32) * SD_BP + (32 * jt + 16 * s2 + 4 * hi) * 2;
                        const s16x4 v0 = *(const LAS s16x4*)vp, v1 = *(const LAS s16x4*)(vp + 16);
                        const bf16x8 vf = {v0[0], v0[1], v0[2], v0[3], v1[0], v1[1], v1[2], v1[3]};
                        Yd = __builtin_amdgcn_mfma_f32_32x32x16_bf16(__builtin_bit_cast(bf16x8, pw), vf, Yd, 0, 0, 0);
                    }
                }
            }
            f32x16 Yo = {0.f, 0.f, 0.f, 0.f, 0.f, 0.f, 0.f, 0.f, 0.f, 0.f, 0.f, 0.f, 0.f, 0.f, 0.f, 0.f};
#pragma unroll
            for (int ks = 0; ks < 8; ++ks) {
                const bf16x8 sf = *(const LAS bf16x8*)(lds + SD_SL + (32 * ph + c32) * SD_BP + ks * 32 + hi * 16);
                Yo = __builtin_amdgcn_mfma_f32_32x32x16_bf16(cf[ks], sf, Yo, 0, 0, 0);
            }
            const int pcol = 32 * ph + c32;
#pragma unroll
            for (int r4 = 0; r4 < 4; ++r4) {
                const f32x4 ea = *(const LAS f32x4*)(eacs + 32 * it + 8 * r4 + 4 * hi);
                const u32x2 xw = *(const LAS u32x2*)(lds + SD_XT + pcol * SD_BP + (32 * it + 8 * r4 + 4 * hi) * 2);
                const float xs4[4] = {bflo(xw.x), bfhi(xw.x), bflo(xw.y), bfhi(xw.y)};
#pragma unroll
                for (int q = 0; q < 4; ++q) {
                    const int r = 4 * r4 + q, i = 32 * it + 8 * r4 + 4 * hi + q;
                    const float xs = xs4[q];
                    const float y = Yd[r] + ea[q] * Yo[r] + Dk * xs;
                    LAS unsigned short* zp = (LAS unsigned short*)(lds + SD_ZT + i * SD_XP + pcol * 2);
                    *zp = (unsigned short)cvtpk(y * bf2f(*zp), 0.f);
                }
            }
        }
        __syncthreads();
        if (!(probe & 2)) {
            const float dec = eacs[127];
#pragma unroll
            for (int r = 0; r < 16; ++r) St[r] *= dec;
            const int i16 = lane & 15, gsel = (lane >> 4) & 1;
#pragma unroll
            for (int ks = 0; ks < 8; ++ks) {
                const u32x4 xr = *(const LAS u32x4*)(lds + SD_XT + (32 * pt + c32) * SD_BP + ks * 32 + hi * 16);
                const f32x4 f0 = *(const LAS f32x4*)(dte + 16 * ks + 8 * hi), f1 = *(const LAS f32x4*)(dte + 16 * ks + 8 * hi + 4);
                u32x4 aw;
                aw.x = cvtpk(bflo(xr.x) * f0[0], bfhi(xr.x) * f0[1]); aw.y = cvtpk(bflo(xr.y) * f0[2], bfhi(xr.y) * f0[3]);
                aw.z = cvtpk(bflo(xr.z) * f1[0], bfhi(xr.z) * f1[1]); aw.w = cvtpk(bflo(xr.w) * f1[2], bfhi(xr.w) * f1[3]);
                const LAS unsigned char* bp = lds + SD_BM + (16 * ks + 8 * hi + (i16 >> 2)) * SD_BP + (32 * nt + 16 * gsel + 4 * (i16 & 3)) * 2;
                const v4i16_t t0v = __builtin_amdgcn_ds_read_tr16_b64_v4i16((LAS v4i16_t*)bp);
                const v4i16_t t1v = __builtin_amdgcn_ds_read_tr16_b64_v4i16((LAS v4i16_t*)(bp + 4 * SD_BP));
                const bf16x8 bfr = {t0v[0], t0v[1], t0v[2], t0v[3], t1v[0], t1v[1], t1v[2], t1v[3]};
                St = __builtin_amdgcn_mfma_f32_32x32x16_bf16(__builtin_bit_cast(bf16x8, aw), bfr, St, 0, 0, 0);
            }
#pragma unroll
            for (int r = 0; r < 16; r += 2) {
                const unsigned w2 = cvtpk(St[r], St[r + 1]);
                *(LAS unsigned short*)(lds + SD_SL + (32 * pt + crow(r, hi)) * SD_BP + (32 * nt + c32) * 2) = (unsigned short)(w2 & 0xffffu);
                *(LAS unsigned short*)(lds + SD_SL + (32 * pt + crow(r + 1, hi)) * SD_BP + (32 * nt + c32) * 2) = (unsigned short)(w2 >> 16);
            }
        }
        __syncthreads();
#pragma unroll
        for (int q = 0; q < 2; ++q) {
            const int e = tid + 512 * q, r = e >> 3;
            const u32x4 yv = *(const LAS u32x4*)(lds + SD_ZT + r * SD_XP + (e & 7) * 16);
            *(u32x4*)(ybase + (row0 + r) * ypitch + h * 64 + (e & 7) * 8) = yv;
            float sq = 0.f;
#pragma unroll
            for (int k = 0; k < 4; ++k) { const float lo = bflo(yv[k]), hi2 = bfhi(yv[k]); sq += lo * lo + hi2 * hi2; }
            sq = dpp_add<0x111, 0xf>(sq); sq = dpp_add<0x112, 0xf>(sq); sq = dpp_add<0x114, 0xf>(sq);
            if (ssqh != nullptr && (lane & 7) == 7) ssqh[(row0 + r) * 16 + h] = sq;
        }
        if (ch + 1 < SEQ / 128) {
            SSD_PF_COMMIT();
            if (wid == 0) {
                ssd_dt_chunk(lds, dr0, dr1, par ^ 1, lane, A2, dtb);
                if (ch + 2 < SEQ / 128) { dr0 = a.DT[(row0 + 256 + 2 * lane) * 16 + h]; dr1 = a.DT[(row0 + 256 + 2 * lane + 1) * 16 + h]; }
            }
        }
        __syncthreads();
    }
#undef SSD_PF_LOAD
#undef SSD_PF_COMMIT
}

constexpr int S5_Q = 64, S5_NCH = SEQ / S5_Q, S5_BP = 272, S5_XP = 144;
constexpr int S5_BM = 0, S5_CM = 64 * S5_BP, S5_XT = 2 * 64 * S5_BP, S5_WT = S5_XT + 64 * S5_XP, S5_ZT = S5_WT + 64 * S5_XP, S5_SET = S5_ZT + 64 * S5_XP;
constexpr int S5_SL = 2 * S5_SET, S5_F = S5_SL + 64 * S5_BP;
constexpr int S5_ACS = S5_F, S5_LACS = S5_F + 768, S5_DTE = S5_F + 1536, S5_EACS = S5_F + 2304, S5_CW = S5_F + 3072, S5_DTA = S5_CW + 5 * 64 * 4, S5_END = S5_DTA + SEQ * 4;
static_assert(S5_END <= MISC_OFF, "SSD5 LDS map");
__device__ __forceinline__ void ssd5_dt(LAS unsigned char* lds, int ch, int lane, float A2) {
    const int sl = (ch % 3) * 64 + lane;
    const float d = ((const LAS float*)(lds + S5_DTA))[ch * S5_Q + lane];
    float incl = d * A2;
    incl = dpp_add<0x111, 0xf>(incl); incl = dpp_add<0x112, 0xf>(incl); incl = dpp_add<0x114, 0xf>(incl); incl = dpp_add<0x118, 0xf>(incl);
    incl = dpp_add<0x142, 0xa>(incl); incl = dpp_add<0x143, 0xc>(incl);
    const float tot = __builtin_bit_cast(float, __builtin_amdgcn_readlane(__builtin_bit_cast(int, incl), 63));
    ((LAS float*)(lds + S5_ACS))[sl] = incl;
    ((LAS float*)(lds + S5_LACS))[sl] = incl - __builtin_amdgcn_logf(d);
    ((LAS float*)(lds + S5_DTE))[sl] = d * __builtin_amdgcn_exp2f(tot - incl);
    ((LAS float*)(lds + S5_EACS))[sl] = __builtin_amdgcn_exp2f(incl);
}
__device__ __forceinline__ void ssd_unit5(const SsdArgs& a, int unit, LAS unsigned char* lds, bf16* ybase, int ypitch, float* ssqh, const bf16* __restrict__ BC, int wv) {
    const int tid = opaque_tid(wv), lane = tid & 63, wid = __builtin_amdgcn_readfirstlane(tid >> 6), c32 = lane & 31, hi = lane >> 5;
    const int b = unit >> 4, h = unit & 15, g = h >> 3;
    const float A2 = -__expf(a.a_log[h]) * 1.4426950408889634f, Dk = a.dskip[h], dtb = a.dt_bias[h];
    const size_t tok0 = (size_t)b * SEQ;
    LAS float* cwl = (LAS float*)(lds + S5_CW);
    for (int e = tid; e < 5 * 64; e += NTHR) { const int k = e >> 6, c = e & 63; cwl[e] = k < 4 ? a.conv_w[k * 1536 + h * 64 + c] : a.conv_b[h * 64 + c]; }
    for (int e = tid; e < 64 * S5_BP / 4; e += NTHR) ((LAS unsigned*)(lds + S5_SL))[e] = 0u;
    {
        float r4[4];
#pragma unroll
        for (int q = 0; q < 4; ++q) r4[q] = a.DT[(tok0 + tid + NTHR * q) * 16 + h];
#pragma unroll
        for (int q = 0; q < 4; ++q) ((LAS float*)(lds + S5_DTA))[tid + NTHR * q] = softplusf(r4[q] + dtb);
    }
    const int t = tid & 255, xc = t & 7, tp = t >> 3;
    u32x4 pbc[8] = {}, pxr[5] = {}, pz[2] = {};
#define S5_LOAD(CH) do { const size_t r0_ = tok0 + (size_t)(CH) * S5_Q; \
        _Pragma("unroll") for (int q = 0; q < 8; ++q) { const int e = t + 256 * q, r = e >> 5, ci = e & 31; \
            pbc[q] = *(const u32x4*)(BC + (r0_ + r) * 512 + (ci < 16 ? g * 128 + ci * 8 : 256 + g * 128 + (ci - 16) * 8)); } \
        _Pragma("unroll") for (int k = 0; k < 5; ++k) { const int tk = (CH) * S5_Q + 2 * tp - 3 + k; pxr[k] = (u32x4){0u, 0u, 0u, 0u}; \
            if (tk >= 0) pxr[k] = *(const u32x4*)(a.P + (tok0 + tk) * PW + P_XS + h * 64 + xc * 8); } \
        _Pragma("unroll") for (int q = 0; q < 2; ++q) { const int e = t + 256 * q; pz[q] = *(const u32x4*)(a.ZY + (r0_ + (e >> 3)) * ZYW + h * 64 + (e & 7) * 8); } } while (0)
#define S5_COMMIT(CH) do { LAS unsigned char* sb_ = lds + ((CH) & 1) * S5_SET; \
        _Pragma("unroll") for (int q = 0; q < 8; ++q) { const int e = t + 256 * q, r = e >> 5, ci = e & 31; \
            *(LAS u32x4*)(sb_ + (ci < 16 ? S5_BM + ci * 16 : S5_CM + (ci - 16) * 16) + r * S5_BP) = pbc[q]; } \
        _Pragma("unroll") for (int q = 0; q < 2; ++q) { const int e = t + 256 * q; *(LAS u32x4*)(sb_ + S5_ZT + (e >> 3) * S5_XP + (e & 7) * 16) = pz[q]; } \
        const f32x2 de_ = *(const LAS f32x2*)((const LAS float*)(lds + S5_DTE) + ((CH) % 3) * 64 + 2 * tp); \
        _Pragma("unroll") for (int e2 = 0; e2 < 4; ++e2) { const int c0 = xc * 8 + 2 * e2; \
            f32x2 va = *(const LAS f32x2*)(cwl + 4 * 64 + c0), vc = va; \
            _Pragma("unroll") for (int k = 0; k < 4; ++k) { const f32x2 w2 = *(const LAS f32x2*)(cwl + k * 64 + c0); \
                va += w2 * (f32x2){bflo(pxr[k][e2]), bfhi(pxr[k][e2])}; vc += w2 * (f32x2){bflo(pxr[k + 1][e2]), bfhi(pxr[k + 1][e2])}; } \
            va.x = siluf(va.x); va.y = siluf(va.y); vc.x = siluf(vc.x); vc.y = siluf(vc.y); \
            *(LAS unsigned*)(sb_ + S5_XT + c0 * S5_XP + tp * 4) = cvtpk(va.x, vc.x); \
            *(LAS unsigned*)(sb_ + S5_XT + (c0 + 1) * S5_XP + tp * 4) = cvtpk(va.y, vc.y); \
            *(LAS unsigned*)(sb_ + S5_WT + c0 * S5_XP + tp * 4) = cvtpk(va.x * de_.x, vc.x * de_.y); \
            *(LAS unsigned*)(sb_ + S5_WT + (c0 + 1) * S5_XP + tp * 4) = cvtpk(va.y * de_.x, vc.y * de_.y); } } while (0)
#define S5_YSTORE(CH) do { const size_t r0_ = tok0 + (size_t)(CH) * S5_Q; \
        _Pragma("unroll") for (int q = 0; q < 2; ++q) { const int e = t + 256 * q, r = e >> 3; \
            const u32x4 yv = *(const LAS u32x4*)(lds + ((CH) & 1) * S5_SET + S5_ZT + r * S5_XP + (e & 7) * 16); \
            *(u32x4*)(ybase + (r0_ + r) * ypitch + h * 64 + (e & 7) * 8) = yv; \
            float sq = 0.f; _Pragma("unroll") for (int k = 0; k < 4; ++k) { const float lo = bflo(yv[k]), hi2 = bfhi(yv[k]); sq += lo * lo + hi2 * hi2; } \
            sq = dpp_add<0x111, 0xf>(sq); sq = dpp_add<0x112, 0xf>(sq); sq = dpp_add<0x114, 0xf>(sq); \
            if (ssqh != nullptr && (lane & 7) == 7) ssqh[(r0_ + r) * 16 + h] = sq; } } while (0)
    __syncthreads();
    if (wid >= 4) S5_LOAD(0);
    if (wid == 4) { ssd5_dt(lds, 0, lane, A2); ssd5_dt(lds, 1, lane, A2); }
    __syncthreads();
    if (wid >= 4) { S5_COMMIT(0); S5_LOAD(1); }
    __syncthreads();
    if (wid < 4) {
        const int it = (wid >> 1) & 1, ph = wid & 1;
        const int nst = wid < 2 ? 3 : 1, st0 = wid < 2 ? 3 * wid : 4 + wid;
        f32x16 St[3];
#pragma unroll
        for (int k = 0; k < 3; ++k) St[k] = (f32x16){0.f, 0.f, 0.f, 0.f, 0.f, 0.f, 0.f, 0.f, 0.f, 0.f, 0.f, 0.f, 0.f, 0.f, 0.f, 0.f};
#pragma unroll 1
        for (int ch = 0; ch < S5_NCH; ++ch) {
            LAS unsigned char* sb = lds + (ch & 1) * S5_SET;
            const int sl = (ch % 3) * 64;
            const LAS float* acs2 = (const LAS float*)(lds + S5_ACS) + sl; const LAS float* lacs = (const LAS float*)(lds + S5_LACS) + sl; const LAS float* eacs = (const LAS float*)(lds + S5_EACS) + sl;
            {
                bf16x8 cf[8];
#pragma unroll
                for (int ks = 0; ks < 8; ++ks) cf[ks] = *(const LAS bf16x8*)(sb + S5_CM + (32 * it + c32) * S5_BP + ks * 32 + hi * 16);
                f32x16 Yd = {0.f, 0.f, 0.f, 0.f, 0.f, 0.f, 0.f, 0.f, 0.f, 0.f, 0.f, 0.f, 0.f, 0.f, 0.f, 0.f};
                const float ai = acs2[32 * it + c32];
#pragma unroll
                for (int jt = 0; jt < 2; ++jt) {
                    if (jt <= it) {
                        f32x16 X = {0.f, 0.f, 0.f, 0.f, 0.f, 0.f, 0.f, 0.f, 0.f, 0.f, 0.f, 0.f, 0.f, 0.f, 0.f, 0.f};
#pragma unroll
                        for (int ks = 0; ks < 8; ++ks) {
                            const bf16x8 bfr = *(const LAS bf16x8*)(sb + S5_BM + (32 * jt + c32) * S5_BP + ks * 32 + hi * 16);
                            X = __builtin_amdgcn_mfma_f32_32x32x16_bf16(bfr, cf[ks], X, 0, 0, 0);
                        }
#pragma unroll
                        for (int r4 = 0; r4 < 4; ++r4) {
                            const f32x4 aj = *(const LAS f32x4*)(lacs + 32 * jt + 8 * r4 + 4 * hi);
#pragma unroll
                            for (int q = 0; q < 4; ++q) {
                                const int r = 4 * r4 + q, jr = 8 * r4 + 4 * hi + q;
                                float f = __builtin_amdgcn_exp2f(ai - aj[q]);
                                if (jt == it && jr > c32) f = 0.f;
                                X[r] *= f;
                            }
                        }
#pragma unroll
                        for (int s2 = 0; s2 < 2; ++s2) {
                            u32x4 pw;
                            pw.x = cvtpk(X[8 * s2 + 0], X[8 * s2 + 1]); pw.y = cvtpk(X[8 * s2 + 2], X[8 * s2 + 3]);
                            pw.z = cvtpk(X[8 * s2 + 4], X[8 * s2 + 5]); pw.w = cvtpk(X[8 * s2 + 6], X[8 * s2 + 7]);
                            const LAS unsigned char* vp = sb + S5_XT + (32 * ph + c32) * S5_XP + (32 * jt + 16 * s2 + 4 * hi) * 2;
                            const s16x4 v0 = *(const LAS s16x4*)vp, v1 = *(const LAS s16x4*)(vp + 16);
                            const bf16x8 vf = {v0[0], v0[1], v0[2], v0[3], v1[0], v1[1], v1[2], v1[3]};
                            Yd = __builtin_amdgcn_mfma_f32_32x32x16_bf16(__builtin_bit_cast(bf16x8, pw), vf, Yd, 0, 0, 0);
                        }
                    }
                }
                f32x16 Yo = {0.f, 0.f, 0.f, 0.f, 0.f, 0.f, 0.f, 0.f, 0.f, 0.f, 0.f, 0.f, 0.f, 0.f, 0.f, 0.f};
#pragma unroll
                for (int ks = 0; ks < 8; ++ks) {
                    const bf16x8 sf = *(const LAS bf16x8*)(lds + S5_SL + (32 * ph + c32) * S5_BP + ks * 32 + hi * 16);
                    Yo = __builtin_amdgcn_mfma_f32_32x32x16_bf16(cf[ks], sf, Yo, 0, 0, 0);
                }
                const int pcol = 32 * ph + c32;
#pragma unroll
                for (int r4 = 0; r4 < 4; ++r4) {
                    const f32x4 ea = *(const LAS f32x4*)(eacs + 32 * it + 8 * r4 + 4 * hi);
                    const u32x2 xw = *(const LAS u32x2*)(sb + S5_XT + pcol * S5_XP + (32 * it + 8 * r4 + 4 * hi) * 2);
                    const float xs4[4] = {bflo(xw.x), bfhi(xw.x), bflo(xw.y), bfhi(xw.y)};
#pragma unroll
                    for (int q = 0; q < 4; ++q) {
                        const int r = 4 * r4 + q, i = 32 * it + 8 * r4 + 4 * hi + q;
                        const float y = Yd[r] + ea[q] * Yo[r] + Dk * xs4[q];
                        LAS unsigned short* zp = (LAS unsigned short*)(sb + S5_ZT + i * S5_XP + pcol * 2);
                        *zp = (unsigned short)cvtpk(y * bf2f(*zp), 0.f);
                    }
                }
            }
            asm volatile("s_waitcnt lgkmcnt(0)" ::: "memory"); __builtin_amdgcn_s_barrier();
            {
                const float dec = eacs[63];
                const int i16 = lane & 15, gsel = (lane >> 4) & 1;
#pragma unroll
                for (int k = 0; k < 3; ++k) {
                    if (k < nst) {
                        const int tl = st0 + k, pt = tl >> 2, nt = tl & 3;
                        f32x16 acc = St[k];
#pragma unroll
                        for (int r = 0; r < 16; ++r) acc[r] *= dec;
#pragma unroll
                        for (int ks = 0; ks < 4; ++ks) {
                            const bf16x8 aw = *(const LAS bf16x8*)(sb + S5_WT + (32 * pt + c32) * S5_XP + ks * 32 + hi * 16);
                            const LAS unsigned char* bp = sb + S5_BM + (16 * ks + 8 * hi + (i16 >> 2)) * S5_BP + (32 * nt + 16 * gsel + 4 * (i16 & 3)) * 2;
                            const v4i16_t t0v = __builtin_amdgcn_ds_read_tr16_b64_v4i16((LAS v4i16_t*)bp);
                            const v4i16_t t1v = __builtin_amdgcn_ds_read_tr16_b64_v4i16((LAS v4i16_t*)(bp + 4 * S5_BP));
                            const bf16x8 bfr = {t0v[0], t0v[1], t0v[2], t0v[3], t1v[0], t1v[1], t1v[2], t1v[3]};
                            acc = __builtin_amdgcn_mfma_f32_32x32x16_bf16(aw, bfr, acc, 0, 0, 0);
                        }
                        St[k] = acc;
#pragma unroll
                        for (int r = 0; r < 16; r += 2) {
                            const unsigned w2 = cvtpk(acc[r], acc[r + 1]);
                            *(LAS unsigned short*)(lds + S5_SL + (32 * pt + crow(r, hi)) * S5_BP + (32 * nt + c32) * 2) = (unsigned short)(w2 & 0xffffu);
                            *(LAS unsigned short*)(lds + S5_SL + (32 * pt + crow(r + 1, hi)) * S5_BP + (32 * nt + c32) * 2) = (unsigned short)(w2 >> 16);
                        }
                    }
                }
            }
            asm volatile("s_waitcnt lgkmcnt(0)" ::: "memory"); __builtin_amdgcn_s_barrier();
        }
    } else {
#pragma unroll 1
        for (int ch = 0; ch < S5_NCH; ++ch) {
            if (ch >= 1) S5_YSTORE(ch - 1);
            if (ch + 1 < S5_NCH) {
                S5_COMMIT(ch + 1);
                if (ch + 2 < S5_NCH) { S5_LOAD(ch + 2); if (wid == 4) ssd5_dt(lds, ch + 2, lane, A2); }
            }
            __builtin_amdgcn_s_barrier();
            asm volatile("s_waitcnt lgkmcnt(0)" ::: "memory"); __builtin_amdgcn_s_barrier();
        }
        S5_YSTORE(S5_NCH - 1);
    }
    __syncthreads();
#undef S5_LOAD
#undef S5_COMMIT
#undef S5_YSTORE
}

constexpr int S6_SL = 2 * S5_SET, S6_F = S6_SL + 2 * 16384;
constexpr int S6_ACS = S6_F, S6_LACS = S6_F + 768, S6_DTE = S6_F + 1536, S6_EACS = S6_F + 2304, S6_CW = S6_F + 3072, S6_END = S6_CW + 5 * 64 * 4;
static_assert(S6_END <= MISC_OFF, "SSD6 LDS map");
__device__ __forceinline__ float dot2sq(unsigned v, float acc) { const bf16x2_t_ b = __builtin_bit_cast(bf16x2_t_, v); return __builtin_amdgcn_fdot2_f32_bf16(b, b, acc, false); }
__device__ __forceinline__ void ssd6_dt(LAS unsigned char* lds, int ch, int lane, float A2, float d) {
    const int sl = (ch % 3) * 64 + lane;
    float incl = d * A2;
    incl = dpp_add<0x111, 0xf>(incl); incl = dpp_add<0x112, 0xf>(incl); incl = dpp_add<0x114, 0xf>(incl); incl = dpp_add<0x118, 0xf>(incl);
    incl = dpp_add<0x142, 0xa>(incl); incl = dpp_add<0x143, 0xc>(incl);
    const float tot = __builtin_bit_cast(float, __builtin_amdgcn_readlane(__builtin_bit_cast(int, incl), 63));
    ((LAS float*)(lds + S6_ACS))[sl] = incl;
    ((LAS float*)(lds + S6_LACS))[sl] = incl - __builtin_amdgcn_logf(d);
    ((LAS float*)(lds + S6_DTE))[sl] = d * __builtin_amdgcn_exp2f(tot - incl);
    ((LAS float*)(lds + S6_EACS))[sl] = __builtin_amdgcn_exp2f(incl);
}
__device__ __forceinline__ void ssd6_state_tile(f32x16& St, const LAS unsigned char* sb, LAS unsigned char* sw, int pt, int nt, float dec, int lane) {
    const int c32 = lane & 31, hi = lane >> 5, i16 = lane & 15, gsel = (lane >> 4) & 1;
    bf16x8 aw[4]; v4i16_t t0v[4], t1v[4];
#pragma unroll
    for (int ks = 0; ks < 4; ++ks) {
        aw[ks] = *(const LAS bf16x8*)(sb + S5_WT + (32 * pt + c32) * S5_XP + (((2 * ks + hi) ^ (((32 * pt + c32) >> 3) & 7)) << 4));
        const LAS unsigned char* bp = sb + S5_BM + (16 * ks + 8 * hi + (i16 >> 2)) * S5_BP + (32 * nt + 16 * gsel + 4 * (i16 & 3)) * 2;
        t0v[ks] = __builtin_amdgcn_ds_read_tr16_b64_v4i16((LAS v4i16_t*)bp);
        t1v[ks] = __builtin_amdgcn_ds_read_tr16_b64_v4i16((LAS v4i16_t*)(bp + 4 * S5_BP));
    }
    f32x16 acc = St;
#pragma unroll
    for (int r = 0; r < 16; ++r) acc[r] *= dec;
#pragma unroll
    for (int ks = 0; ks < 4; ++ks) {
        const bf16x8 bfr = {t0v[ks][0], t0v[ks][1], t0v[ks][2], t0v[ks][3], t1v[ks][0], t1v[ks][1], t1v[ks][2], t1v[ks][3]};
        acc = __builtin_amdgcn_mfma_f32_32x32x16_bf16(aw[ks], bfr, acc, 0, 0, 0);
    }
    St = acc;
    const int bx = (64 * nt + 2 * c32) ^ (hi << 6);
    LAS unsigned char* wb = sw + (32 * pt + 4 * hi) * 256;
#pragma unroll
    for (int r = 0; r < 16; r += 2) {
        const unsigned w2 = cvtpk(acc[r], acc[r + 1]);
        const int a0 = (r & 3) + 8 * ((r >> 2) & 1), a1 = ((r + 1) & 3) + 8 * (((r + 1) >> 2) & 1);
        *(LAS unsigned short*)(wb + ((r & 3) + 8 * (r >> 2)) * 256 + (bx ^ (a0 << 4))) = (unsigned short)(w2 & 0xffffu);
        *(LAS unsigned short*)(wb + (((r + 1) & 3) + 8 * ((r + 1) >> 2)) * 256 + (bx ^ (a1 << 4))) = (unsigned short)(w2 >> 16);
    }
}
template <bool DIAG>
__device__ __forceinline__ void ssd6_maskf(float (&f)[16], float ai, const f32x4 (&aj)[4], int c32, int hi) {
#pragma unroll
    for (int r4 = 0; r4 < 4; ++r4)
#pragma unroll
        for (int q = 0; q < 4; ++q) {
            const int r = 4 * r4 + q, jr = 8 * r4 + 4 * hi + q;
            float v = __builtin_amdgcn_exp2f(ai - aj[r4][q]);
            if (DIAG && jr > c32) v = 0.f;
            f[r] = v;
        }
}
__device__ __forceinline__ void ssd6_yd(f32x16& Yd, const f32x16& X, const s16x4 (&xv)[4]) {
#pragma unroll
    for (int s2 = 0; s2 < 2; ++s2) {
        u32x4 pw;
        pw.x = cvtpk(X[8 * s2 + 0], X[8 * s2 + 1]); pw.y = cvtpk(X[8 * s2 + 2], X[8 * s2 + 3]);
        pw.z = cvtpk(X[8 * s2 + 4], X[8 * s2 + 5]); pw.w = cvtpk(X[8 * s2 + 6], X[8 * s2 + 7]);
        const bf16x8 vf = {xv[2 * s2][0], xv[2 * s2][1], xv[2 * s2][2], xv[2 * s2][3], xv[2 * s2 + 1][0], xv[2 * s2 + 1][1], xv[2 * s2 + 1][2], xv[2 * s2 + 1][3]};
        Yd = __builtin_amdgcn_mfma_f32_32x32x16_bf16(__builtin_bit_cast(bf16x8, pw), vf, Yd, 0, 0, 0);
    }
}
template <int PROBE>
__device__ __forceinline__ void ssd_unit6(const SsdArgs& a, int unit, LAS unsigned char* lds, bf16* ybase, int ypitch, float* ssqh, const bf16* __restrict__ BC, int wv) {
    const int tid = opaque_tid(wv), lane = tid & 63, wid = __builtin_amdgcn_readfirstlane(tid >> 6), c32 = lane & 31, hi = lane >> 5;
    const int b = unit >> 4, h = unit & 15, g = h >> 3;
    const float A2 = -__expf(a.a_log[h]) * 1.4426950408889634f, Dk = a.dskip[h], dtb = a.dt_bias[h];
    const size_t tok0 = (size_t)b * SEQ;
#if !CONV_STEP1
    {
        const int cp = tid & 127, q4 = tid >> 7;
        const int col = cp < 64 ? g * 128 + 2 * cp : 256 + g * 128 + 2 * (cp - 64);
        f32x2 wk[5];
#pragma unroll
        for (int k = 0; k < 4; ++k) wk[k] = *(const f32x2*)(a.conv_w + k * 1536 + 1024 + col);
        wk[4] = *(const f32x2*)(a.conv_b + 1024 + col);
        unsigned rv[8][6];
#pragma unroll
        for (int i = 0; i < 8; ++i) {
            const int bl = 1 + q4 * 8 + i;
            const size_t gb = (size_t)b * 32 + (bl < 32 ? bl : 31);
#pragma unroll
            for (int j = 0; j < 3; ++j) {
                rv[i][j] = *(const unsigned*)(a.RAWB + ((gb - 1) * 6 + 3 + j) * 512 + col);
                rv[i][3 + j] = *(const unsigned*)(a.RAWB + (gb * 6 + j) * 512 + col);
            }
        }
#pragma unroll
        for (int i = 0; i < 8; ++i) {
            const int bl = 1 + q4 * 8 + i;
#pragma unroll
            for (int r = 0; r < 3; ++r) {
                float v0 = wk[4].x, v1 = wk[4].y;
#pragma unroll
                for (int k = 0; k < 4; ++k) { v0 += wk[k].x * bflo(rv[i][r + k]); v1 += wk[k].y * bfhi(rv[i][r + k]); }
                if (bl < 32) *(unsigned*)((bf16*)BC + (tok0 + 64 * bl + r) * 512 + col) = cvtpk(siluf(v0), siluf(v1));
            }
        }
        asm volatile("s_waitcnt vmcnt(0)" ::: "memory");
    }
#endif
    LAS float* cwl = (LAS float*)(lds + S6_CW);
    for (int e = tid; e < 5 * 64; e += NTHR) { const int k = e >> 6, c = e & 63; cwl[e] = k < 4 ? a.conv_w[k * 1536 + h * 64 + c] : a.conv_b[h * 64 + c]; }
    for (int e = tid; e < 2 * 16384 / 4; e += NTHR) ((LAS unsigned*)(lds + S6_SL))[e] = 0u;
    const int t = tid & 255, xc = t & 7, tp = t >> 3;
    const int tpx4 = ((((tp >> 2) ^ xc) << 2) | (tp & 3)) * 4;
    u32x4 pbc0[8] = {}, pxr0[5] = {}, pz0[2] = {}, pbc1[8] = {}, pxr1[5] = {}, pz1[2] = {};
    const unsigned cBC = (unsigned)(tok0 * 1024 + g * 256) + (unsigned)((t >> 5) * 1024 + ((t & 31) < 16 ? (t & 31) * 16 : 512 + ((t & 31) - 16) * 16));
    const unsigned cP = (unsigned)(tok0 * (PW * 2) + (P_XS + h * 64) * 2) + (unsigned)(2 * tp * (PW * 2) + xc * 16);
    const unsigned cZ = (unsigned)(tok0 * (ZYW * 2) + h * 128) + (unsigned)((t >> 3) * (ZYW * 2) + (t & 7) * 16);
    const unsigned cY = (unsigned)(tok0 * (ypitch * 2) + h * 128) + (unsigned)((t >> 3) * (ypitch * 2) + (t & 7) * 16);
    const unsigned cQ = (unsigned)((tok0 * 16 + h) * 4) + (unsigned)((t >> 3) * 64);
    const char* BCb = (const char*)BC; const char* Pb = (const char*)a.P; const char* Zb = (const char*)a.ZY; char* Yb = (char*)ybase; char* Qb = (char*)ssqh;
#define S6_LOAD(CH, S) do { \
        _Pragma("unroll") for (int q = 0; q < 8; ++q) pbc##S[q] = *(const u32x4*)(BCb + (cBC + (unsigned)((CH) * (S5_Q * 1024) + q * 8192))); \
        _Pragma("unroll") for (int k = 0; k < 5; ++k) pxr##S[k] = *(const u32x4*)(Pb + (cP + (unsigned)(((CH) * S5_Q - 3 + k) * (PW * 2)))); \
        _Pragma("unroll") for (int q = 0; q < 2; ++q) pz##S[q] = *(const u32x4*)(Zb + (cZ + (unsigned)(((CH) * S5_Q + 32 * q) * (ZYW * 2)))); } while (0)
#define S6_LOAD0(S) do { \
        _Pragma("unroll") for (int q = 0; q < 8; ++q) pbc##S[q] = *(const u32x4*)(BCb + (cBC + (unsigned)(q * 8192))); \
        _Pragma("unroll") for (int k = 0; k < 5; ++k) { pxr##S[k] = (u32x4){0u, 0u, 0u, 0u}; if (2 * tp - 3 + k >= 0) pxr##S[k] = *(const u32x4*)(Pb + (cP + (unsigned)((k - 3) * (PW * 2)))); } \
        _Pragma("unroll") for (int q = 0; q < 2; ++q) pz##S[q] = *(const u32x4*)(Zb + (cZ + (unsigned)(32 * q * (ZYW * 2)))); } while (0)
#define S6_COMMIT(CH, S) do { LAS unsigned char* sb_ = lds + ((CH) & 1) * S5_SET; \
        _Pragma("unroll") for (int q = 0; q < 8; ++q) { const int e = t + 256 * q, r = e >> 5, ci = e & 31; \
            *(LAS u32x4*)(sb_ + (ci < 16 ? S5_BM + ci * 16 : S5_CM + (ci - 16) * 16) + r * S5_BP) = pbc##S[q]; } \
        _Pragma("unroll") for (int q = 0; q < 2; ++q) { const int e = t + 256 * q; *(LAS u32x4*)(sb_ + S5_ZT + (e >> 3) * S5_XP + (e & 7) * 16) = pz##S[q]; } \
        const f32x2 de_ = *(const LAS f32x2*)((const LAS float*)(lds + S6_DTE) + ((CH) % 3) * 64 + 2 * tp); \
        f32x2 wt_[5][4];        \
        _Pragma("unroll") for (int e2 = 0; e2 < 4; ++e2) _Pragma("unroll") for (int k = 0; k < 5; ++k) wt_[k][e2] = *(const LAS f32x2*)(cwl + k * 64 + xc * 8 + 2 * e2); \
        __builtin_amdgcn_sched_barrier(0); \
        _Pragma("unroll") for (int e2 = 0; e2 < 4; ++e2) { const int c0 = xc * 8 + 2 * e2; \
            f32x2 va = wt_[4][e2], vc = va; \
            _Pragma("unroll") for (int k = 0; k < 4; ++k) { const f32x2 w2 = wt_[k][e2]; \
                va += w2 * (f32x2){bflo(pxr##S[k][e2]), bfhi(pxr##S[k][e2])}; vc += w2 * (f32x2){bflo(pxr##S[k + 1][e2]), bfhi(pxr##S[k + 1][e2])}; } \
            va.x = siluf(va.x); va.y = siluf(va.y); vc.x = siluf(vc.x); vc.y = siluf(vc.y); \
            *(LAS unsigned*)(sb_ + S5_XT + c0 * S5_XP + tpx4) = cvtpk(va.x, vc.x); \
            *(LAS unsigned*)(sb_ + S5_XT + (c0 + 1) * S5_XP + tpx4) = cvtpk(va.y, vc.y); \
            *(LAS unsigned*)(sb_ + S5_WT + c0 * S5_XP + tpx4) = cvtpk(va.x * de_.x, vc.x * de_.y); \
            *(LAS unsigned*)(sb_ + S5_WT + (c0 + 1) * S5_XP + tpx4) = cvtpk(va.y * de_.x, vc.y * de_.y); } } while (0)
#define S6_YSTORE(CH) do { \
        _Pragma("unroll") for (int q = 0; q < 2; ++q) { const int e = t + 256 * q, r = e >> 3; \
            const u32x4 yv = *(const LAS u32x4*)(lds + ((CH) & 1) * S5_SET + S5_ZT + r * S5_XP + (e & 7) * 16); \
            *(u32x4*)(Yb + (cY + (unsigned)(((CH) * S5_Q + 32 * q) * (ypitch * 2)))) = yv; \
            float sq = dot2sq(yv.x, 0.f); sq = dot2sq(yv.y, sq); sq = dot2sq(yv.z, sq); sq = dot2sq(yv.w, sq); \
            sq = dpp_add<0x111, 0xf>(sq); sq = dpp_add<0x112, 0xf>(sq); sq = dpp_add<0x114, 0xf>(sq); \
            if (ssqh != nullptr && (lane & 7) == 7) *(float*)(Qb + (cQ + (unsigned)(((CH) * S5_Q + 32 * q) * 64))) = sq; } } while (0)
#define S6_BAR() do { asm volatile("s_waitcnt lgkmcnt(0)" ::: "memory"); __builtin_amdgcn_s_barrier(); } while (0)
    if (wid >= 4) S6_LOAD0(0);
    if (wid == 0) {
        const float da = a.DT[(tok0 + lane) * 16 + h], db = a.DT[(tok0 + 64 + lane) * 16 + h];
        ssd6_dt(lds, 0, lane, A2, softplusf(da + dtb)); ssd6_dt(lds, 1, lane, A2, softplusf(db + dtb));
    }
    __syncthreads();
    if (wid >= 4) { S6_COMMIT(0, 0); S6_LOAD(1, 1); S6_LOAD(2, 0); }
    __syncthreads();
    if (wid < 4) {
        const int it = (wid >> 1) & 1, ph = wid & 1;
        __builtin_amdgcn_s_waitcnt(0x0F70);
        f32x16 St0 = {0.f, 0.f, 0.f, 0.f, 0.f, 0.f, 0.f, 0.f, 0.f, 0.f, 0.f, 0.f, 0.f, 0.f, 0.f, 0.f}, St1 = St0;
        const int srd = (32 * ph + c32) * 256, sxr = (hi << 4) ^ ((c32 & 15) << 4);
#pragma unroll 1
        for (int ch = 0; ch < S5_NCH; ++ch) {
            LAS unsigned char* sb = lds + (ch & 1) * S5_SET;
            const LAS unsigned char* sr = lds + S6_SL + ((ch + 1) & 1) * 16384 + srd;
            const int sl = (ch % 3) * 64;
            const LAS float* acs2 = (const LAS float*)(lds + S6_ACS) + sl; const LAS float* lacs = (const LAS float*)(lds + S6_LACS) + sl; const LAS float* eacs = (const LAS float*)(lds + S6_EACS) + sl;
            float drw = 0.f;
            if (wid == 0 && ch + 2 < S5_NCH) { const float* dp = a.DT + (tok0 + (ch + 2) * S5_Q + lane) * 16 + h; asm volatile("global_load_dword %0, %1, off" : "=&v"(drw) : "v"(dp) : "memory"); }
            if (!(PROBE & 1)) {
                const LAS unsigned char* xrow = sb + S5_XT + (32 * ph + c32) * S5_XP; const int xsw = ((32 * ph + c32) >> 3) & 7;
                bf16x8 cf[8], bj[8], sf[8];
#pragma unroll
                for (int ks = 0; ks < 8; ++ks) cf[ks] = *(const LAS bf16x8*)(sb + S5_CM + (32 * it + c32) * S5_BP + ks * 32 + hi * 16);
#pragma unroll
                for (int ks = 0; ks < 8; ++ks) bj[ks] = *(const LAS bf16x8*)(sb + S5_BM + c32 * S5_BP + ks * 32 + hi * 16);
#pragma unroll
                for (int ks = 0; ks < 8; ++ks) sf[ks] = *(const LAS bf16x8*)(sr + (sxr ^ (ks << 5)));
                const float ai = acs2[32 * it + c32];
                f32x4 aj0[4]; s16x4 xv0[4];
#pragma unroll
                for (int r4 = 0; r4 < 4; ++r4) aj0[r4] = *(const LAS f32x4*)(lacs + 8 * r4 + 4 * hi);
#pragma unroll
                for (int s2 = 0; s2 < 2; ++s2) { xv0[2 * s2] = *(const LAS s16x4*)(xrow + (((2 * s2) ^ xsw) << 4) + 8 * hi); xv0[2 * s2 + 1] = *(const LAS s16x4*)(xrow + (((2 * s2 + 1) ^ xsw) << 4) + 8 * hi); }
                f32x16 X = {0.f, 0.f, 0.f, 0.f, 0.f, 0.f, 0.f, 0.f, 0.f, 0.f, 0.f, 0.f, 0.f, 0.f, 0.f, 0.f}, Yo = X, Yd = X;
#pragma unroll
                for (int ks = 0; ks < 8; ++ks) X = __builtin_amdgcn_mfma_f32_32x32x16_bf16(bj[ks], cf[ks], X, 0, 0, 0);
#pragma unroll
                for (int ks = 0; ks < 8; ++ks) Yo = __builtin_amdgcn_mfma_f32_32x32x16_bf16(cf[ks], sf[ks], Yo, 0, 0, 0);
                float f0[16];
                if (it == 0) ssd6_maskf<true>(f0, ai, aj0, c32, hi); else ssd6_maskf<false>(f0, ai, aj0, c32, hi);
#pragma unroll
                for (int i = 0; i < 16; ++i) { __builtin_amdgcn_sched_group_barrier(0x008, 1, 0); __builtin_amdgcn_sched_group_barrier(0x002, 2, 0); __builtin_amdgcn_sched_group_barrier(0x400, 1, 0); }
                if (it == 1) {
                    f32x4 aj1[4]; s16x4 xv1[4];
#pragma unroll
                    for (int ks = 0; ks < 8; ++ks) bj[ks] = *(const LAS bf16x8*)(sb + S5_BM + (32 + c32) * S5_BP + ks * 32 + hi * 16);
#pragma unroll
                    for (int r4 = 0; r4 < 4; ++r4) aj1[r4] = *(const LAS f32x4*)(lacs + 32 + 8 * r4 + 4 * hi);
#pragma unroll
                    for (int s2 = 0; s2 < 2; ++s2) { xv1[2 * s2] = *(const LAS s16x4*)(xrow + (((4 + 2 * s2) ^ xsw) << 4) + 8 * hi); xv1[2 * s2 + 1] = *(const LAS s16x4*)(xrow + (((5 + 2 * s2) ^ xsw) << 4) + 8 * hi); }
#pragma unroll
                    for (int r = 0; r < 16; ++r) X[r] *= f0[r];
                    ssd6_yd(Yd, X, xv0);
                    f32x16 X1 = {0.f, 0.f, 0.f, 0.f, 0.f, 0.f, 0.f, 0.f, 0.f, 0.f, 0.f, 0.f, 0.f, 0.f, 0.f, 0.f};
#pragma unroll
                    for (int ks = 0; ks < 8; ++ks) X1 = __builtin_amdgcn_mfma_f32_32x32x16_bf16(bj[ks], cf[ks], X1, 0, 0, 0);
                    float f1[16];
                    ssd6_maskf<true>(f1, ai, aj1, c32, hi);
#pragma unroll
                    for (int i = 0; i < 8; ++i) { __builtin_amdgcn_sched_group_barrier(0x008, 1, 1); __builtin_amdgcn_sched_group_barrier(0x002, 4, 1); __builtin_amdgcn_sched_group_barrier(0x400, 2, 1); }
#pragma unroll
                    for (int r = 0; r < 16; ++r) X1[r] *= f1[r];
                    ssd6_yd(Yd, X1, xv1);
                } else {
#pragma unroll
                    for (int r = 0; r < 16; ++r) X[r] *= f0[r];
                    ssd6_yd(Yd, X, xv0);
                }
                const int pcol = 32 * ph + c32, i16 = lane & 15, gsel = (lane >> 4) & 1;
                f32x4 ea[4]; u32x2 xw[4]; v4i16_t gz[4];
#pragma unroll
                for (int r4 = 0; r4 < 4; ++r4) {
                    ea[r4] = *(const LAS f32x4*)(eacs + 32 * it + 8 * r4 + 4 * hi);
                    xw[r4] = *(const LAS u32x2*)(xrow + (((4 * it + r4) ^ xsw) << 4) + 8 * hi);
                    gz[r4] = __builtin_amdgcn_ds_read_tr16_b64_v4i16((LAS v4i16_t*)(sb + S5_ZT + (32 * it + 8 * r4 + 4 * hi + (i16 >> 2)) * S5_XP + (32 * ph + 16 * gsel + 4 * (i16 & 3)) * 2));
                }
#pragma unroll
                for (int r4 = 0; r4 < 4; ++r4) {
                    const float xs4[4] = {bflo(xw[r4].x), bfhi(xw[r4].x), bflo(xw[r4].y), bfhi(xw[r4].y)};
                    float g4[4];
#pragma unroll
                    for (int q = 0; q < 4; ++q) { const int r = 4 * r4 + q; g4[q] = (Yd[r] + ea[r4][q] * Yo[r] + Dk * xs4[q]) * bf2f((unsigned short)gz[r4][q]); }
                    const unsigned w01 = cvtpk(g4[0], g4[1]), w23 = cvtpk(g4[2], g4[3]);
                    LAS unsigned char* zp = sb + S5_ZT + (32 * it + 8 * r4 + 4 * hi) * S5_XP + pcol * 2;
                    *(LAS unsigned short*)zp = (unsigned short)(w01 & 0xffffu); *(LAS unsigned short*)(zp + S5_XP) = (unsigned short)(w01 >> 16);
                    *(LAS unsigned short*)(zp + 2 * S5_XP) = (unsigned short)(w23 & 0xffffu); *(LAS unsigned short*)(zp + 3 * S5_XP) = (unsigned short)(w23 >> 16);
                }
            }
            if (!(PROBE & 2)) { const float dec = eacs[63]; ssd6_state_tile(St0, sb, lds + S6_SL + (ch & 1) * 16384, 0, wid, dec, lane); ssd6_state_tile(St1, sb, lds + S6_SL + (ch & 1) * 16384, 1, wid, dec, lane); }
            if (wid == 0 && ch + 2 < S5_NCH) {
                asm volatile("s_waitcnt vmcnt(0)" : "+v"(drw) :: "memory");
                ssd6_dt(lds, ch + 2, lane, A2, softplusf(drw + dtb));
            }
            S6_BAR();
        }
    } else {
#define S6_PERIOD(CH, S, LCH) do { \
            if ((CH) >= 1 && !(PROBE & 8)) S6_YSTORE((CH) - 1); \
            if ((CH) + 1 < S5_NCH) { if (!(PROBE & 16)) S6_COMMIT((CH) + 1, S); if ((CH) + 3 < S5_NCH && !(PROBE & 32)) S6_LOAD(LCH, S); } \
            S6_BAR(); } while (0)
#define S6_PERIOD_U(CH, S, LCH) do { \
            if (!(PROBE & 8)) S6_YSTORE((CH) - 1); \
            if (!(PROBE & 16)) S6_COMMIT((CH) + 1, S); if (!(PROBE & 32)) S6_LOAD(LCH, S); \
            S6_BAR(); } while (0)
        S6_PERIOD(0, 1, 3);
#pragma unroll 1
        for (int ch = 1; ch < S5_NCH - 1; ch += 2) {
            const int l3 = ch + 3 < S5_NCH ? ch + 3 : S5_NCH - 1, l4 = ch + 4 < S5_NCH ? ch + 4 : S5_NCH - 1;
            S6_PERIOD_U(ch, 0, l3);
            S6_PERIOD_U(ch + 1, 1, l4);
        }
        S6_PERIOD(S5_NCH - 1, 0, S5_NCH - 1);
        S6_YSTORE(S5_NCH - 1);
#undef S6_PERIOD
#undef S6_PERIOD_U
    }
    __syncthreads();
#undef S6_LOAD
#undef S6_LOAD0
#undef S6_COMMIT
#undef S6_YSTORE
#undef S6_BAR
}

struct ConfArgs { const bf16* P; bf16* ZY; const float* dw_w; const float* dw_b; const float* ln_w; const float* ln_b; };
__device__ __forceinline__ void conf_naive_unit(const ConfArgs& a, int unit, float* sm, int wv) {
    constexpr int TT = 16;
    float* glu = sm;
    float* outb = sm + (TT + 30) * 512;
    const int b = unit >> 7, t0 = (unit & 127) * TT, c = opaque_tid(wv), lane = c & 63, w = c >> 6;
    for (int tt = 0; tt < TT + 30; ++tt) {
        const int t = t0 - 30 + tt;
        float v = 0.f;
        if (t >= 0) { const size_t base = ((size_t)b * SEQ + t) * PW; v = bf2f(a.P[base + P_CA + c]); }
        glu[tt * 512 + c] = v;
    }
    float wk[31];
#pragma unroll
    for (int k = 0; k < 31; ++k) wk[k] = a.dw_w[k * 512 + c];
    const float bias = a.dw_b[c];
    for (int tt = 0; tt < TT; ++tt) {
        float v = bias;
#pragma unroll
        for (int k = 0; k < 31; ++k) v += wk[k] * glu[(tt + k) * 512 + c];
        outb[tt * 512 + c] = v;
    }
    __syncthreads();
    for (int tt = w * 2; tt < w * 2 + 2; ++tt) {
        float v[8], s = 0.f;
#pragma unroll
        for (int j = 0; j < 8; ++j) { v[j] = outb[tt * 512 + j * 64 + lane]; s += v[j]; }
        const float mean = wave_sum(s) * (1.f / 512.f);
        float s2 = 0.f;
#pragma unroll
        for (int j = 0; j < 8; ++j) { v[j] -= mean; s2 += v[j] * v[j]; }
        const float rstd = rsqrtf(wave_sum(s2) * (1.f / 512.f) + EPS);
        const size_t zrow = ((size_t)b * SEQ + t0 + tt) * ZYW + 1536;
#pragma unroll
        for (int j = 0; j < 8; ++j) {
            const int ch = j * 64 + lane;
            const float y = siluf(v[j] * rstd * a.ln_w[ch] + a.ln_b[ch]);
            const float z = bf2f(a.ZY[zrow + ch]);
            a.ZY[zrow + ch] = f2bf(y * siluf(z));
        }
    }
    __syncthreads();
}


constexpr int CF_TT = 64, CF_ROWS = CF_TT + 30, CF_GLU = 0, CF_OUT = CF_ROWS * 1024, CF_END = CF_OUT + CF_TT * 1024;
static_assert(CF_END <= MISC_OFF, "conformer LDS map");
__device__ __forceinline__ void conf_unit(const ConfArgs& a, int unit, LAS unsigned char* lds, bf16* ybase, int ypitch, int wv) {
    const int tid = opaque_tid(wv), lane = tid & 63, wid = __builtin_amdgcn_readfirstlane(tid >> 6);
    const int b = unit >> 5, t0 = (unit & 31) * CF_TT;
    {
        const int c8 = tid & 63, rb = tid >> 6;
        u32x4 va[12];
#pragma unroll
        for (int k = 0; k < 12; ++k) {
            const int row = rb + 8 * k, t = t0 - 30 + row;
            va[k] = (u32x4){0u, 0u, 0u, 0u};
            if (row < CF_ROWS && t >= 0) va[k] = *(const u32x4*)(a.P + ((size_t)b * SEQ + t) * PW + P_CA + c8 * 8);
        }
#pragma unroll
        for (int k = 0; k < 12; ++k) { const int row = rb + 8 * k; if (row < CF_ROWS) *(LAS u32x4*)(lds + CF_GLU + row * 1024 + c8 * 16) = va[k]; }
    }
    __syncthreads();
    {
        const int cp = tid & 255, th = tid >> 8;
        f32x2 w2[31];
#pragma unroll
        for (int k = 0; k < 31; ++k) w2[k] = *(const f32x2*)(a.dw_w + k * 512 + 2 * cp);
        const f32x2 bias2 = *(const f32x2*)(a.dw_b + 2 * cp);
#pragma unroll 1
        for (int bb = 0; bb < 2; ++bb) {
            const int r0 = th * 32 + bb * 16;
            f32x2 acc[16];
#pragma unroll
            for (int o = 0; o < 16; ++o) acc[o] = bias2;
#pragma unroll
            for (int r = 0; r < 46; ++r) {
                const unsigned xw = *(const LAS unsigned*)(lds + CF_GLU + (r0 + r) * 1024 + cp * 4);
                const f32x2 x2 = {bflo(xw), bfhi(xw)};
#pragma unroll
                for (int o = 0; o < 16; ++o) { if (r - o >= 0 && r - o <= 30) acc[o] += w2[r - o] * x2; }
            }
#pragma unroll
            for (int o = 0; o < 16; ++o) *(LAS unsigned*)(lds + CF_OUT + (r0 + o) * 1024 + cp * 4) = cvtpk(acc[o].x, acc[o].y);
        }
    }
    __syncthreads();
    {
        const f32x4 lw0 = *(const f32x4*)(a.ln_w + lane * 8), lw1 = *(const f32x4*)(a.ln_w + lane * 8 + 4), lb0 = *(const f32x4*)(a.ln_b + lane * 8), lb1 = *(const f32x4*)(a.ln_b + lane * 8 + 4);
        const float lw[8] = {lw0[0], lw0[1], lw0[2], lw0[3], lw1[0], lw1[1], lw1[2], lw1[3]}, lb[8] = {lb0[0], lb0[1], lb0[2], lb0[3], lb1[0], lb1[1], lb1[2], lb1[3]};
        u32x4 zv[8];
#pragma unroll
        for (int q = 0; q < 8; ++q) zv[q] = *(const u32x4*)(a.ZY + ((size_t)b * SEQ + t0 + wid * 8 + q) * ZYW + 1536 + lane * 8);
#pragma unroll
        for (int q = 0; q < 8; ++q) {
            const int tt = wid * 8 + q;
            const u32x4 xv = *(const LAS u32x4*)(lds + CF_OUT + tt * 1024 + lane * 16);
            bf16* yp = ybase + ((size_t)b * SEQ + t0 + tt) * ypitch + lane * 8;
            float v[8], s = 0.f, s2 = 0.f;
#pragma unroll
            for (int e = 0; e < 4; ++e) { v[2 * e] = bflo(xv[e]); v[2 * e + 1] = bfhi(xv[e]); }
#pragma unroll
            for (int e = 0; e < 8; ++e) { s += v[e]; s2 += v[e] * v[e]; }
            s = wave_sum(s); s2 = wave_sum(s2);
            const float mean = s * (1.f / 512.f), var = fmaxf(s2 * (1.f / 512.f) - mean * mean, 0.f), rstd = rsqrtf(var + EPS);
            u32x4 ov;
#pragma unroll
            for (int e = 0; e < 4; ++e) {
                const float y0 = siluf((v[2 * e] - mean) * rstd * lw[2 * e] + lb[2 * e]) * bflo(zv[q][e]);
                const float y1 = siluf((v[2 * e + 1] - mean) * rstd * lw[2 * e + 1] + lb[2 * e + 1]) * bfhi(zv[q][e]);
                ov[e] = cvtpk(y0, y1);
            }
            __builtin_nontemporal_store(ov, (u32x4*)yp);
        }
    }
    __syncthreads();
}

typedef unsigned u32x2f __attribute__((ext_vector_type(2)));
__device__ __forceinline__ void final_norm_rows(const bf16* __restrict__ XB, float* __restrict__ out, const float* __restrict__ w, const float* __restrict__ SSQ, int gw, int NGW, int lane, int Mend) {
    f32x4 wv[4];
#pragma unroll
    for (int j = 0; j < 4; ++j) wv[j] = *(const f32x4*)(w + 4 * lane + 256 * j);
#pragma unroll 1
    for (int r0 = gw; r0 < Mend; r0 += 16 * NGW) {
        u32x2f xv[16][4]; float sq[16];
#pragma unroll
        for (int r = 0; r < 16; ++r) {
            const int row = r0 + r * NGW;
            sq[r] = (row < Mend && lane < 16) ? SSQ[row * 16 + lane] : 0.f;
#pragma unroll
            for (int j = 0; j < 4; ++j) { xv[r][j] = (u32x2f){0u, 0u}; if (row < Mend) xv[r][j] = *(const u32x2f*)(XB + (size_t)row * DM + 4 * lane + 256 * j); }
        }
        asm volatile("" ::: "memory");
#pragma unroll
        for (int r = 0; r < 16; ++r) {
            const int row = r0 + r * NGW;
            const float rstd = rsqrtf(wave_sum(sq[r]) * (1.f / DM) + EPS);
            if (row < Mend) {
#pragma unroll
                for (int j = 0; j < 4; ++j) {
                    const f32x4 o = {bflo(xv[r][j].x) * rstd * wv[j][0], bfhi(xv[r][j].x) * rstd * wv[j][1], bflo(xv[r][j].y) * rstd * wv[j][2], bfhi(xv[r][j].y) * rstd * wv[j][3]};
                    __builtin_nontemporal_store(o, (f32x4*)(out + (size_t)row * DM + 4 * lane + 256 * j));
                }
            }
        }
    }
}

#define GAS __attribute__((address_space(1)))
typedef GAS unsigned gu32;
#define RLX_AGENT __ATOMIC_RELAXED, __HIP_MEMORY_SCOPE_AGENT
#define XB_TMO      128
#define XB_XCNT(j)  (256  + 64 * (j))
#define XB_XSUB(j)  (1280 + 64 * (j))
#define XB_XGEN(j)  (2304 + 64 * (j))
#define XB_TOP      3328
#define XB_TOPGEN   3392
#define XCD_BAR_WORDS 3456
#define XB_SPIN_CAP (1u << 18)

__device__ __forceinline__ unsigned xb_ld(unsigned* p)              { return __hip_atomic_load(p, __ATOMIC_RELAXED, __HIP_MEMORY_SCOPE_AGENT); }
__device__ __forceinline__ unsigned xb_add(unsigned* p, unsigned v) { return __hip_atomic_fetch_add(p, v, __ATOMIC_RELAXED, __HIP_MEMORY_SCOPE_AGENT); }
__device__ __forceinline__ unsigned xb_xcc_id() { return (unsigned)__builtin_amdgcn_s_getreg((3 << 11) | 20) & 0xFu; }
#define XB_SPIN(cond, bar) do { unsigned _sp = 0; while (cond) { __builtin_amdgcn_s_sleep(1); \
    if ((++_sp & 255u) == 0u) { if (xb_ld(&(bar)[XB_TMO])) break; if (_sp > XB_SPIN_CAP) { atomicAdd(&(bar)[XB_TMO], 1u); break; } } } } while (0)

struct XcdBarrier {
    unsigned* bar; unsigned x;
    unsigned total;
    volatile LAS unsigned* st;
};

__device__ __forceinline__ XcdBarrier xcd_barrier_post(unsigned* bar, volatile LAS unsigned* st, bool leader) {
    XcdBarrier b; b.bar = bar; b.x = xb_xcc_id(); b.st = st; b.total = 0u;
    if (leader) (void)xb_add(&bar[XB_XCNT(b.x)], 1u);
    return b;
}
__device__ __forceinline__ void xcd_barrier_complete(unsigned* bar, unsigned x, unsigned& nloc, unsigned& nx, unsigned G) {
    unsigned sum, cnt, mine, sp = 0u;
    for (;;) {
        sum = 0u; cnt = 0u; mine = 0u;
#pragma unroll
        for (unsigned j = 0; j < 16; ++j) { const unsigned c = xb_ld(&bar[XB_XCNT(j)]); sum += c; cnt += (c > 0u) ? 1u : 0u; mine = (j == x) ? c : mine; }
        if (sum == G) break;
        __builtin_amdgcn_s_sleep(1);
        if ((++sp & 255u) == 0u) { if (xb_ld(&bar[XB_TMO])) break; if (sp > XB_SPIN_CAP) { atomicAdd(&bar[XB_TMO], 1u); break; } }
    }
    nloc = mine > 0u ? mine : 1u; nx = cnt > 0u ? cnt : 1u;
}

__device__ __forceinline__ void xcd_barrier(const XcdBarrier& b, bool leader) {
    asm volatile("s_waitcnt vmcnt(0)" ::: "memory");
    __syncthreads();
    if (leader) {
        unsigned* bar = b.bar;
        __builtin_amdgcn_s_waitcnt(0);
        unsigned nloc = b.st[0], nx = b.st[1];
        if (nloc == 0u) { xcd_barrier_complete(bar, b.x, nloc, nx, b.total); b.st[0] = nloc; b.st[1] = nx; }
        const unsigned old = xb_add(&bar[XB_XSUB(b.x)], 1u);
        const unsigned gen = old / nloc;
        if (old + 1u == (gen + 1u) * nloc) {
            if (nx > 1u) {
                __builtin_amdgcn_fence(__ATOMIC_RELEASE, "agent");
                asm volatile("s_waitcnt vmcnt(0)" ::: "memory");
                const unsigned og = xb_add(&bar[XB_TOP], 1u);
                const unsigned tg = og / nx;
                if (og + 1u == (tg + 1u) * nx) xb_add(&bar[XB_TOPGEN], 1u);
                else XB_SPIN(xb_ld(&bar[XB_TOPGEN]) == tg, bar);
            }
            __builtin_amdgcn_fence(__ATOMIC_ACQUIRE, "agent");
            xb_add(&bar[XB_XGEN(b.x)], 1u);
            asm volatile("s_waitcnt vmcnt(0)" ::: "memory");
        } else if (nx == 1u) {
            __builtin_amdgcn_fence(__ATOMIC_ACQUIRE, "agent");
            XB_SPIN(xb_ld(&bar[XB_XGEN(b.x)]) == gen, bar);
            asm volatile("s_waitcnt vmcnt(0)" ::: "memory");
        } else {
            XB_SPIN(xb_ld(&bar[XB_XGEN(b.x)]) == gen, bar);
            __builtin_amdgcn_fence(__ATOMIC_ACQUIRE, "agent");
            asm volatile("s_waitcnt vmcnt(0)" ::: "memory");
        }
    }
    __syncthreads();
}

__global__ __launch_bounds__(NTHR, 2) void mega_fwd(Params p) {
    extern __shared__ __attribute__((aligned(16))) unsigned char lds[];
    float* sm = (float*)lds;
    volatile LAS unsigned* MISC = (volatile LAS unsigned*)((LAS unsigned char*)lds + MISC_OFF);
    const int wv = __builtin_amdgcn_readfirstlane((int)(threadIdx.x >> 6));
#define LEADER() (wv == 0 && lane_id() == 0)
    if (wv == 0 && lane_id() < 16) MISC[lane_id()] = 0u;
    __syncthreads();
    { const XcdBarrier b0 = xcd_barrier_post((unsigned*)(p.ws + WS_CTL) + CW_BAR, MISC + 8, LEADER()); if (LEADER()) MISC[10] = b0.x; }
    (void)xcd_barrier_post((unsigned*)(p.ws + WS_CTL) + CW_GBAR + (blockIdx.x & 7) * CW_GSTRIDE, MISC + 11, LEADER());
    __syncthreads();
#define GRID_SYNC() do { XcdBarrier b_; b_.bar = (unsigned*)(p.ws + WS_CTL) + CW_BAR; b_.st = MISC + 8; b_.x = MISC[10]; b_.total = gridDim.x; xcd_barrier(b_, LEADER()); } while (0)
#define GROUP_SYNC() do { XcdBarrier b_; b_.bar = (unsigned*)(p.ws + WS_CTL) + CW_GBAR + (blockIdx.x & 7) * CW_GSTRIDE; b_.st = MISC + 11; b_.x = MISC[10]; \
        b_.total = (gridDim.x + 7u - (blockIdx.x & 7u)) >> 3; xcd_barrier(b_, LEADER()); } while (0)
    const int bid = blockIdx.x, G = gridDim.x, NGW = G * NWAVE;
    const int gx = bid & 7, li = bid >> 3, gs = G >> 3;
#define SEAM() GROUP_SYNC()
#define ROWLOOP(body) do { const int tid_ = opaque_tid(wv), lane = tid_ & 63, gw_ = bid * NWAVE + __builtin_amdgcn_readfirstlane(tid_ >> 6); for (int row = gw_; row < M; row += NGW) { body; } } while (0)
    const float* x = p.in[0];
    unsigned char* ws = p.ws;
    bf16* Win_t = (bf16*)(ws + WS_WIN); bf16* Wout_t = (bf16*)(ws + WS_WOUT);
    float* SSQ = (float*)(ws + WS_SSQ); float* SSQH = (float*)(ws + WS_SSQH); float* DT = (float*)(ws + WS_DT);
    bf16* XB = (bf16*)(ws + WS_XB); bf16* ZY = (bf16*)(ws + WS_ZY); bf16* P = (bf16*)(ws + WS_P);
    float* out = p.out;

    wconv_items(p, ws, bid, G, sm, wv);
    { const int tid_ = opaque_tid(wv); normprep_rows(x, XB, (float*)(ws + WS_XS), bid * NWAVE + __builtin_amdgcn_readfirstlane(tid_ >> 6), NGW, tid_ & 63); }
    GRID_SYNC();

    for (int l = 0; l < DEPTH; ++l) {
        {
            pg8::Gemm g{XB, Win_t + (size_t)l * NINP * DM, M, NINP, DM}; pg8::StaticOrder S; S.init(M, NINP, G, bid);
            int pt0 = -1, pt1 = -1, pt2 = -1, pt3 = -1;
            if (l != 0) {
                { pg8::Unit uu; for (int i = 0; S.next(i, uu); ++i) { const int pm_ = uu.pm; if (pm_ != pt0 && pm_ != pt1 && pm_ != pt2 && pm_ != pt3) { if (pt0 < 0) pt0 = pm_; else if (pt1 < 0) pt1 = pm_; else if (pt2 < 0) pt2 = pm_; else if (pt3 < 0) pt3 = pm_; } } }
                const int tid_ = opaque_tid(wv);
#pragma unroll
                for (int hh = 0; hh < 2; ++hh) {
                    const int sl = (tid_ >> 8) + 2 * hh, pmx = sl == 0 ? pt0 : sl == 1 ? pt1 : sl == 2 ? pt2 : pt3;
                    if (pmx >= 0) {
                        const f32x4* sp = (const f32x4*)(SSQ + ((size_t)pmx * 256 + (tid_ & 255)) * 16);
                        const f32x4 s0 = sp[0], s1 = sp[1], s2 = sp[2], s3 = sp[3];
                        const float sm_ = ((s0[0] + s0[1]) + (s0[2] + s0[3])) + ((s1[0] + s1[1]) + (s1[2] + s1[3])) + ((s2[0] + s2[1]) + (s2[2] + s2[3])) + ((s3[0] + s3[1]) + (s3[2] + s3[3]));
                        ((LAS float*)((LAS unsigned char*)lds + 131072))[sl * 256 + (tid_ & 255)] = rsqrtf(sm_ * (1.f / DM) + EPS);
                    }
                }
                if (tid_ < 128) ((LAS int*)((LAS unsigned char*)lds + 131072 + 4096))[tid_] = tid_ == pt0 ? 0 : tid_ == pt1 ? 1 : tid_ == pt2 ? 2 : tid_ == pt3 ? 3 : -1;
                __syncthreads();
            }
            EpiIn E{SSQ, ZY, P, DT, l == 0 ? 1 : 0, (bf16*)(ws + WS_BC), (bf16*)(ws + WS_RAWB), p.in[3] + l * 4 * 1536, p.in[4] + l * 1536, (const PG8_LAS float*)((PG8_LAS unsigned char*)lds + 131072)};
#if STAGGER_IN > 0
            if ((bid >> 3) & 1) { const unsigned long long t0_ = __builtin_amdgcn_s_memrealtime(); while (__builtin_amdgcn_s_memrealtime() - t0_ < STAGGER_IN) __builtin_amdgcn_s_sleep(8); }
#endif
#if REP_PHASE == 4
            pg8::gemm_phase<EpiIn, pg8::StaticOrder, true, true>((PG8_LAS unsigned char*)lds, g, S, E, wv);
#endif
            pg8::gemm_phase<EpiIn, pg8::StaticOrder, true, true>((PG8_LAS unsigned char*)lds, g, S, E, wv);
        }
        SEAM();
        {
            SsdArgs sa{P, ZY, DT, SSQH, p.in[3] + l * 4 * 1536, p.in[4] + l * 1536, p.in[5] + l * 16, p.in[6] + l * 16, p.in[7] + l * 16, (const bf16*)(ws + WS_RAWB)};
            bf16* BC = (bf16*)(ws + WS_BC);
#if CONV_STEP1
            for (int u = bid; u < BATCH * 32; u += G) bc_unit(sa, u, BC, wv);
            GRID_SYNC();
#endif
            AttnArgs aa{P, ZY, p.in[9] + l * 8};
            ConfArgs ca{P, ZY, p.in[10] + l * 31 * 512, p.in[11] + l * 512, p.in[12] + l * 512, p.in[13] + l * 512};
            const bool ssd_first = (bid & 7) < 4;
#pragma nounroll
            for (int slot = 0; slot < 2; ++slot) {
                if ((slot == 0) == ssd_first) {
#if REP_PHASE == 1
                    for (int u = bid; u < BATCH * 16; u += G) { const int pair = (u & 7) + 8 * (u >> 6), hh = (u >> 3) & 7; ssd_unit6<SSD_PROBE>(sa, (pair >> 1) * 16 + (pair & 1) * 8 + hh, (LAS unsigned char*)lds, (bf16*)out, 1024, nullptr, BC, wv); }
#endif
                    for (int ul = li; ul < 32; ul += gs)
                        ssd_unit6<0>(sa, (2 * gx + (ul >> 4)) * 16 + (ul & 15), (LAS unsigned char*)lds, ZY, ZYW, SSQH, BC, wv);
                } else {
                    if (ssd_first) {
                        for (int ul = li; ul < 64; ul += gs) conf_unit(ca, ((2 * gx + (ul >> 5)) << 5) | (ul & 31), (LAS unsigned char*)lds, ZY + 1536, ZYW, wv);
                        for (int ul = li; ul < 64; ul += gs) attn_unit(aa, ((2 * gx + (ul >> 5)) << 5) | (ul & 31), (LAS unsigned char*)lds, ZY + 1024, ZYW, wv);
                    } else {
                        for (int ul = li; ul < 64; ul += gs) attn_unit(aa, ((2 * gx + (ul >> 5)) << 5) | (ul & 31), (LAS unsigned char*)lds, ZY + 1024, ZYW, wv);
                        for (int ul = li; ul < 64; ul += gs) conf_unit(ca, ((2 * gx + (ul >> 5)) << 5) | (ul & 31), (LAS unsigned char*)lds, ZY + 1536, ZYW, wv);
                    }
                }
            }
        }
        SEAM();
        {
            pg8::Gemm g{ZY, Wout_t + (size_t)l * DM * 2048, M, DM, 2048}; pg8::StaticOrder S; S.init(M, DM, G, bid);
            EpiOut E{l == 0 ? (const float*)(ws + WS_XS) : nullptr, XB, SSQ, SSQH, 0};
#if REP_PHASE == 6
            if (l == 0) { EpiOut E2{(const float*)(ws + WS_XS), XB, SSQ, SSQH, 1}; pg8::gemm_phase<EpiOut, pg8::StaticOrder, true, true>((PG8_LAS unsigned char*)lds, g, S, E2, wv); }
#endif
            pg8::gemm_phase<EpiOut, pg8::StaticOrder, true, true>((PG8_LAS unsigned char*)lds, g, S, E, wv);
        }
        SEAM();
    }
    { const int tid_ = opaque_tid(wv); const int wv_ = __builtin_amdgcn_readfirstlane(tid_ >> 6);
      final_norm_rows(XB, out, p.in[15], SSQ, gx * 4096 + li * NWAVE + wv_, gs * NWAVE, tid_ & 63, gx * 4096 + 4096); }
}

extern "C" void kernel_launch(void* const* d_in, const int* in_sizes, int n_in, void* d_out, int out_size, void* d_ws, size_t ws_size, hipStream_t stream) {
    static int grid_blocks = 0;
    if (grid_blocks == 0) {
        if (n_in != 16 || out_size != M * DM || ws_size < WS_END) { fprintf(stderr, "kernel_launch: unexpected shapes (n_in %d out %d ws %zu)\n", n_in, out_size, ws_size); grid_blocks = -1; return; }
        int dev = 0, cus = 0, per_cu = 0;
        (void)hipGetDevice(&dev);
        (void)hipDeviceGetAttribute(&cus, hipDeviceAttributeMultiprocessorCount, dev);
        (void)hipFuncSetAttribute((const void*)mega_fwd, hipFuncAttributeMaxDynamicSharedMemorySize, LDS_BYTES);
        (void)hipOccupancyMaxActiveBlocksPerMultiprocessor(&per_cu, (const void*)mega_fwd, NTHR, LDS_BYTES);
        if (per_cu < 1) { fprintf(stderr, "kernel_launch: occupancy query says %d blocks per CU\n", per_cu); per_cu = 1; }
        grid_blocks = (cus / 8) * 8;
        fprintf(stderr, "kernel_launch: %d CUs, occupancy %d/CU, grid %d\n", cus, per_cu, grid_blocks);
    }
    if (grid_blocks < 0) return;
    Params p{};
    for (int i = 0; i < 16; ++i) p.in[i] = (const float*)d_in[i];
    p.out = (float*)d_out; p.ws = (unsigned char*)d_ws;
    if (hipMemsetAsync((char*)d_ws + WS_CTL, 0, CTL_ZERO_BYTES, stream) != hipSuccess) { fprintf(stderr, "kernel_launch: memset of the control words failed\n"); return; }
    hipLaunchKernelGGL(mega_fwd, dim3(grid_blocks), dim3(NTHR), LDS_BYTES, stream, p);
    const hipError_t e = hipPeekAtLastError();
    if (e != hipSuccess) fprintf(stderr, "launch failed: %s (grid %d)\n", hipGetErrorString(e), grid_blocks);
}
```
